# Optimizing an MI355X kernel written in HIP

```python
import jax, jax.numpy as jnp
from jax import lax
import numpy as np

D_MODEL = 2048
BATCH = 16
SEQ = 2048
DEPTH = 1

D_MIX = D_MODEL
RET_HEADS = 8
RET_HEAD_DIM = 128
RET_WIDTH = RET_HEADS * RET_HEAD_DIM
RET_CHUNK = 128
ROPE_BASE = 10000.0
LRU_WIDTH = D_MIX - RET_WIDTH
LRU_BLOCKS = 8
LRU_BLOCK_DIM = LRU_WIDTH // LRU_BLOCKS
CONV_WIDTH = 4
LRU_C = 8.0
PROJ_IN = 4 * RET_WIDTH + 2 * LRU_WIDTH
N_GROUPS = 4
EXPERTS_PER_GROUP = 8
N_EXPERTS = N_GROUPS * EXPERTS_PER_GROUP
TOP_K = 2
D_EXPERT = D_MODEL // 2
MOE_BLOCK = 128
EPS = 1e-6

kernel_name = "hymba_retention_rglru_hmoe"


def rms_norm(x, g):
    xf = x.astype(jnp.float32)
    y = xf * lax.rsqrt(jnp.mean(xf * xf, axis=-1, keepdims=True) + EPS)
    return (y * g.astype(jnp.float32)).astype(x.dtype)


def rope(x, pos):
    half = x.shape[-1] // 2
    inv = ROPE_BASE ** (-jnp.arange(half, dtype=jnp.float32) / half)
    ang = pos.astype(jnp.float32)[:, None] * inv[None, :]
    cos = jnp.cos(ang)[None, :, None, :]
    sin = jnp.sin(ang)[None, :, None, :]
    xf = x.astype(jnp.float32)
    x1, x2 = xf[..., :half], xf[..., half:]
    return jnp.concatenate([x1 * cos - x2 * sin, x1 * sin + x2 * cos], axis=-1).astype(x.dtype)


def retention_chunkwise(q, k, v):
    B, S, H, d = q.shape
    C = RET_CHUNK
    N = S // C
    log_g = jnp.log1p(-(2.0 ** (-5.0 - jnp.arange(H, dtype=jnp.float32))))
    idx = jnp.arange(C, dtype=jnp.float32)
    rel = idx[:, None] - idx[None, :]
    decay_mask = jnp.where(rel[None] >= 0,
                           jnp.exp(jnp.maximum(rel, 0.0)[None] * log_g[:, None, None]), 0.0)
    q_dec = jnp.exp((idx + 1.0)[None, :] * log_g[:, None])
    k_dec = jnp.exp((C - 1.0 - idx)[None, :] * log_g[:, None])
    chunk_dec = jnp.exp(C * log_g)
    qc = q.reshape(B, N, C, H, d)
    kc = k.reshape(B, N, C, H, d)
    vc = v.reshape(B, N, C, H, d)
    scores = jnp.einsum('bnihd,bnjhd->bnhij', qc, kc).astype(jnp.float32) * decay_mask
    o_inner = jnp.einsum('bnhij,bnjhe->bnihe', scores, vc.astype(jnp.float32))
    kv = jnp.einsum('bnjhd,hj,bnjhe->nbhde', kc.astype(jnp.float32), k_dec,
                    vc.astype(jnp.float32))

    def step(state, kv_n):
        return chunk_dec[None, :, None, None] * state + kv_n, state

    _, s_prev = lax.scan(step, jnp.zeros((B, H, d, d), jnp.float32), kv)
    o_cross = jnp.einsum('bnihd,hi,nbhde->bnihe', qc.astype(jnp.float32), q_dec, s_prev)
    return (o_inner + o_cross).reshape(B, S, H, d)


def causal_depthwise_conv(u, w, b):
    K = w.shape[0]
    S = u.shape[1]
    up = jnp.pad(u, ((0, 0), (K - 1, 0), (0, 0)))
    out = b
    for kk in range(K):
        out = out + up[:, kk:kk + S] * w[kk]
    return out


def rg_lru(xc, w_rg, b_rg, w_ig, b_ig, lam):
    B, S, W = xc.shape
    xb = xc.reshape(B, S, LRU_BLOCKS, LRU_BLOCK_DIM)
    r = jax.nn.sigmoid(jnp.einsum('bsnc,ncd->bsnd', xb, w_rg).reshape(B, S, W) + b_rg)
    i = jax.nn.sigmoid(jnp.einsum('bsnc,ncd->bsnd', xb, w_ig).reshape(B, S, W) + b_ig)
    log_a = (-LRU_C * r * jax.nn.softplus(-lam)).astype(jnp.float32)
    a = jnp.exp(log_a)
    bx = (jnp.sqrt(-jnp.expm1(2.0 * log_a)) * (i * xc)).astype(jnp.float32)

    def combine(left, right):
        a1, b1 = left
        a2, b2 = right
        return a1 * a2, a2 * b1 + b2

    _, h = lax.associative_scan(combine, (a, bx), axis=1)
    return h


def hierarchical_moe(h, w_group, b_group, w_router, b_router, w_gate, w_up, w_down):
    B, S, D = h.shape
    T = B * S
    xt = h.reshape(T, D)
    g_prob = jax.nn.softmax((xt @ w_group + b_group).astype(jnp.float32), axis=-1)
    g_p, g_idx = lax.top_k(g_prob, 1)
    e_logits = (xt @ w_router + b_router).astype(jnp.float32).reshape(T, N_GROUPS, EXPERTS_PER_GROUP)
    e_logits = jnp.take_along_axis(e_logits, g_idx[:, :, None], axis=1)[:, 0]
    e_top, e_loc = lax.top_k(e_logits, TOP_K)
    e_w = jax.nn.softmax(e_top, axis=-1) * g_p
    e_id = g_idx * EXPERTS_PER_GROUP + e_loc

    A = T * TOP_K
    flat_e = e_id.reshape(A)
    flat_w = e_w.reshape(A)
    order = jnp.argsort(flat_e)
    sorted_e = flat_e[order]
    counts = jnp.bincount(flat_e, length=N_EXPERTS)
    padded = (counts + MOE_BLOCK - 1) // MOE_BLOCK * MOE_BLOCK
    start = jnp.cumsum(counts) - counts
    pad_end = jnp.cumsum(padded)
    pad_start = pad_end - padded
    dest = pad_start[sorted_e] + (jnp.arange(A) - start[sorted_e])
    n_blocks = (A + N_EXPERTS * (MOE_BLOCK - 1) + MOE_BLOCK - 1) // MOE_BLOCK
    P = n_blocks * MOE_BLOCK
    tok = jnp.full((P,), T, jnp.int32).at[dest].set((order // TOP_K).astype(jnp.int32))
    wbuf = jnp.zeros((P,), jnp.float32).at[dest].set(flat_w[order])
    block_e = jnp.minimum(
        jnp.searchsorted(pad_end, jnp.arange(n_blocks) * MOE_BLOCK, side='right'), N_EXPERTS - 1)

    x_pad = jnp.concatenate([xt, jnp.zeros((1, D), xt.dtype)], axis=0)
    xs = x_pad[tok].reshape(n_blocks, MOE_BLOCK, D)

    def expert_block(args):
        xb, e = args
        hb = jax.nn.silu(xb @ w_gate[e]) * (xb @ w_up[e])
        return hb @ w_down[e]

    yb = lax.map(expert_block, (xs, block_e))
    y = yb.reshape(P, D) * wbuf[:, None].astype(yb.dtype)
    out = jnp.zeros((T + 1, D), yb.dtype).at[tok].add(y)[:T]
    return out.reshape(B, S, D)


def setup_inputs(seed: int = 0) -> dict:
    key = jax.random.key(seed)
    ks = jax.random.split(key, 24)
    f32 = jnp.float32
    L, D = DEPTH, D_MODEL

    def nrm(k, shape, scale):
        return jax.random.normal(k, shape, f32) * scale

    x = jax.random.normal(ks[0], (BATCH, SEQ, D), f32)
    norm_mix_g = 1.0 + nrm(ks[1], (L, D), 0.02)
    w_in = nrm(ks[2], (L, D, PROJ_IN), D ** -0.5)
    ret_norm_g = 1.0 + nrm(ks[3], (L, RET_WIDTH), 0.02)
    conv_w = nrm(ks[4], (L, CONV_WIDTH, LRU_WIDTH), CONV_WIDTH ** -0.5)
    conv_b = nrm(ks[5], (L, LRU_WIDTH), 0.02)
    w_rg = nrm(ks[6], (L, LRU_BLOCKS, LRU_BLOCK_DIM, LRU_BLOCK_DIM), LRU_BLOCK_DIM ** -0.5)
    b_rg = nrm(ks[7], (L, LRU_WIDTH), 0.02)
    w_ig = nrm(ks[8], (L, LRU_BLOCKS, LRU_BLOCK_DIM, LRU_BLOCK_DIM), LRU_BLOCK_DIM ** -0.5)
    b_ig = nrm(ks[9], (L, LRU_WIDTH), 0.02)
    u = jax.random.uniform(ks[10], (L, LRU_WIDTH), f32, 0.9, 0.999)
    a0 = u ** (1.0 / LRU_C)
    lru_lambda = jnp.log(a0) - jnp.log1p(-a0)
    lru_norm_g = 1.0 + nrm(ks[11], (L, LRU_WIDTH), 0.02)
    w_out = nrm(ks[12], (L, D_MIX, D), D_MIX ** -0.5)
    norm_ffn_g = 1.0 + nrm(ks[13], (L, D), 0.02)
    w_group = nrm(ks[14], (L, D, N_GROUPS), D ** -0.5)
    b_group = nrm(ks[15], (L, N_GROUPS), 0.01)
    w_router = nrm(ks[16], (L, D, N_EXPERTS), D ** -0.5)
    b_router = nrm(ks[17], (L, N_EXPERTS), 0.01)
    w_gate = nrm(ks[18], (L, N_EXPERTS, D, D_EXPERT), D ** -0.5)
    w_up = nrm(ks[19], (L, N_EXPERTS, D, D_EXPERT), D ** -0.5)
    w_down = nrm(ks[20], (L, N_EXPERTS, D_EXPERT, D), D_EXPERT ** -0.5)
    norm_final_g = 1.0 + nrm(ks[21], (D,), 0.02)
    return {"x": x, "norm_mix_g": norm_mix_g, "w_in": w_in, "ret_norm_g": ret_norm_g,
            "conv_w": conv_w, "conv_b": conv_b, "w_rg": w_rg, "b_rg": b_rg,
            "w_ig": w_ig, "b_ig": b_ig, "lru_lambda": lru_lambda, "lru_norm_g": lru_norm_g,
            "w_out": w_out, "norm_ffn_g": norm_ffn_g, "w_group": w_group, "b_group": b_group,
            "w_router": w_router, "b_router": b_router, "w_gate": w_gate, "w_up": w_up,
            "w_down": w_down, "norm_final_g": norm_final_g}


def reference(x, norm_mix_g, w_in, ret_norm_g, conv_w, conv_b, w_rg, b_rg, w_ig, b_ig,
              lru_lambda, lru_norm_g, w_out, norm_ffn_g, w_group, b_group, w_router, b_router,
              w_gate, w_up, w_down, norm_final_g):
    B, S, D = x.shape
    pos = jnp.arange(S)
    R = RET_WIDTH
    splits = [R, 2 * R, 3 * R, 4 * R, 4 * R + LRU_WIDTH]
    for l in range(DEPTH):
        h = rms_norm(x, norm_mix_g[l])
        proj = h @ w_in[l]
        q, k, v, g_ret, u, z = jnp.split(proj, splits, axis=-1)
        q = rope(q.reshape(B, S, RET_HEADS, RET_HEAD_DIM), pos) * (RET_HEAD_DIM ** -0.5)
        k = rope(k.reshape(B, S, RET_HEADS, RET_HEAD_DIM), pos)
        v = v.reshape(B, S, RET_HEADS, RET_HEAD_DIM)
        o = retention_chunkwise(q, k, v)
        mu = jnp.mean(o, axis=-1, keepdims=True)
        var = jnp.mean(jnp.square(o - mu), axis=-1, keepdims=True)
        o = (o - mu) * lax.rsqrt(var + EPS)
        o = o.reshape(B, S, R) * ret_norm_g[l].astype(jnp.float32)
        ret_out = (jax.nn.silu(g_ret.astype(jnp.float32)) * o).astype(x.dtype)
        uc = causal_depthwise_conv(u, conv_w[l], conv_b[l])
        hl = rg_lru(uc, w_rg[l], b_rg[l], w_ig[l], b_ig[l], lru_lambda[l])
        hl = hl.reshape(B, S, LRU_BLOCKS, LRU_BLOCK_DIM)
        hl = hl * lax.rsqrt(jnp.mean(hl * hl, axis=-1, keepdims=True) + EPS)
        hl = hl.reshape(B, S, LRU_WIDTH) * lru_norm_g[l].astype(jnp.float32)
        lru_out = (hl * jax.nn.gelu(z.astype(jnp.float32))).astype(x.dtype)
        mix = jnp.concatenate([ret_out, lru_out], axis=-1)
        x = x + mix @ w_out[l]
        h = rms_norm(x, norm_ffn_g[l])
        x = x + hierarchical_moe(h, w_group[l], b_group[l], w_router[l], b_router[l],
                                 w_gate[l], w_up[l], w_down[l])
    return rms_norm(x, norm_final_g)
```

```cpp
#include <hip/hip_runtime.h>
#include <cstdio>
#include <cstdint>

#ifndef MK_N_LAUNCHES
#define MK_N_LAUNCHES 1
#endif
#ifndef MK_REPEAT_PHASE
#define MK_REPEAT_PHASE -1
#endif
#ifndef MK_LAST_PHASE
#define MK_LAST_PHASE 8
#endif

#define GAS __attribute__((address_space(1)))
#define LAS __attribute__((address_space(3)))
typedef unsigned short bf16_t;
typedef short bf16x8 __attribute__((ext_vector_type(8)));
typedef short s16x4 __attribute__((ext_vector_type(4)));
typedef float f32x4 __attribute__((ext_vector_type(4)));
typedef float f32x2 __attribute__((ext_vector_type(2)));
typedef unsigned u32x4 __attribute__((ext_vector_type(4)));
typedef unsigned u32x2 __attribute__((ext_vector_type(2)));
typedef GAS unsigned gu32;
typedef int i32x4 __attribute__((ext_vector_type(4)));
typedef int i32x8 __attribute__((ext_vector_type(8)));
constexpr float SC_WGU = 64.0f, SC_WD = 32.0f, SC_HB = 4.0f, SC_Y = 16.0f;

constexpr int T = 32768, D = 2048, SEQ = 2048, NBATCH = 16, PROJ = 6144;
constexpr int NH = 8, HD = 128, CHK = 128, NCHUNK = SEQ / CHK;
constexpr int NLB = 8;
constexpr int NE = 32, DE = 1024;
constexpr int CAP = 32768;
constexpr int MAXRT = 288;
constexpr float EPS = 1e-6f;
constexpr int NWAVES = 8, NTHREADS = 512;
constexpr int NPHASES = 8;

constexpr size_t MiB = 1u << 20;
constexpr size_t WS_CTL = 0, CTL_ZERO_BYTES = 65536;
constexpr size_t WS_TOK = 1 * MiB;
constexpr size_t WS_RSS = 5 * MiB;
constexpr size_t WS_APK = 9 * MiB;
constexpr size_t WS_AW  = 9 * MiB + 512 * 1024;
constexpr size_t WS_ROPE = 10 * MiB;
constexpr size_t WS_WGT = 11 * MiB;
constexpr size_t WS_WIN = 12 * MiB;
constexpr size_t WS_WOUT = 36 * MiB;
constexpr size_t WS_WD = 44 * MiB;
constexpr size_t WS_WGU = 172 * MiB;
constexpr size_t WS_R2 = 428 * MiB;
constexpr size_t WS_H2 = WS_R2, WS_X1 = WS_R2 + 128 * MiB;
constexpr size_t WS_R1 = 812 * MiB;
constexpr size_t WS_Y = WS_WGU;
constexpr size_t WS_END = 956 * MiB;
static_assert(WS_Y + (size_t)MAXRT * 256 * 2048 * 2 <= WS_X1, "y overlays Wgu + h2 only");
static_assert(WS_R1 + (size_t)MAXRT * 256 * 1024 * 2 <= WS_END, "hb fits");
constexpr int CW_BAR = 1024;
constexpr int CW_CNT = 8192;
constexpr int CW_Q = 6144;
constexpr int NCONV = 32;

constexpr int RING_BYTES = 131072;
constexpr int LDSCTL_OFF = 143360, MISC_OFF = LDSCTL_OFF + 320;
constexpr int TS_OFF = LDSCTL_OFF + 1024;
constexpr int CN_OFF = LDSCTL_OFF + 1280;
constexpr int RE_OFF = LDSCTL_OFF + 1536;
constexpr int GT_OFF = LDSCTL_OFF + 2048;
constexpr int LDS_BYTES = 147456;

#define LDS_WAIT() asm volatile("s_waitcnt lgkmcnt(0)" ::: "memory")
#define VM_WAIT() asm volatile("s_waitcnt vmcnt(0)" ::: "memory")
__device__ __forceinline__ unsigned f2bf(float f) { unsigned u = __builtin_bit_cast(unsigned, f); return (u + 0x7fffu + ((u >> 16) & 1u)) >> 16; }
typedef __bf16 hwbf16x2 __attribute__((ext_vector_type(2)));
__device__ __forceinline__ unsigned pk2(float lo, float hi) { const f32x2 v = {lo, hi}; return __builtin_bit_cast(unsigned, __builtin_convertvector(v, hwbf16x2)); }
__device__ __forceinline__ float bflo(unsigned w) { return __builtin_bit_cast(float, w << 16); }
__device__ __forceinline__ float bfhi(unsigned w) { return __builtin_bit_cast(float, w & 0xffff0000u); }
__device__ __forceinline__ float sat8(float x) { return __builtin_amdgcn_fmed3f(x, -448.0f, 448.0f); }
__device__ __forceinline__ unsigned pk4_fp8(float a, float b, float c, float d) { int p = 0; a = sat8(a); b = sat8(b); c = sat8(c); d = sat8(d); p = __builtin_amdgcn_cvt_pk_fp8_f32(a, b, p, false); p = __builtin_amdgcn_cvt_pk_fp8_f32(c, d, p, true); return (unsigned)p; }
__device__ __forceinline__ unsigned cvt_pk_bf16(float lo, float hi) { unsigned r; asm volatile("v_cvt_pk_bf16_f32 %0, %1, %2" : "=v"(r) : "v"(lo), "v"(hi)); return r; }
__device__ __forceinline__ int lane_id() { int l; asm volatile("v_mbcnt_lo_u32_b32 %0, -1, 0\n\tv_mbcnt_hi_u32_b32 %0, -1, %0" : "=v"(l)); return l; }
__device__ __forceinline__ float wave_sum(float v) {
#pragma unroll
    for (int o = 1; o < 64; o <<= 1) v += __shfl_xor(v, o);
    return v;
}

namespace pg8 {
constexpr int BM = 256, BK = 64, HALF = 128, HTB = HALF * BK * 2, STAGE_BYTES = 8 * HTB, NXCD = 8, WGM = 2;
__host__ __device__ __forceinline__ int lds_byte(int r, int c) { const int st = (r >> 4) * 2 + (c >> 5), rr = r & 15, cc = c & 31, ob = rr * 64 + cc * 2; return st * 1024 + (ob ^ (((ob >> 9) & 1) << 5)); }
__host__ __device__ __forceinline__ void stage_rc(int b, int& R, int& C) { const int st = b / 1024, sb = b % 1024, swz = sb ^ (((sb >> 9) & 1) << 5); R = (st >> 1) * 16 + swz / 64; C = (st & 1) * 32 + (swz % 64) / 2; }
__host__ __device__ __forceinline__ int perm32(int rho) { const int n = rho >> 4, i = rho & 15; return 8 * (i >> 2) + 4 * n + (i & 3); }

struct Unit { int pm, pn, e, ti; };

template <int NM, int NN> struct StaticOrder {
    static_assert(NM % WGM == 0 && (NM * NN) % NXCD == 0, "whole 8-row groups, whole XCD shares");
    int G, c;
    __device__ void init(int, int, int G_, int c_) { G = G_; c = c_; }
    __device__ bool next(int i, Unit& u) const {
        constexpr int nwg = NM * NN, q = nwg / NXCD, nig = WGM * NN;
        const int L = i * G + c; if (L >= nwg) return false;
        const int wgid = (L % NXCD) * q + L / NXCD;
        const int gid = wgid / nig, w = wgid % nig;
        u.pm = gid * WGM + (w % WGM); u.pn = w / WGM; u.e = 0; u.ti = 0; return true;
    }
};
template <int K, int NM, int NN, bool ROPE = false, bool IDENT = false> struct DenseSched {
    static constexpr bool ident = IDENT;
    StaticOrder<NM, NN> so; const char* A; const char* B;
    __device__ __forceinline__ bool bsel(const Unit& u) const { return ROPE && u.pn < 8; }
    __device__ __forceinline__ bool next(int i, Unit& u) const { return so.next(i, u); }
    __device__ __forceinline__ const char* a_ptr(const Unit& u) const { return IDENT ? A : A + (size_t)u.pm * (256 * K * 2); }
    __device__ __forceinline__ const char* b_ptr(const Unit& u) const { return B + (size_t)u.pn * (256 * K * 2); }
    __device__ __forceinline__ void gather(const Unit& u, int tid, unsigned (&v)[2][2]) const {
#pragma unroll
        for (int i = 0; i < 2; ++i) { int R, C; stage_rc(tid * 16 + i * 8192, R, C);
#pragma unroll
            for (int h = 0; h < 2; ++h) v[h][i] = ((unsigned)(u.pm * 256 + h * 128 + R) * (unsigned)K + (unsigned)C) * 2u; }
    }
    __device__ __forceinline__ const int* tok_ptr(const Unit&) const { return nullptr; }
    __device__ __forceinline__ int count(const Unit&) const { return 0; }
};
template <int K, bool GATHER, bool IDENT = false> struct MoeSched {
    static constexpr bool ident = IDENT;
    int G, c, nrt; const LAS int* ts; const LAS int* cn;
    const char* A; const char* B; size_t bstride; const int* tok;
    __device__ __forceinline__ bool bsel(const Unit&) const { return false; }
    __device__ __forceinline__ bool next(int i, Unit& u) const {
        int L;
        int rt, pnv;
        if (G == 256) { const int b = i * 8 + (c & 7), s_ = c >> 3; rt = (b >> 1) * 8 + (s_ >> 2); pnv = (b & 1) * 4 + (s_ & 3); L = rt * 8 + pnv; }
        else { L = i * G + c; rt = L >> 3; }
        if (rt >= nrt) return false;
        const int e = __builtin_amdgcn_readfirstlane((int)((const LAS unsigned char*)ts + (RE_OFF - TS_OFF))[rt]);
        u.pm = rt; u.pn = L & 7; u.e = e; u.ti = rt - __builtin_amdgcn_readfirstlane(ts[e]); return true;
    }
    __device__ __forceinline__ const char* a_ptr(const Unit& u) const { return GATHER ? A : A + (size_t)u.pm * (256 * K * 2); }
    __device__ __forceinline__ const char* b_ptr(const Unit& u) const { return B + (size_t)u.e * bstride + (size_t)u.pn * (256 * K * 2); }
    __device__ __forceinline__ const int* tok_ptr(const Unit& u) const { return tok + (size_t)u.e * CAP + u.ti * 256; }
    __device__ __forceinline__ int count(const Unit& u) const { return __builtin_amdgcn_readfirstlane(cn[u.e]); }
    __device__ __forceinline__ void gather(const Unit& u, int tid, unsigned (&v)[2][2]) const {
        const int cnt = __builtin_amdgcn_readfirstlane(cn[u.e]);
#pragma unroll
        for (int i = 0; i < 2; ++i) { int R, C; stage_rc(tid * 16 + i * 8192, R, C);
#pragma unroll
            for (int h = 0; h < 2; ++h) { const int rank = u.ti * 256 + h * 128 + R; int t = 0; if (IDENT) t = u.pm * 256 + h * 128 + R; else if (rank < cnt) t = tok[(size_t)u.e * CAP + rank];
                v[h][i] = ((unsigned)t * (unsigned)K + (unsigned)C) * 2u; } }
    }
};

struct EpiBf16 {
    static constexpr bool PERM = true, BSEL = false;
    bf16_t* O; int ldc; float sc;
    __device__ __forceinline__ void operator()(const f32x4 (&acc)[2][2][4][2], const Unit& u, int wr, int wc, int, int) const {
        const int lane_ = lane_id(), fr = lane_ & 15, fq = lane_ >> 4;
        const int row0 = u.pm * BM + wr * 64 + fr, col0 = u.pn * BM + wc * 32 + 8 * fq;
#pragma unroll
        for (int ai = 0; ai < 2; ++ai)
#pragma unroll
            for (int m = 0; m < 4; ++m) { bf16_t* rowp = O + (size_t)(row0 + ai * HALF + m * 16) * ldc + col0;
#pragma unroll
                for (int bj = 0; bj < 2; ++bj) { const f32x4 v0 = acc[ai][bj][m][0] * sc, v1 = acc[ai][bj][m][1] * sc;
                    u32x4 w; w.x = cvt_pk_bf16(v0[0], v0[1]); w.y = cvt_pk_bf16(v0[2], v0[3]); w.z = cvt_pk_bf16(v1[0], v1[1]); w.w = cvt_pk_bf16(v1[2], v1[3]);
                    *(u32x4*)(rowp + bj * HALF) = w; } }
    }
};
struct EpiFp8 {
    static constexpr bool PERM = true, BSEL = false;
    unsigned char* O; int ldc; float sc;
    __device__ __forceinline__ void operator()(const f32x4 (&acc)[2][2][4][2], const Unit& u, int wr, int wc, int, int) const {
        const int lane_ = lane_id(), fr = lane_ & 15, fq = lane_ >> 4;
        const int row0 = u.pm * BM + wr * 64 + fr, col0 = u.pn * BM + wc * 32 + 8 * (fq & ~1) + (fq & 1) * HALF;
#pragma unroll
        for (int ai = 0; ai < 2; ++ai)
#pragma unroll
            for (int m = 0; m < 4; ++m) { unsigned char* rowp = O + (size_t)(row0 + ai * HALF + m * 16) * ldc + col0;
                u32x2 w[2];
#pragma unroll
                for (int bj = 0; bj < 2; ++bj) { const f32x4 v0 = acc[ai][bj][m][0] * sc, v1 = acc[ai][bj][m][1] * sc;
                    w[bj].x = pk4_fp8(v0[0], v0[1], v0[2], v0[3]); w[bj].y = pk4_fp8(v1[0], v1[1], v1[2], v1[3]); }
                const auto sx = __builtin_amdgcn_permlane16_swap(w[0].x, w[1].x, false, false), sy = __builtin_amdgcn_permlane16_swap(w[0].y, w[1].y, false, false);
                *(u32x4*)rowp = (u32x4){sx[0], sy[0], sx[1], sy[1]}; }
    }
};
struct EpiProj {
    static constexpr bool PERM = true, BSEL = true;
    bf16_t* O; int ldc; const float* rc; const float* rsn;
    __device__ __forceinline__ void operator()(const f32x4 (&acc)[2][2][4][2], const Unit& u, int wr, int wc, int, int) const {
        const int lane_ = lane_id(), fr = lane_ & 15, fq = lane_ >> 4;
        const int row0 = u.pm * BM + wr * 64 + fr;
        if (u.pn >= 8) {
            const int col0 = wc * 32 + 8 * fq;
            const int act = (u.pn >= 12 && u.pn < 16) ? 1 : (u.pn >= 20 ? 2 : 0);
#pragma unroll
            for (int ai = 0; ai < 2; ++ai)
#pragma unroll
                for (int m = 0; m < 4; ++m) { bf16_t* rowp = O + ((size_t)(2 * u.pn) * T + (row0 + ai * HALF + m * 16)) * HD + col0;
#pragma unroll
                    for (int bj = 0; bj < 2; ++bj) { f32x4 v0 = acc[ai][bj][m][0], v1 = acc[ai][bj][m][1];
                        if (act) {
#pragma unroll
                            for (int j = 0; j < 4; ++j) { const float a = v0[j], b = v1[j];
                                const float ya = act == 1 ? a : 1.5957691216057308f * (a + 0.044715f * a * a * a), yb = act == 1 ? b : 1.5957691216057308f * (b + 0.044715f * b * b * b);
                                v0[j] = a * __builtin_amdgcn_rcpf(1.0f + __expf(-ya)); v1[j] = b * __builtin_amdgcn_rcpf(1.0f + __expf(-yb)); } }
                        u32x4 w; w.x = cvt_pk_bf16(v0[0], v0[1]); w.y = cvt_pk_bf16(v0[2], v0[3]); w.z = cvt_pk_bf16(v1[0], v1[1]); w.w = cvt_pk_bf16(v1[2], v1[3]);
                        *(u32x4*)(rowp + (size_t)bj * T * HD) = w; } }
        } else {
            const bool isq = u.pn < 4; const int f0 = 16 * wc + 4 * fq;
            constexpr float L2G[8] = {-4.580368961312479e-2f, -2.272007650008353e-2f, -1.1315313227834146e-2f, -5.646563141142063e-3f, -2.8205190623786626e-3f, -1.4095702546713536e-3f, -7.046129765893727e-4f, -3.522634716290214e-4f};
            float l2g[2];
#pragma unroll
            for (int bj = 0; bj < 2; ++bj) { const int hh = 2 * (u.pn & 3) + bj; float v = L2G[0];
#pragma unroll
                for (int q = 1; q < 8; ++q) v = (hh == q) ? L2G[q] : v;
                l2g[bj] = v; }
#pragma unroll
            for (int ai = 0; ai < 2; ++ai)
#pragma unroll
                for (int m = 0; m < 4; ++m) { const int row = row0 + ai * HALF + m * 16, pos = row & (SEQ - 1), il = pos & 127;
                    const f32x4 cs = *(const f32x4*)(rc + pos * 64 + f0), sn = *(const f32x4*)(rsn + pos * 64 + f0);
                    bf16_t* rowp = O + ((size_t)(2 * u.pn) * T + row) * HD + f0;
#pragma unroll
                    for (int bj = 0; bj < 2; ++bj) { const float sc = isq ? __builtin_amdgcn_exp2f((float)(il - 127) * l2g[bj]) * 0.08838834764831845f : __builtin_amdgcn_exp2f((float)(127 - il) * l2g[bj]);
                        const f32x4 x1 = acc[ai][bj][m][0], x2 = acc[ai][bj][m][1]; const f32x4 y1 = (x1 * cs - x2 * sn) * sc, y2 = (x1 * sn + x2 * cs) * sc;
                        u32x2 w1, w2; w1.x = cvt_pk_bf16(y1[0], y1[1]); w1.y = cvt_pk_bf16(y1[2], y1[3]); w2.x = cvt_pk_bf16(y2[0], y2[1]); w2.y = cvt_pk_bf16(y2[2], y2[3]);
                        *(u32x2*)(rowp + (size_t)bj * T * HD) = w1; *(u32x2*)(rowp + (size_t)bj * T * HD + 64) = w2; } }
        }
    }
};
struct EpiF32Res {
    static constexpr bool PERM = false, BSEL = false;
    const float* base; float* C; int ldc;
    __device__ __forceinline__ void operator()(const f32x4 (&acc)[2][2][4][2], const Unit& u, int wr, int wc, int, int) const {
        const int lane_ = lane_id(), fr = lane_ & 15, fq = lane_ >> 4;
        const int row0 = u.pm * BM + wr * 64 + fr, col0 = u.pn * BM + wc * 32 + 4 * fq;
#pragma unroll
        for (int ai = 0; ai < 2; ++ai)
#pragma unroll
            for (int m = 0; m < 4; ++m) { const size_t off = (size_t)(row0 + ai * HALF + m * 16) * ldc + col0;
#pragma unroll
                for (int bj = 0; bj < 2; ++bj)
#pragma unroll
                    for (int n = 0; n < 2; ++n) { const f32x4 b = *(const f32x4*)(base + off + bj * HALF + n * 16); *(f32x4*)(C + off + bj * HALF + n * 16) = acc[ai][bj][m][n] + b; }
                if (m == 3) asm volatile("" ::: "memory"); }
    }
};
struct EpiSwiGLU {
    static constexpr bool PERM = true, BSEL = false;
    unsigned char* O; const float* rss; const LAS int* cn;
    __device__ __forceinline__ void operator()(const f32x4 (&acc)[2][2][4][2], const Unit& u, int wr, int wc, int, int) const {
        const int lane_ = lane_id(), fr = lane_ & 15, fq = lane_ >> 4;
        const int cnt = __builtin_amdgcn_readfirstlane(cn[u.e]);
        const int col0 = u.pn * HALF + wc * 32 + 8 * fq;
        float rsv[2][4];
#pragma unroll
        for (int ai = 0; ai < 2; ++ai)
#pragma unroll
            for (int m = 0; m < 4; ++m) { const int rank = u.ti * 256 + ai * HALF + wr * 64 + m * 16 + fr; const float v = rss[(size_t)u.e * CAP + (rank < cnt ? rank : 0)]; rsv[ai][m] = rank < cnt ? v * (1.0f / SC_WGU) : 0.f; }
#pragma unroll
        for (int ai = 0; ai < 2; ++ai)
#pragma unroll
            for (int m = 0; m < 4; ++m) { const int r = ai * HALF + wr * 64 + m * 16 + fr;
                const float rs = rsv[ai][m];
                float o[8];
#pragma unroll
                for (int n = 0; n < 2; ++n)
#pragma unroll
                    for (int j = 0; j < 4; ++j) { const float g = acc[ai][0][m][n][j] * rs, uu = acc[ai][1][m][n][j] * rs; o[n * 4 + j] = SC_HB * g * uu * __builtin_amdgcn_rcpf(1.0f + __expf(-g)); }
                u32x2 w; w.x = pk4_fp8(o[0], o[1], o[2], o[3]); w.y = pk4_fp8(o[4], o[5], o[6], o[7]);
                *(u32x2*)(O + (size_t)(u.pm * BM + r) * DE + col0) = w; }
    }
};

template <class Epi, class Sched, int K, bool GATHER, bool ALIGN_EPI, bool SP2, bool FP8 = false>
__device__ __forceinline__ void gemm_phase(LAS unsigned char* lds, const Sched& S, const Epi& E, int wid) {
    const int lane = lane_id(), tid = wid * 64 + lane, wr = wid >> 2, wc = wid & 3, fr = lane & 15, fq = lane >> 4;
    constexpr int nt = K / BK;
    unsigned voffA[2], voffB[2];
#pragma unroll
    for (int i = 0; i < 2; ++i) { int R, C; stage_rc(tid * 16 + i * 8192, R, C); const int Rb = Epi::PERM ? ((R & ~31) + perm32(R & 31)) : R;
        voffA[i] = (unsigned)(R * K + C) * 2u; voffB[i] = (unsigned)(Rb * K + C) * 2u; }
    unsigned voffB2[2]; bool selC = false, selN = false;
    if constexpr (Epi::BSEL) {
#pragma unroll
        for (int i = 0; i < 2; ++i) { int R, C; stage_rc(tid * 16 + i * 8192, R, C); const int Rb = 64 * ((R >> 4) & 1) + 16 * (R >> 5) + (R & 15); voffB2[i] = (unsigned)(Rb * K + C) * 2u; }
    }
    constexpr size_t kstep = (size_t)(BK * 2);
    constexpr size_t hstep = (size_t)HALF * K * 2;
    const unsigned ldsw = (unsigned)wid * 1024u;
    const int aoff = lds_byte(wr * 64 + fr, fq * 8), boff = lds_byte(wc * 32 + fr, fq * 8);
    unsigned vC[2][2];
    LAS int* gtab = (LAS int*)(lds + (GT_OFF));
#define PG8_SA(b, h) (((b) * 2 + (h)) * HTB)
#define PG8_SB(b, h) ((4 + (b) * 2 + (h)) * HTB)
#define PG8_STAGE(bufoff, gbase, voff) do { _Pragma("unroll") for (int _i = 0; _i < 2; ++_i) \
        __builtin_amdgcn_global_load_lds((const unsigned*)((const char*)(gbase) + (voff)[_i]), (LAS unsigned*)(lds + (bufoff) + ldsw + _i * 8192), 16, 0, 0); } while (0)
#define PG8_STAGE_A(bufoff, gp, h, nx) do { if constexpr (GATHER) PG8_STAGE(bufoff, gp, vC[h]); else PG8_STAGE(bufoff, (gp) + (h) * hstep, voffA); } while (0)
#define PG8_SWITCH() do { if constexpr (GATHER) { if (last && has_next) { const int _cnt = S.count(nxt); _Pragma("unroll") for (int _i = 0; _i < 2; ++_i) { int _R, _C; stage_rc(tid * 16 + _i * 8192, _R, _C); \
        _Pragma("unroll") for (int _h = 0; _h < 2; ++_h) { const int _r = _h * 128 + _R; int _t; if constexpr (Sched::ident) _t = nxt.pm * 256 + _r; else { _t = gtab[_r]; _t = (nxt.ti * 256 + _r < _cnt) ? _t : 0; } vC[_h][_i] = ((unsigned)_t * (unsigned)K + (unsigned)_C) * 2u; } } } } } while (0)
#define PG8_STAGE_B(bufoff, gp, nx) do { if constexpr (Epi::BSEL) { const bool _s = (nx) ? selN : selC; if (_s) PG8_STAGE(bufoff, gp, voffB2); else PG8_STAGE(bufoff, gp, voffB); } else PG8_STAGE(bufoff, gp, voffB); } while (0)
#define PG8_LD8(p) __builtin_shufflevector(*(const LAS i32x4*)(p), *(const LAS i32x4*)((p) + 1024), 0, 1, 2, 3, 4, 5, 6, 7)
#define PG8_LDA(dst, b, h) do { _Pragma("unroll") for (int m = 0; m < 4; ++m) { if constexpr (FP8) dst##8[m] = PG8_LD8(lds + PG8_SA(b, h) + aoff + m * 2048); else { _Pragma("unroll") for (int k = 0; k < 2; ++k) dst[m][k] = *(const LAS bf16x8*)(lds + PG8_SA(b, h) + aoff + m * 2048 + k * 1024); } } } while (0)
#define PG8_LDB(dst, b, h) do { _Pragma("unroll") for (int n = 0; n < 2; ++n) { if constexpr (FP8) dst##8[n] = PG8_LD8(lds + PG8_SB(b, h) + boff + n * 2048); else { _Pragma("unroll") for (int k = 0; k < 2; ++k) dst[n][k] = *(const LAS bf16x8*)(lds + PG8_SB(b, h) + boff + n * 2048 + k * 1024); } } } while (0)
#define PG8_MMA(ai, bj, At, Bt) do { __builtin_amdgcn_s_setprio(1); _Pragma("unroll") for (int m = 0; m < 4; ++m) _Pragma("unroll") for (int n = 0; n < 2; ++n) { \
        if constexpr (FP8) acc[ai][bj][m][n] = __builtin_amdgcn_mfma_scale_f32_16x16x128_f8f6f4(Bt##8[n], At##8[m], acc[ai][bj][m][n], 0, 0, 0, 0x7f7f7f7f, 0, 0x7f7f7f7f); \
        else { _Pragma("unroll") for (int k = 0; k < 2; ++k) acc[ai][bj][m][n] = __builtin_amdgcn_mfma_f32_16x16x32_bf16(Bt[n][k], At[m][k], acc[ai][bj][m][n], 0, 0, 0); } } \
        __builtin_amdgcn_s_setprio(0); } while (0)
#define PG8_WAIT_V(n) asm volatile("s_waitcnt vmcnt(" #n ")" ::: "memory")
#define PG8_WAIT_L(n) asm volatile("s_waitcnt lgkmcnt(" #n ")" ::: "memory")
#define PG8_BAR __builtin_amdgcn_s_barrier()
#define PG8_SCHED __builtin_amdgcn_sched_barrier(0)
    Unit cur, nxt; int ui = 0;
    if (!S.next(0, cur)) return;
    f32x4 acc[2][2][4][2];
#pragma unroll
    for (int a = 0; a < 2; ++a)
#pragma unroll
        for (int b = 0; b < 2; ++b)
#pragma unroll
            for (int m = 0; m < 4; ++m)
#pragma unroll
                for (int n = 0; n < 2; ++n) acc[a][b][m][n] = (f32x4){0.f, 0.f, 0.f, 0.f};
    bf16x8 At[4][2], B0[2][2], B1[2][2]; i32x8 At8[4], B08[2], B18[2];
    const char* cA = S.a_ptr(cur); const char* cB = S.b_ptr(cur);
    if constexpr (GATHER) { S.gather(cur, tid, vC); }
    if constexpr (Epi::BSEL) selC = S.bsel(cur);
    if constexpr (SP2) {
        PG8_STAGE_B(PG8_SB(0, 0), cB, false); PG8_STAGE_B(PG8_SB(0, 1), cB + hstep, false); PG8_STAGE_A(PG8_SA(0, 0), cA, 0, false); PG8_STAGE_A(PG8_SA(0, 1), cA, 1, false);
        if (wr == 1) PG8_BAR;
        PG8_WAIT_V(2); PG8_BAR;
        PG8_STAGE_B(PG8_SB(1, 0), cB + kstep, false); PG8_STAGE_A(PG8_SA(1, 0), cA + kstep, 0, false); PG8_STAGE_B(PG8_SB(1, 1), cB + hstep + kstep, false);
        PG8_WAIT_V(6); PG8_BAR;
    } else {
        PG8_STAGE_B(PG8_SB(0, 0), cB, false); PG8_STAGE_A(PG8_SA(0, 0), cA, 0, false); PG8_STAGE_B(PG8_SB(0, 1), cB + hstep, false); PG8_STAGE_A(PG8_SA(0, 1), cA, 1, false);
        if (wr == 1) PG8_BAR;
        PG8_WAIT_V(4); PG8_BAR;
        PG8_STAGE_B(PG8_SB(1, 0), cB + kstep, false); PG8_STAGE_A(PG8_SA(1, 0), cA + kstep, 0, false); PG8_STAGE_B(PG8_SB(1, 1), cB + hstep + kstep, false);
        PG8_WAIT_V(6); PG8_BAR;
    }
    for (;;) {
        const bool has_next = S.next(ui + 1, nxt);
        const char* nA = has_next ? S.a_ptr(nxt) : cA; const char* nB = has_next ? S.b_ptr(nxt) : cB;
        if constexpr (Epi::BSEL) selN = has_next ? S.bsel(nxt) : selC;
        if constexpr (GATHER && !Sched::ident) { if (has_next && wid < 4) __builtin_amdgcn_global_load_lds((const unsigned*)(S.tok_ptr(nxt) + wid * 64 + lane), (LAS unsigned*)(gtab + wid * 64), 4, 0, 0); }
#pragma unroll 1
        for (int t = 0; t < nt; t += 2) {
            const bool last = (t == nt - 2);
            const char* a1 = cA + (size_t)(t + 1) * kstep;
            const char* a2 = last ? nA : cA + (size_t)(t + 2) * kstep; const char* b2 = last ? nB : cB + (size_t)(t + 2) * kstep;
            const char* a3 = a2 + kstep; const char* b3 = b2 + kstep;
            if constexpr (SP2) {
            PG8_LDB(B0, 0, 0); PG8_LDB(B1, 0, 1); PG8_SCHED; PG8_LDA(At, 0, 0); PG8_STAGE_A(PG8_SA(1, 1), a1, 1, false); PG8_SWITCH();
            PG8_WAIT_V(8); PG8_WAIT_L(0); PG8_BAR; PG8_MMA(0, 0, At, B0); PG8_MMA(0, 1, At, B1); PG8_BAR; PG8_SCHED;
            PG8_LDA(At, 0, 1); PG8_STAGE_B(PG8_SB(0, 0), b2, last); PG8_STAGE_B(PG8_SB(0, 1), b2 + hstep, last); PG8_STAGE_A(PG8_SA(0, 0), a2, 0, last);
            PG8_WAIT_V(8); PG8_WAIT_L(0); PG8_BAR; PG8_MMA(1, 0, At, B0); PG8_MMA(1, 1, At, B1); PG8_BAR; PG8_SCHED;
            PG8_LDB(B0, 1, 0); PG8_LDB(B1, 1, 1); PG8_SCHED; PG8_LDA(At, 1, 0); PG8_STAGE_A(PG8_SA(0, 1), a2, 1, last);
            PG8_WAIT_V(8); PG8_WAIT_L(0); PG8_BAR; PG8_MMA(0, 0, At, B0); PG8_MMA(0, 1, At, B1); PG8_BAR; PG8_SCHED;
            PG8_LDA(At, 1, 1); PG8_STAGE_B(PG8_SB(1, 0), b3, last); PG8_STAGE_B(PG8_SB(1, 1), b3 + hstep, last); PG8_STAGE_A(PG8_SA(1, 0), a3, 0, last);
            PG8_WAIT_V(8); PG8_WAIT_L(0); PG8_BAR; PG8_MMA(1, 0, At, B0); PG8_MMA(1, 1, At, B1); PG8_BAR; PG8_SCHED;
            } else {
            PG8_LDB(B0, 0, 0); PG8_SCHED; PG8_LDA(At, 0, 0); PG8_STAGE_A(PG8_SA(1, 1), a1, 1, false); PG8_SWITCH();
            PG8_WAIT_L(8); PG8_BAR; PG8_WAIT_L(0); PG8_MMA(0, 0, At, B0); PG8_BAR; PG8_SCHED;
            PG8_LDB(B1, 0, 1); PG8_STAGE_B(PG8_SB(0, 0), b2, last);
            PG8_BAR; PG8_WAIT_L(0); PG8_MMA(0, 1, At, B1); PG8_BAR;
            PG8_LDA(At, 0, 1); PG8_STAGE_A(PG8_SA(0, 0), a2, 0, last);
            PG8_BAR; PG8_WAIT_L(0); PG8_MMA(1, 0, At, B0); PG8_BAR; PG8_SCHED;
            PG8_STAGE_B(PG8_SB(0, 1), b2 + hstep, last);
            PG8_WAIT_V(6); PG8_BAR; PG8_MMA(1, 1, At, B1); PG8_BAR;
            PG8_LDB(B0, 1, 0); PG8_SCHED; PG8_LDA(At, 1, 0); PG8_STAGE_A(PG8_SA(0, 1), a2, 1, last);
            PG8_WAIT_L(8); PG8_BAR; PG8_WAIT_L(0); PG8_MMA(0, 0, At, B0); PG8_BAR; PG8_SCHED;
            PG8_LDB(B1, 1, 1); PG8_STAGE_B(PG8_SB(1, 0), b3, last);
            PG8_BAR; PG8_WAIT_L(0); PG8_MMA(0, 1, At, B1); PG8_BAR;
            PG8_LDA(At, 1, 1); PG8_STAGE_A(PG8_SA(1, 0), a3, 0, last);
            PG8_BAR; PG8_WAIT_L(0); PG8_MMA(1, 0, At, B0); PG8_BAR; PG8_SCHED;
            PG8_STAGE_B(PG8_SB(1, 1), b3 + hstep, last);
            PG8_WAIT_V(6); PG8_BAR; PG8_MMA(1, 1, At, B1); PG8_BAR;
            }
        }
        if constexpr (ALIGN_EPI) { if (wr == 0) PG8_BAR; }
        E(acc, cur, wr, wc, fr, fq);
        if (!has_next) break;
#pragma unroll
        for (int a = 0; a < 2; ++a)
#pragma unroll
            for (int b = 0; b < 2; ++b)
#pragma unroll
                for (int m = 0; m < 4; ++m)
#pragma unroll
                    for (int n = 0; n < 2; ++n) acc[a][b][m][n] = (f32x4){0.f, 0.f, 0.f, 0.f};
        cur = nxt; cA = nA; cB = nB; ++ui; selC = selN;
        if constexpr (ALIGN_EPI) { if (wr == 1) PG8_BAR; }
    }
    PG8_WAIT_V(0);
    if constexpr (!ALIGN_EPI) { if (wr == 0) PG8_BAR; }
    PG8_BAR;
#undef PG8_SA
#undef PG8_SB
#undef PG8_STAGE
#undef PG8_STAGE_A
#undef PG8_SWITCH
#undef PG8_STAGE_B
#undef PG8_LDA
#undef PG8_LDB
#undef PG8_MMA
#undef PG8_LD8
#undef PG8_WAIT_V
#undef PG8_WAIT_L
#undef PG8_BAR
#undef PG8_SCHED
}
}

#ifndef PG8_SP2
#define PG8_SP2 true
#endif
#ifndef PG8_ALIGN
#define PG8_ALIGN true
#endif

#define XB_TMO      128
#define XB_XCNT(j)  (256  + 64 * (j))
#define XB_XSUB(j)  (1280 + 64 * (j))
#define XB_XGEN(j)  (2304 + 64 * (j))
#define XB_TOP      3328
#define XB_TOPGEN   3392
#define XCD_BAR_WORDS 3456
#define XB_SPIN_CAP (1u << 18)
__device__ __forceinline__ unsigned xb_ld(unsigned* p)              { return __hip_atomic_load(p, __ATOMIC_RELAXED, __HIP_MEMORY_SCOPE_AGENT); }
__device__ __forceinline__ unsigned xb_add(unsigned* p, unsigned v) { return __hip_atomic_fetch_add(p, v, __ATOMIC_RELAXED, __HIP_MEMORY_SCOPE_AGENT); }
__device__ __forceinline__ unsigned xb_xcc_id() { return (unsigned)__builtin_amdgcn_s_getreg((3 << 11) | 20) & 0xFu; }
#define XB_SPIN(cond, bar) do { unsigned _sp = 0; while (cond) { __builtin_amdgcn_s_sleep(1); \
    if ((++_sp & 255u) == 0u) { if (xb_ld(&(bar)[XB_TMO])) break; if (_sp > XB_SPIN_CAP) { atomicAdd(&(bar)[XB_TMO], 1u); break; } } } } while (0)
struct XcdBarrier { unsigned* bar; unsigned x; volatile LAS unsigned* st; };
__device__ __forceinline__ XcdBarrier xcd_barrier_post(unsigned* bar, volatile LAS unsigned* st) {
    XcdBarrier b; b.bar = bar; b.x = xb_xcc_id(); b.st = st;
    if (threadIdx.x == 0) (void)xb_add(&bar[XB_XCNT(b.x)], 1u);
    return b;
}
__device__ __forceinline__ void xcd_barrier_complete(unsigned* bar, unsigned x, unsigned& nloc, unsigned& nx) {
    const unsigned G = gridDim.x * gridDim.y * gridDim.z;
    unsigned sum, cnt, mine, sp = 0u;
    for (;;) {
        sum = 0u; cnt = 0u; mine = 0u;
#pragma unroll
        for (unsigned j = 0; j < 16; ++j) { const unsigned c = xb_ld(&bar[XB_XCNT(j)]); sum += c; cnt += (c > 0u) ? 1u : 0u; mine = (j == x) ? c : mine; }
        if (sum == G) break;
        __builtin_amdgcn_s_sleep(1);
        if ((++sp & 255u) == 0u) { if (xb_ld(&bar[XB_TMO])) break; if (sp > XB_SPIN_CAP) { atomicAdd(&bar[XB_TMO], 1u); break; } }
    }
    nloc = mine > 0u ? mine : 1u; nx = cnt > 0u ? cnt : 1u;
}
__device__ __forceinline__ void xcd_barrier(const XcdBarrier& b) {
    asm volatile("s_waitcnt vmcnt(0)" ::: "memory");
    __syncthreads();
    if (threadIdx.x == 0) {
        unsigned* bar = b.bar;
        __builtin_amdgcn_s_waitcnt(0);
        unsigned nloc = b.st[0], nx = b.st[1];
        if (nloc == 0u) { xcd_barrier_complete(bar, b.x, nloc, nx); b.st[0] = nloc; b.st[1] = nx; }
        const unsigned old = xb_add(&bar[XB_XSUB(b.x)], 1u);
        const unsigned gen = old / nloc;
        if (old + 1u == (gen + 1u) * nloc) {
            __builtin_amdgcn_fence(__ATOMIC_RELEASE, "agent");
            asm volatile("s_waitcnt vmcnt(0)" ::: "memory");
            const unsigned og = xb_add(&bar[XB_TOP], 1u);
            const unsigned tg = og / nx;
            if (og + 1u == (tg + 1u) * nx) xb_add(&bar[XB_TOPGEN], 1u);
            else XB_SPIN(xb_ld(&bar[XB_TOPGEN]) == tg, bar);
            __builtin_amdgcn_fence(__ATOMIC_ACQUIRE, "agent");
            xb_add(&bar[XB_XGEN(b.x)], 1u);
            asm volatile("s_waitcnt vmcnt(0)" ::: "memory");
        } else {
            XB_SPIN(xb_ld(&bar[XB_XGEN(b.x)]) == gen, bar);
            __builtin_amdgcn_fence(__ATOMIC_ACQUIRE, "agent");
            asm volatile("s_waitcnt vmcnt(0)" ::: "memory");
        }
    }
    __syncthreads();
}

struct Frame {
    LAS unsigned char* lds;
    volatile LAS unsigned* MISC;
    unsigned* ctl;
    int wave, vcu, G;
    const float *x, *norm_mix_g, *w_in, *ret_norm_g, *conv_w, *conv_b, *w_rg, *b_rg, *w_ig, *b_ig, *lam, *lru_norm_g, *w_out, *norm_ffn_g,
                *w_group, *b_group, *w_router, *b_router, *w_gate, *w_up, *w_down, *norm_final_g;
    float* out;
    unsigned char* ws;
};

__device__ __forceinline__ unsigned offb(unsigned row, unsigned ch);
__device__ __forceinline__ bf16x8 tr_frag(LAS unsigned char* img, int lane, int c, int ks);
__device__ __forceinline__ bf16x8 tr_rows(LAS unsigned char* img, int lane, int c, int row0) {
    const unsigned q = (lane & 15) >> 2, p = lane & 3;
    const s16x4 a = __builtin_amdgcn_ds_read_tr16_b64_v4i16((LAS s16x4*)(img + offb(row0 + q, 2 * c + (p >> 1)) + 8 * (p & 1)));
    const s16x4 b = __builtin_amdgcn_ds_read_tr16_b64_v4i16((LAS s16x4*)(img + offb(row0 + 4 + q, 2 * c + (p >> 1)) + 8 * (p & 1)));
    bf16x8 r; r[0] = a[0]; r[1] = a[1]; r[2] = a[2]; r[3] = a[3]; r[4] = b[0]; r[5] = b[1]; r[6] = b[2]; r[7] = b[3]; return r;
}
template <bool F8, bool GK>
__device__ __forceinline__ void p0_transpose_item(const float* W, int N, int k0, int n0, void* WTrow0, int KoutB, const float* gk, float scale, LAS unsigned char* img, int lane) {
    const int l31 = lane & 31, lh = lane >> 5, l15 = lane & 15, g = lane >> 4;
    const float* src = W + (size_t)(k0 + lh) * N + n0 + 4 * l31;
#define P0_OUT(pass) do { LDS_WAIT(); asm volatile("" ::: "memory"); const int kk0 = k0 + 64 * (pass); \
        if constexpr (F8) { _Pragma("unroll") for (int c = 0; c < 8; ++c) { const u32x4 q0 = __builtin_bit_cast(u32x4, tr_rows(img, lane, c, 16 * g)), q1 = __builtin_bit_cast(u32x4, tr_rows(img, lane, c, 16 * g + 8)); \
            u32x4 o; o.x = pk4_fp8(bflo(q0.x), bfhi(q0.x), bflo(q0.y), bfhi(q0.y)); o.y = pk4_fp8(bflo(q0.z), bfhi(q0.z), bflo(q0.w), bfhi(q0.w)); \
            o.z = pk4_fp8(bflo(q1.x), bfhi(q1.x), bflo(q1.y), bfhi(q1.y)); o.w = pk4_fp8(bflo(q1.z), bfhi(q1.z), bflo(q1.w), bfhi(q1.w)); \
            *(u32x4*)((unsigned char*)WTrow0 + (size_t)(16 * c + l15) * KoutB + kk0 + 16 * g) = o; } } \
        else { _Pragma("unroll") for (int c = 0; c < 8; ++c) _Pragma("unroll") for (int ks = 0; ks < 2; ++ks) { const bf16x8 f = tr_frag(img, lane, c, ks); \
            *(bf16x8*)((unsigned char*)WTrow0 + (size_t)(16 * c + l15) * KoutB + 2 * (kk0 + 32 * ks + 8 * g)) = f; } } \
        LDS_WAIT(); asm volatile("" ::: "memory"); } while (0)
#pragma unroll 1
    for (int pass = 0; pass < 2; ++pass) {
#pragma unroll
        for (int half = 0; half < 2; ++half) {
            const int st = 2 * pass + half;
            f32x4 v[16]; float gs[16];
#pragma unroll
            for (int i = 0; i < 16; ++i) v[i] = __builtin_nontemporal_load((const f32x4*)(src + (size_t)(32 * st + 2 * i) * N));
#pragma unroll
            for (int i = 0; i < 16; ++i) gs[i] = GK ? gk[k0 + 32 * st + 2 * i + lh] * scale : scale;
#pragma unroll
            for (int i = 0; i < 16; ++i) { const int kl = 32 * half + 2 * i + lh; const f32x4 x = v[i] * gs[i];
                u32x2 w; w.x = pk2(x.x, x.y); w.y = pk2(x.z, x.w); *(LAS u32x2*)(img + offb(kl, l31 >> 1) + 8 * (l31 & 1)) = w; }
        }
        P0_OUT(pass);
    }
#undef P0_OUT
}
constexpr int I_G = (D / 128) * (DE / 128), I_DN = (DE / 128) * (D / 128), NQ_ITEMS = NE * (2 * I_G + I_DN);
__device__ __forceinline__ void convert_queue(Frame& F) {
    LAS unsigned char* scr = F.lds + F.wave * 16384;
    const int lane = lane_id();
    unsigned char* Wd8 = F.ws + WS_WD; unsigned char* Wgu8 = F.ws + WS_WGU;
    for (;;) {
        unsigned it = 0; if (lane == 0) it = atomicAdd(F.ctl + CW_Q, 1u);
        int r = __builtin_amdgcn_readfirstlane((int)it); if (r >= NQ_ITEMS) break;
        const int e = r / (2 * I_G + I_DN); r -= e * (2 * I_G + I_DN);
        if (r < 2 * I_G) { const int up = r >= I_G; if (up) r -= I_G; const int nblk = DE / 128, kb = r / nblk, nb = r % nblk;
            const float* W = (up ? F.w_up : F.w_gate) + (size_t)e * D * DE;
            unsigned char* row0 = Wgu8 + (size_t)e * D * D + (size_t)(256 * nb + 128 * up) * D;
            p0_transpose_item<true, true>(W, DE, 128 * kb, 128 * nb, row0, D, F.norm_ffn_g, SC_WGU, scr, lane); continue; }
        r -= 2 * I_G;
        { const int nblk = D / 128, kb = r / nblk, nb = r % nblk; p0_transpose_item<true, false>(F.w_down + (size_t)e * DE * D, D, 128 * kb, 128 * nb, Wd8 + (size_t)e * D * DE + (size_t)(128 * nb) * DE, DE, nullptr, SC_WD, scr, lane); }
    }
}
__device__ __forceinline__ void p0_prologue(Frame& F) {
    LAS unsigned char* scr = F.lds + F.wave * 16384;
    const int lane = lane_id(), tid = F.wave * 64 + lane;
    const int gw = F.wave * F.G + F.vcu, NGW = F.G * NWAVES;
    bf16_t* Win_t = (bf16_t*)(F.ws + WS_WIN); bf16_t* Wout_t = (bf16_t*)(F.ws + WS_WOUT);
    constexpr int I_IN = (D / 128) * (PROJ / 128), I_OUT = (D / 128) * (D / 128);
    constexpr int NITEMS = I_IN + I_OUT;
    for (int it = gw; it < NITEMS; it += NGW) {
        int r = it;
        if (r < I_IN) { const int nblk = PROJ / 128, kb = r / nblk, nb = r % nblk; p0_transpose_item<false, false>(F.w_in, PROJ, 128 * kb, 128 * nb, Win_t + (size_t)(128 * nb) * D, D * 2, nullptr, 1.0f, scr, lane); continue; } r -= I_IN;
        { const int nblk = D / 128, kb = r / nblk, nb = r % nblk; p0_transpose_item<false, false>(F.w_out, D, 128 * kb, 128 * nb, Wout_t + (size_t)(128 * nb) * D, D * 2, nullptr, 1.0f, scr, lane); }
    }
    bf16_t* Hb = (bf16_t*)(F.ws + WS_R1);
    for (int m = gw; m < T; m += 2 * NGW) {
        const int m2 = m + NGW < T ? m + NGW : m;
        const f32x4* xr = (const f32x4*)(F.x + (size_t)m * D) + lane; const f32x4* xr2 = (const f32x4*)(F.x + (size_t)m2 * D) + lane; const f32x4* gr = (const f32x4*)F.norm_mix_g + lane;
        f32x4 v[8], v2[8]; float s = 0.f, s2 = 0.f;
#pragma unroll
        for (int j = 0; j < 8; ++j) { v[j] = __builtin_nontemporal_load(xr + 64 * j); v2[j] = __builtin_nontemporal_load(xr2 + 64 * j); }
#pragma unroll
        for (int j = 0; j < 8; ++j) { s += (v[j].x * v[j].x + v[j].y * v[j].y) + (v[j].z * v[j].z + v[j].w * v[j].w); s2 += (v2[j].x * v2[j].x + v2[j].y * v2[j].y) + (v2[j].z * v2[j].z + v2[j].w * v2[j].w); }
        const float rs = 1.0f / sqrtf(wave_sum(s) * (1.0f / D) + EPS), rs2 = 1.0f / sqrtf(wave_sum(s2) * (1.0f / D) + EPS);
        u32x2* o = (u32x2*)(Hb + (size_t)m * D) + lane; u32x2* o2 = (u32x2*)(Hb + (size_t)m2 * D) + lane;
#pragma unroll
        for (int j = 0; j < 8; ++j) { const f32x4 g = gr[64 * j]; u32x2 w; w.x = pk2(v[j].x * rs * g.x, v[j].y * rs * g.y); w.y = pk2(v[j].z * rs * g.z, v[j].w * rs * g.w); o[64 * j] = w;
            u32x2 w2; w2.x = pk2(v2[j].x * rs2 * g.x, v2[j].y * rs2 * g.y); w2.y = pk2(v2[j].z * rs2 * g.z, v2[j].w * rs2 * g.w); o2[64 * j] = w2; }
    }
    const int gt = F.vcu * NTHREADS + tid, NGT = F.G * NTHREADS;
    float* rc = (float*)(F.ws + WS_ROPE); float* rsn = rc + SEQ * 64;
    for (int i = gt; i < SEQ * 64; i += NGT) { const int pos = i >> 6, f = i & 63; const float inv = powf(10000.0f, -(float)f / 64.0f); const float ang = (float)pos * inv; float sv, cv; sincosf(ang, &sv, &cv); rc[i] = cv; rsn[i] = sv; }
    bf16_t* whi = (bf16_t*)(F.ws + WS_WGT); bf16_t* wlo = whi + 48 * D;
    for (int i = gt; i < 48 * D; i += NGT) { const int n = i / D, k = i % D; float v = 0.f;
        if (n < 4) v = F.w_group[k * 4 + n]; else if (n < 36) v = F.w_router[k * 32 + (n - 4)];
        v *= F.norm_ffn_g[k]; const unsigned h = f2bf(v); const float hf = __builtin_bit_cast(float, h << 16); whi[i] = (bf16_t)h; wlo[i] = (bf16_t)f2bf(v - hf); }
}

__device__ __forceinline__ unsigned offb(unsigned row, unsigned ch) { return 256u * row + 16u * (ch ^ (((row & 3u) << 2) | ((row >> 2) & 3u))); }
__device__ __forceinline__ bf16x8 row_frag(LAS unsigned char* img, int lane, int rb, int s) { return *(const LAS bf16x8*)(img + offb((lane & 15) + 16 * rb, 4 * s + (lane >> 4))); }
__device__ __forceinline__ bf16x8 tr_frag(LAS unsigned char* img, int lane, int c, int ks) {
    const unsigned g = lane >> 4, q = (lane & 15) >> 2, p = lane & 3;
    const s16x4 a = __builtin_amdgcn_ds_read_tr16_b64_v4i16((LAS s16x4*)(img + offb(32 * ks + 8 * g + q, 2 * c + (p >> 1)) + 8 * (p & 1)));
    const s16x4 b = __builtin_amdgcn_ds_read_tr16_b64_v4i16((LAS s16x4*)(img + offb(32 * ks + 8 * g + 4 + q, 2 * c + (p >> 1)) + 8 * (p & 1)));
    bf16x8 r; r[0] = a[0]; r[1] = a[1]; r[2] = a[2]; r[3] = a[3]; r[4] = b[0]; r[5] = b[1]; r[6] = b[2]; r[7] = b[3]; return r;
}
#define MFMA16(a, b, c) __builtin_amdgcn_mfma_f32_16x16x32_bf16(a, b, c, 0, 0, 0)
__device__ __forceinline__ bf16x8 tr_frag2(LAS unsigned char* img, int lane, int c, int ks) {
    const unsigned g = lane >> 4, q = (lane & 15) >> 2, p = lane & 3;
    const s16x4 a = __builtin_amdgcn_ds_read_tr16_b64_v4i16((LAS s16x4*)(img + offb(32 * ks + 4 * g + q, 2 * c + (p >> 1)) + 8 * (p & 1)));
    const s16x4 b = __builtin_amdgcn_ds_read_tr16_b64_v4i16((LAS s16x4*)(img + offb(32 * ks + 16 + 4 * g + q, 2 * c + (p >> 1)) + 8 * (p & 1)));
    bf16x8 r; r[0] = a[0]; r[1] = a[1]; r[2] = a[2]; r[3] = a[3]; r[4] = b[0]; r[5] = b[1]; r[6] = b[2]; r[7] = b[3]; return r;
}
#define GLDS16(gsrc, ldst) __builtin_amdgcn_global_load_lds((const unsigned*)(gsrc), (LAS unsigned*)(ldst), 16, 0, 0)
#define RAW_BAR() do { asm volatile("s_waitcnt lgkmcnt(0)" ::: "memory"); __builtin_amdgcn_s_barrier(); asm volatile("" ::: "memory"); } while (0)
__device__ __forceinline__ void retention_unit(Frame& F, int b, int h) {
    LAS unsigned char* KI = F.lds; LAS unsigned char* VI0 = F.lds + 32768; LAS unsigned char* SI = F.lds + 98304;
    const int lane = lane_id(), w = F.wave, l15 = lane & 15, lg = lane >> 4;
    const int rtw = (w < 4) ? w : 11 - w;
    const float gC = expf(128.0f * log1pf(-exp2f(-5.0f - (float)h)));
    const bf16_t* proj = (const bf16_t*)(F.ws + WS_R2);
    bf16_t* mix = (bf16_t*)(F.ws + WS_R1);
    f32x4 accS[8];
#pragma unroll
    for (int c = 0; c < 8; ++c) accS[c] = (f32x4){0.f, 0.f, 0.f, 0.f};
    const int il = 16 * rtw + l15;
    unsigned dsrc[4];
#pragma unroll
    for (int i = 0; i < 4; ++i) { const unsigned row = 16 * w + 4 * i + lg; dsrc[i] = row * (HD * 2) + 16u * ((unsigned)l15 ^ (((row & 3u) << 2) | ((row >> 2) & 3u))); }
    const char* kbase = (const char*)(proj + ((size_t)(8 + h) * T + b * SEQ) * HD);
    const size_t vofs = (size_t)8 * T * HD * 2;
    const bf16_t* qbase = proj + ((size_t)h * T + b * SEQ + il) * HD + 8 * lg;
#define RET_DMA(img, base) do { _Pragma("unroll") for (int _i = 0; _i < 4; ++_i) GLDS16((base) + dsrc[_i], (img) + 4096 * w + 1024 * _i); } while (0)
    RET_DMA(KI, kbase); RET_DMA(VI0, kbase + vofs);
    u32x4 qn[4]; u32x2 ov[8];
#pragma unroll
    for (int s = 0; s < 4; ++s) qn[s] = *(const u32x4*)(qbase + 32 * s);
#pragma unroll
    for (int c = 0; c < 8; ++c) *(LAS u32x2*)(SI + offb(16 * c + l15, 2 * w + (lane >> 5)) + 8 * (lg & 1)) = (u32x2){0u, 0u};
#pragma unroll 1
    for (int n = 0; n < NCHUNK; ++n) {
        const int tok0 = b * SEQ + n * CHK;
        LAS unsigned char* VI = VI0 + (n & 1) * 32768;
        asm volatile("s_waitcnt vmcnt(0)" ::: "memory"); RAW_BAR();
        bf16x8 qf[4];
#pragma unroll
        for (int s = 0; s < 4; ++s) qf[s] = __builtin_bit_cast(bf16x8, qn[s]);
        const char* nk = kbase + (size_t)(n + 1) * (CHK * HD * 2);
        if (n + 1 < NCHUNK) {
            RET_DMA(VI0 + ((n + 1) & 1) * 32768, nk + vofs);
#pragma unroll
            for (int s = 0; s < 4; ++s) qn[s] = *(const u32x4*)(qbase + (size_t)(n + 1) * (CHK * HD) + 32 * s);
        }
        if (n > 0) { bf16_t* prow = mix + (size_t)(tok0 - CHK + il) * D + h * HD + 4 * lg;
#pragma unroll
            for (int c = 0; c < 8; ++c) *(u32x2*)(prow + 16 * c) = ov[c]; }
        u32x2 gv[8];
        { const bf16_t* grow = proj + ((size_t)(24 + h) * T + tok0 + il) * HD + 4 * lg;
#pragma unroll
          for (int c = 0; c < 8; ++c) gv[c] = *(const u32x2*)(grow + 16 * c); }
        bf16x8 pf[4];
#pragma unroll
        for (int s = 0; s < 4; ++s) {
            f32x4 sc[2];
#pragma unroll
            for (int t = 0; t < 2; ++t) { const int jt = 2 * s + t; sc[t] = (f32x4){0.f, 0.f, 0.f, 0.f};
#pragma unroll
                for (int k = 0; k < 4; ++k) sc[t] = MFMA16(row_frag(KI, lane, jt, k), qf[k], sc[t]);
                const int j0 = 16 * jt + 4 * lg;
#pragma unroll
                for (int r = 0; r < 4; ++r) sc[t][r] = (j0 + r > il) ? 0.f : sc[t][r]; }
            const u32x4 pw = (u32x4){pk2(sc[0][0], sc[0][1]), pk2(sc[0][2], sc[0][3]), pk2(sc[1][0], sc[1][1]), pk2(sc[1][2], sc[1][3])};
            pf[s] = __builtin_bit_cast(bf16x8, pw);
        }
        bf16x8 ktf[4];
#pragma unroll
        for (int s = 0; s < 4; ++s) ktf[s] = tr_frag2(KI, lane, w, s);
        RAW_BAR();
        if (n + 1 < NCHUNK) RET_DMA(KI, nk);
        f32x4 accO[8];
        bf16x8 vfr[2][4], sfr[2][4];
#pragma unroll
        for (int s = 0; s < 4; ++s) { vfr[0][s] = tr_frag2(VI, lane, 0, s); sfr[0][s] = row_frag(SI, lane, 0, s); }
#pragma unroll
        for (int c = 0; c < 8; ++c) {
            if (c < 7) {
#pragma unroll
                for (int s = 0; s < 4; ++s) { vfr[(c + 1) & 1][s] = tr_frag2(VI, lane, c + 1, s); sfr[(c + 1) & 1][s] = row_frag(SI, lane, c + 1, s); } }
            f32x4 o = (f32x4){0.f, 0.f, 0.f, 0.f};
#pragma unroll
            for (int s = 0; s < 4; ++s) o = MFMA16(vfr[c & 1][s], pf[s], o);
#pragma unroll
            for (int s = 0; s < 4; ++s) o = MFMA16(sfr[c & 1][s], qf[s], o);
            accO[c] = o;
#pragma unroll
            for (int s = 0; s < 4; ++s) accS[c] = MFMA16(ktf[s], vfr[c & 1][s], accS[c]);
            __builtin_amdgcn_sched_barrier(0);
        }
        {
            float s1 = 0.f;
#pragma unroll
            for (int c = 0; c < 8; ++c) s1 += (accO[c][0] + accO[c][1]) + (accO[c][2] + accO[c][3]);
            s1 += __shfl_xor(s1, 16); s1 += __shfl_xor(s1, 32);
            const float mu = s1 * (1.0f / 128.0f); float s2 = 0.f;
#pragma unroll
            for (int c = 0; c < 8; ++c) { const f32x4 d = accO[c] - mu; s2 += (d[0] * d[0] + d[1] * d[1]) + (d[2] * d[2] + d[3] * d[3]); }
            s2 += __shfl_xor(s2, 16); s2 += __shfl_xor(s2, 32);
            const float rstd = 1.0f / sqrtf(s2 * (1.0f / 128.0f) + EPS);
            const float* gn = F.ret_norm_g + h * HD + 4 * lg;
#pragma unroll
            for (int c = 0; c < 8; ++c) {
                const f32x4 gain = *(const f32x4*)(gn + 16 * c);
                const float g[4] = {bflo(gv[c].x), bfhi(gv[c].x), bflo(gv[c].y), bfhi(gv[c].y)}; float o[4];
#pragma unroll
                for (int r = 0; r < 4; ++r) o[r] = (accO[c][r] - mu) * rstd * gain[r] * g[r];
                ov[c].x = pk2(o[0], o[1]); ov[c].y = pk2(o[2], o[3]);
            }
        }
        RAW_BAR();
#pragma unroll
        for (int c = 0; c < 8; ++c) { accS[c] = accS[c] * gC; u32x2 wv; wv.x = pk2(accS[c][0], accS[c][1]); wv.y = pk2(accS[c][2], accS[c][3]);
            *(LAS u32x2*)(SI + offb(16 * c + l15, 2 * w + (lane >> 5)) + 8 * (lg & 1)) = wv; }
    }
    { bf16_t* prow = mix + (size_t)(b * SEQ + (NCHUNK - 1) * CHK + il) * D + h * HD + 4 * lg;
#pragma unroll
      for (int c = 0; c < 8; ++c) *(u32x2*)(prow + 16 * c) = ov[c]; }
    asm volatile("s_waitcnt vmcnt(0)" ::: "memory"); RAW_BAR();
#undef RET_DMA
}
template <int N> __device__ __forceinline__ float dpp_shr(float old, float src) {
    return __builtin_bit_cast(float, __builtin_amdgcn_update_dpp(__builtin_bit_cast(int, old), __builtin_bit_cast(int, src), 0x110 + N, 0xf, 0xf, false));
}
__device__ __forceinline__ float sigmoidf_(float x) { return __builtin_amdgcn_rcpf(1.0f + __expf(-x)); }
__device__ __forceinline__ float gelu_tanh(float z) { const float y2 = 1.5957691216057308f * (z + 0.044715f * z * z * z); return z * __builtin_amdgcn_rcpf(1.0f + __expf(-y2)); }
template <int N> __device__ __forceinline__ float dpp_shr0(float src) {
    return __builtin_bit_cast(float, __builtin_amdgcn_update_dpp(0, __builtin_bit_cast(int, src), 0x110 + N, 0xf, 0xf, true));
}
__device__ __forceinline__ float row_prefix_sum(float v) { v += dpp_shr0<1>(v); v += dpp_shr0<2>(v); v += dpp_shr0<4>(v); v += dpp_shr0<8>(v); return v; }
__device__ __forceinline__ void lru_unit(Frame& F, int b, int nb) {
    constexpr int RAWB = 132 * 256;
    LAS unsigned char* UI0 = F.lds; LAS unsigned char* RAW0 = F.lds + 65536; LAS float* PART = (LAS float*)(F.lds + 65536 + 2 * RAWB); LAS float* CW = PART + 1024;
    static_assert(65536 + 2 * RAWB + 4096 + 2560 <= LDSCTL_OFF, "LRU scratch below the LDS control words");
    const int lane = lane_id(), w = F.wave, tid = w * 64 + lane, l15 = lane & 15, lg = lane >> 4, cb = 128 * nb;
    const bf16_t* proj = (const bf16_t*)(F.ws + WS_R2);
    bf16_t* mix = (bf16_t*)(F.ws + WS_R1);
    const char* zline = (const char*)(F.ws + WS_CTL + 61440);
    const char* ubase = (const char*)(proj + ((size_t)(32 + nb) * T + b * SEQ) * HD);
#define LRU_DMA(n_, buf) do { _Pragma("unroll") for (int _i = 0; _i < 5; ++_i) { if (_i < 4 || w == 0) { const int _r = (_i < 4 ? 16 * w + 4 * _i : 128) + lg; int _pos = 128 * (n_) - 3 + _r; _pos = _pos > SEQ - 1 ? SEQ - 1 : _pos; \
        const char* _src = _pos < 0 ? zline + 16 * l15 : ubase + (size_t)_pos * (HD * 2) + 16 * (l15 ^ (_r & 15)); GLDS16(_src, (buf) + 256 * (_i < 4 ? 16 * w + 4 * _i : 128)); } } } while (0)
    const int sj = tid >> 2, sc0 = tid & 3;
#define LRU_CONV(RAW, UI) do { _Pragma("unroll") for (int q = 0; q < 4; ++q) { const int ch = sc0 + 4 * q; float a8[8]; \
            { const f32x4 b0 = *(const LAS f32x4*)(CW + 512 + 8 * ch), b1 = *(const LAS f32x4*)(CW + 512 + 8 * ch + 4); a8[0] = b0.x; a8[1] = b0.y; a8[2] = b0.z; a8[3] = b0.w; a8[4] = b1.x; a8[5] = b1.y; a8[6] = b1.z; a8[7] = b1.w; } \
            _Pragma("unroll") for (int k = 0; k < 4; ++k) { const int rr = sj + k; const u32x4 uv = *(const LAS u32x4*)((RAW) + 256 * rr + 16 * (ch ^ (rr & 15))); \
                const f32x4 w0 = *(const LAS f32x4*)(CW + k * 128 + 8 * ch), w1 = *(const LAS f32x4*)(CW + k * 128 + 8 * ch + 4); \
                a8[0] += w0.x * bflo(uv.x); a8[1] += w0.y * bfhi(uv.x); a8[2] += w0.z * bflo(uv.y); a8[3] += w0.w * bfhi(uv.y); \
                a8[4] += w1.x * bflo(uv.z); a8[5] += w1.y * bfhi(uv.z); a8[6] += w1.z * bflo(uv.w); a8[7] += w1.w * bfhi(uv.w); } \
            u32x4 o; o.x = pk2(a8[0], a8[1]); o.y = pk2(a8[2], a8[3]); o.z = pk2(a8[4], a8[5]); o.w = pk2(a8[6], a8[7]); \
            *(LAS u32x4*)((UI) + offb(sj, ch)) = o; } } while (0)
    LRU_DMA(0, RAW0);
    for (int i = tid; i < 640; i += NTHREADS) CW[i] = (i < 512) ? F.conv_w[(i >> 7) * 1024 + cb + (i & 127)] : F.conv_b[cb + i - 512];
    bf16x8 wrf[4], wif[4];
#pragma unroll
    for (int s = 0; s < 4; ++s)
#pragma unroll
        for (int jj = 0; jj < 8; ++jj) { const int c = 32 * s + 8 * lg + jj; const size_t o = ((size_t)(nb * 128 + c)) * 128 + 16 * w + l15;
            wrf[s][jj] = (short)f2bf(F.w_rg[o]); wif[s][jj] = (short)f2bf(F.w_ig[o]); }
    const int d0 = cb + 16 * w + 4 * lg;
    const f32x4 brg = *(const f32x4*)(F.b_rg + d0), big = *(const f32x4*)(F.b_ig + d0), lam = *(const f32x4*)(F.lam + d0), ng = *(const f32x4*)(F.lru_norm_g + d0);
    f32x4 sp;
#pragma unroll
    for (int r = 0; r < 4; ++r) sp[r] = 8.0f * log1pf(expf(-lam[r]));
    f32x4 Hc = (f32x4){0.f, 0.f, 0.f, 0.f};
    const bf16_t* zbase = proj + ((size_t)(40 + nb) * T + b * SEQ + l15) * HD + 16 * w + 4 * lg;
    bf16_t* obase = mix + (size_t)(b * SEQ + l15) * D + 1024 + d0;
    asm volatile("s_waitcnt vmcnt(0)" ::: "memory"); RAW_BAR();
    LRU_DMA(1, RAW0 + RAWB);
    LRU_CONV(RAW0, UI0);
    u32x2 zv[8];
#pragma unroll
    for (int tt = 0; tt < 8; ++tt) zv[tt] = *(const u32x2*)(zbase + (size_t)(16 * tt) * HD);
    RAW_BAR();
#pragma unroll 1
    for (int n = 0; n < NCHUNK; ++n) {
        LAS unsigned char* UI = UI0 + (n & 1) * 32768;
        f32x4 hv[8]; float ssq[8];
        f32x4 aR = (f32x4){0.f, 0.f, 0.f, 0.f}, aI = (f32x4){0.f, 0.f, 0.f, 0.f};
#pragma unroll
        for (int s = 0; s < 4; ++s) { const bf16x8 uf = row_frag(UI, lane, 0, s); aR = MFMA16(wrf[s], uf, aR); aI = MFMA16(wif[s], uf, aI); }
#pragma unroll
        for (int tt = 0; tt < 8; ++tt) {
            f32x4 aRn = (f32x4){0.f, 0.f, 0.f, 0.f}, aIn = (f32x4){0.f, 0.f, 0.f, 0.f};
            if (tt < 7) {
#pragma unroll
                for (int s = 0; s < 4; ++s) { const bf16x8 uf = row_frag(UI, lane, tt + 1, s); aRn = MFMA16(wrf[s], uf, aRn); aIn = MFMA16(wif[s], uf, aIn); } }
            const int dl = 16 * w + 4 * lg;
            const u32x2 ucv = *(const LAS u32x2*)(UI + offb(16 * tt + l15, dl >> 3) + (dl & 7) * 2);
            const float uc[4] = {bflo(ucv.x), bfhi(ucv.x), bflo(ucv.y), bfhi(ucv.y)};
            float q = 0.f;
#pragma unroll
            for (int r = 0; r < 4; ++r) {
                const float rg = sigmoidf_(aR[r] + brg[r]), ig = sigmoidf_(aI[r] + big[r]);
                const float L = -sp[r] * rg;
                const float P = row_prefix_sum(L);
                const float bx = __builtin_amdgcn_sqrtf(fmaxf(1.0f - __expf(2.0f * L), 0.f)) * ig * uc[r];
                float hh;
                if (__builtin_expect(__any(P < -40.0f), 0)) {
                    float A = __expf(L), B = bx;
                    { const float Ap = dpp_shr<1>(1.0f, A), Bp = dpp_shr<1>(0.0f, B); B = A * Bp + B; A = A * Ap; }
                    { const float Ap = dpp_shr<2>(1.0f, A), Bp = dpp_shr<2>(0.0f, B); B = A * Bp + B; A = A * Ap; }
                    { const float Ap = dpp_shr<4>(1.0f, A), Bp = dpp_shr<4>(0.0f, B); B = A * Bp + B; A = A * Ap; }
                    { const float Ap = dpp_shr<8>(1.0f, A), Bp = dpp_shr<8>(0.0f, B); B = A * Bp + B; A = A * Ap; }
                    hh = A * Hc[r] + B;
                } else {
                    const float E = __expf(P), Ei = __builtin_amdgcn_rcpf(E);
                    const float C = row_prefix_sum(bx * Ei);
                    hh = E * (Hc[r] + C);
                }
                Hc[r] = __shfl(hh, (lane & 48) | 15);
                hv[tt][r] = hh; q += hh * hh;
            }
            q += __shfl_xor(q, 16); q += __shfl_xor(q, 32);
            ssq[tt] = q; aR = aRn; aI = aIn;
            __builtin_amdgcn_sched_barrier(0);
        }
        if (lg == 0) {
#pragma unroll
            for (int tt = 0; tt < 8; ++tt) PART[w * 128 + 16 * tt + l15] = ssq[tt];
        }
        asm volatile("s_waitcnt vmcnt(0)" ::: "memory"); RAW_BAR();
#pragma unroll
        for (int tt = 0; tt < 8; ++tt) {
            const int tk = 16 * tt + l15; float tot = 0.f;
#pragma unroll
            for (int ww = 0; ww < 8; ++ww) tot += PART[ww * 128 + tk];
            const float rs = __builtin_amdgcn_rsqf(tot * (1.0f / 128.0f) + EPS);
            const float z[4] = {bflo(zv[tt].x), bfhi(zv[tt].x), bflo(zv[tt].y), bfhi(zv[tt].y)}; float o[4];
#pragma unroll
            for (int r = 0; r < 4; ++r) o[r] = hv[tt][r] * rs * ng[r] * z[r];
            u32x2 wv; wv.x = pk2(o[0], o[1]); wv.y = pk2(o[2], o[3]);
            *(u32x2*)(obase + (size_t)(n * CHK + 16 * tt) * D) = wv;
        }
        if (n + 1 < NCHUNK) {
            LRU_CONV(RAW0 + ((n + 1) & 1) * RAWB, UI0 + ((n + 1) & 1) * 32768);
#pragma unroll
            for (int tt = 0; tt < 8; ++tt) zv[tt] = *(const u32x2*)(zbase + (size_t)((n + 1) * CHK + 16 * tt) * HD);
        }
        RAW_BAR();
        if (n + 2 < NCHUNK) LRU_DMA(n + 2, RAW0 + (n & 1) * RAWB);
    }
    asm volatile("s_waitcnt vmcnt(0)" ::: "memory"); RAW_BAR();
#undef LRU_DMA
#undef LRU_CONV
}
__device__ __forceinline__ void router_phase(Frame& F) {
    const float* x1 = (const float*)(F.ws + WS_X1);
    unsigned char* h2 = F.ws + WS_H2;
    const bf16_t* whi = (const bf16_t*)(F.ws + WS_WGT);
    int* tokl = (int*)(F.ws + WS_TOK); float* rss = (float*)(F.ws + WS_RSS); u32x2* apk = (u32x2*)(F.ws + WS_APK); f32x2* aw = (f32x2*)(F.ws + WS_AW);
    const int w = F.wave, lane = lane_id(), l15 = lane & 15, lg = lane >> 4;
    LAS float* LG = (LAS float*)(F.lds + 65536 + w * 4096);
    LAS unsigned char* WB0 = F.lds;
    unsigned wsrc[3];
#pragma unroll
    for (int i = 0; i < 3; ++i) { const unsigned row = 4 * (3 * w + i) + lg; wsrc[i] = row * (D * 2) + 16u * ((unsigned)l15 ^ (row & 15u)); }
#define RT_DMA(kc, buf) do { _Pragma("unroll") for (int _i = 0; _i < 3; ++_i) GLDS16((const char*)whi + wsrc[_i] + (kc) * 256, (buf) + 1024 * (3 * w + _i)); } while (0)
    for (int base = F.vcu * NWAVES; base < T / 16; base += F.G * NWAVES) {
        const int item = base + w; const int r0 = item * 16;
        const float* xr = x1 + (size_t)(r0 + l15) * D + 8 * lg; unsigned char* hr = h2 + (size_t)(r0 + l15) * D + 8 * lg;
        f32x4 acc[3]; float ss = 0.f;
#pragma unroll
        for (int ct = 0; ct < 3; ++ct) acc[ct] = (f32x4){0.f, 0.f, 0.f, 0.f};
        f32x4 xa[8], xb[8];
        RT_DMA(0, WB0);
#pragma unroll
        for (int j = 0; j < 4; ++j) { xa[2 * j] = *(const f32x4*)(xr + 32 * j); xa[2 * j + 1] = *(const f32x4*)(xr + 32 * j + 4); }
#pragma unroll 1
        for (int kc = 0; kc < 16; ++kc) {
            LAS unsigned char* WB = WB0 + (kc & 1) * 24576;
            asm volatile("s_waitcnt vmcnt(0)" ::: "memory"); RAW_BAR();
            if (kc + 1 < 16) { RT_DMA(kc + 1, WB0 + ((kc + 1) & 1) * 24576); }
#pragma unroll
            for (int j = 0; j < 4; ++j) { xa[2 * j] = *(const f32x4*)(xr + 128 * kc + 32 * j); xa[2 * j + 1] = *(const f32x4*)(xr + 128 * kc + 32 * j + 4); }
#pragma unroll
            for (int j = 0; j < 4; ++j) {
                const f32x4 a0 = xa[2 * j], a1 = xa[2 * j + 1];
                ss += (a0.x * a0.x + a0.y * a0.y) + (a0.z * a0.z + a0.w * a0.w) + (a1.x * a1.x + a1.y * a1.y) + (a1.z * a1.z + a1.w * a1.w);
                const float av[8] = {a0.x, a0.y, a0.z, a0.w, a1.x, a1.y, a1.z, a1.w};
                unsigned hw[4], lw[4];
#pragma unroll
                for (int i = 0; i < 4; ++i) { hw[i] = pk2(av[2 * i], av[2 * i + 1]); lw[i] = pk2(av[2 * i] - bflo(hw[i]), av[2 * i + 1] - bfhi(hw[i])); }
                const u32x4 xh4 = (u32x4){hw[0], hw[1], hw[2], hw[3]}, xl4 = (u32x4){lw[0], lw[1], lw[2], lw[3]};
                *(u32x2*)(hr + 128 * kc + 32 * j) = (u32x2){pk4_fp8(av[0], av[1], av[2], av[3]), pk4_fp8(av[4], av[5], av[6], av[7])};
                const bf16x8 xh = __builtin_bit_cast(bf16x8, xh4), xl = __builtin_bit_cast(bf16x8, xl4);
#pragma unroll
                for (int ct = 0; ct < 3; ++ct) { const unsigned rh = 16 * ct + l15, rl = 48 + 16 * ct + l15;
                    const bf16x8 bh = *(const LAS bf16x8*)(WB + 256 * rh + 16 * ((4 * j + lg) ^ (rh & 15))), bl = *(const LAS bf16x8*)(WB + 256 * rl + 16 * ((4 * j + lg) ^ (rl & 15)));
                    acc[ct] = MFMA16(xh, bh, acc[ct]); acc[ct] = MFMA16(xh, bl, acc[ct]); acc[ct] = MFMA16(xl, bh, acc[ct]); }
            }
        }
        ss += __shfl_xor(ss, 16); ss += __shfl_xor(ss, 32);
#pragma unroll
        for (int ct = 0; ct < 3; ++ct)
#pragma unroll
            for (int r = 0; r < 4; ++r) LG[(4 * lg + r) * 48 + 16 * ct + l15] = acc[ct][r];
        LDS_WAIT();
        if (lane < 16) {
            const int t = r0 + lane; const float rs = 1.0f / sqrtf(ss * (1.0f / D) + EPS);
            const LAS float* L = LG + lane * 48;
            float gl[4];
#pragma unroll
            for (int j = 0; j < 4; ++j) gl[j] = L[j] * rs + F.b_group[j];
            int g = 0; float gm = gl[0];
#pragma unroll
            for (int j = 1; j < 4; ++j) if (gl[j] > gm) { gm = gl[j]; g = j; }
            float den = 0.f;
#pragma unroll
            for (int j = 0; j < 4; ++j) den += expf(gl[j] - gm);
            const float gp = 1.0f / den;
            float v[8];
#pragma unroll
            for (int q = 0; q < 8; ++q) v[q] = L[4 + 8 * g + q] * rs + F.b_router[8 * g + q];
            int ia = 0; float va = v[0];
#pragma unroll
            for (int q = 1; q < 8; ++q) if (v[q] > va) { va = v[q]; ia = q; }
            int ib = -1; float vb = -3.0e38f;
#pragma unroll
            for (int q = 0; q < 8; ++q) if (q != ia && v[q] > vb) { vb = v[q]; ib = q; }
            const float wa = 1.0f / (1.0f + expf(vb - va)), wb = 1.0f - wa;
            const int ea = 8 * g + ia, eb = 8 * g + ib;
            const unsigned ra = atomicAdd(F.ctl + CW_CNT + 64 * ea, 1u), rb = atomicAdd(F.ctl + CW_CNT + 64 * eb, 1u);
            tokl[(size_t)ea * CAP + ra] = t; tokl[(size_t)eb * CAP + rb] = t; rss[(size_t)ea * CAP + ra] = rs; rss[(size_t)eb * CAP + rb] = rs;
            apk[t] = (u32x2){((unsigned)ea << 16) | ra, ((unsigned)eb << 16) | rb}; aw[t] = (f32x2){wa * gp, wb * gp};
        }
        LDS_WAIT();
    }
#undef RT_DMA
}
__device__ __forceinline__ void compute_tile_start(Frame& F) {
    LAS int* ts = (LAS int*)(F.lds + TS_OFF); LAS int* cn = (LAS int*)(F.lds + CN_OFF);
    const int tid = F.wave * 64 + lane_id();
    if (tid < NE) { int c = (int)__hip_atomic_load(F.ctl + CW_CNT + 64 * tid, __ATOMIC_RELAXED, __HIP_MEMORY_SCOPE_AGENT); cn[tid] = c < 0 ? 0 : (c > CAP ? CAP : c); }
    __syncthreads();
    if (tid == 0) { int a = 0; for (int e = 0; e < NE; ++e) { ts[e] = a; a += (cn[e] + 255) >> 8; } ts[NE] = a > MAXRT ? MAXRT : a; }
    __syncthreads();
    if (tid < MAXRT) { int e = 0; for (int j = 1; j < NE; ++j) e = (ts[j] <= tid) ? j : e; ((LAS unsigned char*)(F.lds + RE_OFF))[tid] = (unsigned char)e; }
    __syncthreads();
}
__device__ __forceinline__ void combine_phase(Frame& F) {
    const float* x1 = (const float*)(F.ws + WS_X1); const unsigned char* Y = F.ws + WS_Y;
    const u32x2* apk = (const u32x2*)(F.ws + WS_APK); const f32x2* aw = (const f32x2*)(F.ws + WS_AW);
    const LAS int* ts = (const LAS int*)(F.lds + TS_OFF);
    const int gw = F.vcu * NWAVES + F.wave, NGW = F.G * NWAVES, lane = lane_id();
    int m = gw; if (m >= T) return;
    u32x2 pk[2]; f32x2 ww[2];
#pragma unroll
    for (int r = 0; r < 2; ++r) { const int mr = m + r * NGW < T ? m + r * NGW : m; pk[r] = apk[mr]; ww[r] = aw[mr]; }
    for (; m < T; m += 2 * NGW) {
        f32x4 a0[2][4], a1[2][4]; u32x2 p[2][4], q[2][4]; float w0[2], w1[2]; int mr[2];
#pragma unroll
        for (int r = 0; r < 2; ++r) {
            mr[r] = m + r * NGW < T ? m + r * NGW : m;
            const int e0 = (pk[r].x >> 16) & 31, e1 = (pk[r].y >> 16) & 31;
            const size_t row0 = (size_t)256 * ts[e0] + (pk[r].x & 0xffffu), row1 = (size_t)256 * ts[e1] + (pk[r].y & 0xffffu);
            w0[r] = ww[r].x * (1.0f / SC_Y); w1[r] = ww[r].y * (1.0f / SC_Y);
            const float* xr = x1 + (size_t)mr[r] * D + 8 * lane; const unsigned char* y0 = Y + row0 * D + 8 * lane; const unsigned char* y1 = Y + row1 * D + 8 * lane;
#pragma unroll
            for (int j = 0; j < 4; ++j) { a0[r][j] = *(const f32x4*)(xr + 512 * j); a1[r][j] = *(const f32x4*)(xr + 512 * j + 4); p[r][j] = *(const u32x2*)(y0 + 512 * j); q[r][j] = *(const u32x2*)(y1 + 512 * j); }
        }
#pragma unroll
        for (int r = 0; r < 2; ++r) { const int mn = m + (2 + r) * NGW < T ? m + (2 + r) * NGW : mr[r]; pk[r] = apk[mn]; ww[r] = aw[mn]; }
#pragma unroll
        for (int r = 0; r < 2; ++r) {
            float v[4][8]; float ss = 0.f;
#pragma unroll
            for (int j = 0; j < 4; ++j) {
                const f32x2 p0 = __builtin_amdgcn_cvt_pk_f32_fp8((int)p[r][j].x, false), p1 = __builtin_amdgcn_cvt_pk_f32_fp8((int)p[r][j].x, true), p2 = __builtin_amdgcn_cvt_pk_f32_fp8((int)p[r][j].y, false), p3 = __builtin_amdgcn_cvt_pk_f32_fp8((int)p[r][j].y, true);
                const f32x2 q0 = __builtin_amdgcn_cvt_pk_f32_fp8((int)q[r][j].x, false), q1 = __builtin_amdgcn_cvt_pk_f32_fp8((int)q[r][j].x, true), q2 = __builtin_amdgcn_cvt_pk_f32_fp8((int)q[r][j].y, false), q3 = __builtin_amdgcn_cvt_pk_f32_fp8((int)q[r][j].y, true);
                v[j][0] = a0[r][j].x + w0[r] * p0.x + w1[r] * q0.x; v[j][1] = a0[r][j].y + w0[r] * p0.y + w1[r] * q0.y;
                v[j][2] = a0[r][j].z + w0[r] * p1.x + w1[r] * q1.x; v[j][3] = a0[r][j].w + w0[r] * p1.y + w1[r] * q1.y;
                v[j][4] = a1[r][j].x + w0[r] * p2.x + w1[r] * q2.x; v[j][5] = a1[r][j].y + w0[r] * p2.y + w1[r] * q2.y;
                v[j][6] = a1[r][j].z + w0[r] * p3.x + w1[r] * q3.x; v[j][7] = a1[r][j].w + w0[r] * p3.y + w1[r] * q3.y;
#pragma unroll
                for (int i = 0; i < 8; ++i) ss += v[j][i] * v[j][i];
            }
            const float rs = 1.0f / sqrtf(wave_sum(ss) * (1.0f / D) + EPS);
            if (r == 0 || m + NGW < T) {
                float* orow = F.out + (size_t)mr[r] * D + 8 * lane; const float* gf = F.norm_final_g + 8 * lane;
#pragma unroll
                for (int j = 0; j < 4; ++j) { const f32x4 g0 = *(const f32x4*)(gf + 512 * j), g1 = *(const f32x4*)(gf + 512 * j + 4);
                    *(f32x4*)(orow + 512 * j) = (f32x4){v[j][0] * rs * g0.x, v[j][1] * rs * g0.y, v[j][2] * rs * g0.z, v[j][3] * rs * g0.w};
                    *(f32x4*)(orow + 512 * j + 4) = (f32x4){v[j][4] * rs * g1.x, v[j][5] * rs * g1.y, v[j][6] * rs * g1.z, v[j][7] * rs * g1.w}; }
            }
        }
    }
}
__device__ __forceinline__ void final_norm_only(Frame& F, const float* src) {
    const int gw = F.vcu * NWAVES + F.wave, NGW = F.G * NWAVES, lane = lane_id();
    for (int m = gw; m < T; m += NGW) {
        const f32x4* xr = (const f32x4*)(src + (size_t)m * D) + lane; const f32x4* gr = (const f32x4*)F.norm_final_g + lane;
        f32x4 v[8]; float s = 0.f;
#pragma unroll
        for (int j = 0; j < 8; ++j) { v[j] = xr[64 * j]; s += (v[j].x * v[j].x + v[j].y * v[j].y) + (v[j].z * v[j].z + v[j].w * v[j].w); }
        const float rs = 1.0f / sqrtf(wave_sum(s) * (1.0f / D) + EPS);
        f32x4* o = (f32x4*)(F.out + (size_t)m * D) + lane;
#pragma unroll
        for (int j = 0; j < 8; ++j) { const f32x4 g = gr[64 * j]; o[64 * j] = (f32x4){v[j].x * rs * g.x, v[j].y * rs * g.y, v[j].z * rs * g.z, v[j].w * rs * g.w}; }
    }
}

struct Args { const float* in[22]; float* out; unsigned char* ws; int ph_lo, ph_hi, li, pad; };
__global__ void __launch_bounds__(NTHREADS, 2) hymba_fwd(Args args) {
    extern __shared__ __attribute__((aligned(16))) unsigned char lds[];
    Frame F;
    F.lds = (LAS unsigned char*)lds;
    F.MISC = (volatile LAS unsigned*)(F.lds + MISC_OFF);
    F.wave = __builtin_amdgcn_readfirstlane(threadIdx.x >> 6);
    F.G = gridDim.x; { const int bx = blockIdx.x; F.vcu = (F.G % 8 == 0) ? (bx % 8) * (F.G / 8) + bx / 8 : bx; }
    unsigned char* ws = args.ws; F.ws = ws; F.ctl = (unsigned*)(ws + WS_CTL); F.out = args.out;
    F.x = args.in[0]; F.norm_mix_g = args.in[1]; F.w_in = args.in[2]; F.ret_norm_g = args.in[3]; F.conv_w = args.in[4]; F.conv_b = args.in[5]; F.w_rg = args.in[6]; F.b_rg = args.in[7];
    F.w_ig = args.in[8]; F.b_ig = args.in[9]; F.lam = args.in[10]; F.lru_norm_g = args.in[11]; F.w_out = args.in[12]; F.norm_ffn_g = args.in[13]; F.w_group = args.in[14]; F.b_group = args.in[15];
    F.w_router = args.in[16]; F.b_router = args.in[17]; F.w_gate = args.in[18]; F.w_up = args.in[19]; F.w_down = args.in[20]; F.norm_final_g = args.in[21];
    for (int u = threadIdx.x; u < (LDS_BYTES - LDSCTL_OFF) / 4; u += NTHREADS) ((LAS unsigned*)(F.lds + LDSCTL_OFF))[u] = 0u;
    __syncthreads();
    const int lo = args.ph_lo, hi = args.ph_hi;
    XcdBarrier bar; bar.bar = F.ctl + CW_BAR; bar.x = 0; bar.st = nullptr;
    if (hi - lo > 1) bar = xcd_barrier_post(F.ctl + CW_BAR, F.MISC + 8);
#define IN(k) (lo <= (k) && (k) < hi)
#define BOTH(k) (IN(k) && IN((k) + 1))
#define GRID_BAR() xcd_barrier(bar)

    if (IN(0)) { p0_prologue(F); if (BOTH(0)) GRID_BAR(); }
    if (IN(1)) {
        const int G1 = (F.G > 2 * NCONV) ? F.G - NCONV : F.G;
        if ((int)blockIdx.x < G1) {
        pg8::DenseSched<D, T / 256, PROJ / 256, true, true> S; S.so.init(T, PROJ, G1, (int)blockIdx.x); S.A = (const char*)(ws + WS_R1); S.B = (const char*)(ws + WS_WIN);
        pg8::EpiProj E{(bf16_t*)(ws + WS_R2), PROJ, (const float*)(ws + WS_ROPE), (const float*)(ws + WS_ROPE) + SEQ * 64};
        pg8::gemm_phase<pg8::EpiProj, pg8::DenseSched<D, T / 256, PROJ / 256, true, true>, D, true, PG8_ALIGN, PG8_SP2>(F.lds, S, E, F.wave);
        }
        convert_queue(F);
        if (BOTH(1)) GRID_BAR();
    }
    if (IN(2)) {
        for (int u = (int)blockIdx.x; u < 128; u += F.G) retention_unit(F, u >> 3, u & 7);
        for (int u = (int)((blockIdx.x + (unsigned)F.G - (128u % (unsigned)F.G)) % (unsigned)F.G); u < 128; u += F.G) lru_unit(F, u >> 3, u & 7);
        if (BOTH(2)) GRID_BAR();
    }
    if (IN(3)) {
        pg8::DenseSched<D, T / 256, D / 256, false, true> S; S.so.init(T, D, F.G, (int)blockIdx.x); S.A = (const char*)(ws + WS_R1); S.B = (const char*)(ws + WS_WOUT);
        pg8::EpiF32Res E{F.x, (float*)(ws + WS_X1), D};
        pg8::gemm_phase<pg8::EpiF32Res, pg8::DenseSched<D, T / 256, D / 256, false, true>, D, true, PG8_ALIGN, PG8_SP2>(F.lds, S, E, F.wave);
        if (BOTH(3)) GRID_BAR();
    }
#if MK_LAST_PHASE <= 4
    if (IN(4)) { final_norm_only(F, (const float*)(ws + WS_X1)); }
#else
    if (IN(4)) { router_phase(F); if (BOTH(4)) GRID_BAR(); }
    if (IN(5)) {
        compute_tile_start(F);
        const LAS int* ts = (const LAS int*)(F.lds + TS_OFF); const LAS int* cn = (const LAS int*)(F.lds + CN_OFF);
        pg8::MoeSched<D / 2, true> S; S.G = F.G; S.c = (int)blockIdx.x; S.nrt = __builtin_amdgcn_readfirstlane(ts[NE]); S.ts = ts; S.cn = cn;
        S.A = (const char*)(ws + WS_H2); S.B = (const char*)(ws + WS_WGU); S.bstride = (size_t)D * D; S.tok = (const int*)(ws + WS_TOK);
        pg8::EpiSwiGLU E{ws + WS_R1, (const float*)(ws + WS_RSS), cn};
        pg8::gemm_phase<pg8::EpiSwiGLU, pg8::MoeSched<D / 2, true>, D / 2, true, PG8_ALIGN, PG8_SP2, true>(F.lds, S, E, F.wave);
        if (BOTH(5)) GRID_BAR();
    }
    if (IN(6)) {
        compute_tile_start(F);
        const LAS int* ts = (const LAS int*)(F.lds + TS_OFF); const LAS int* cn = (const LAS int*)(F.lds + CN_OFF);
        pg8::MoeSched<DE / 2, true, true> S; S.G = F.G; S.c = (int)blockIdx.x; S.nrt = __builtin_amdgcn_readfirstlane(ts[NE]); S.ts = ts; S.cn = cn;
        S.A = (const char*)(ws + WS_R1); S.B = (const char*)(ws + WS_WD); S.bstride = (size_t)D * DE; S.tok = nullptr;
        pg8::EpiFp8 E{ws + WS_Y, D, SC_Y / (SC_HB * SC_WD)};
        pg8::gemm_phase<pg8::EpiFp8, pg8::MoeSched<DE / 2, true, true>, DE / 2, true, PG8_ALIGN, PG8_SP2, true>(F.lds, S, E, F.wave);
        if (BOTH(6)) GRID_BAR();
    }
    if (IN(7)) { compute_tile_start(F); combine_phase(F); }
#endif
#undef IN
#undef BOTH
#undef GRID_BAR
}

extern "C" void kernel_launch(void* const* d_in, const int* in_sizes, int n_in, void* d_out, int out_size, void* d_ws, size_t ws_size, hipStream_t stream) {
    static int grid = 0;
    if (grid == 0) {
        if (n_in != 22 || in_sizes[0] != T * D || out_size != T * D || ws_size < WS_END) { fprintf(stderr, "kernel_launch: unexpected shapes (n_in %d, in0 %d, out %d, ws %zu < %zu); nothing launched\n", n_in, n_in > 0 ? in_sizes[0] : -1, out_size, ws_size, (size_t)WS_END); grid = -1; return; }
        int dev = 0, cus = 0, per_cu = 0;
        if (hipGetDevice(&dev) != hipSuccess || hipDeviceGetAttribute(&cus, hipDeviceAttributeMultiprocessorCount, dev) != hipSuccess) { grid = -1; return; }
        if (hipFuncSetAttribute((const void*)hymba_fwd, hipFuncAttributeMaxDynamicSharedMemorySize, LDS_BYTES) != hipSuccess) { fprintf(stderr, "kernel_launch: hipFuncSetAttribute failed\n"); grid = -1; return; }
        if (hipOccupancyMaxActiveBlocksPerMultiprocessor(&per_cu, (const void*)hymba_fwd, NTHREADS, LDS_BYTES) != hipSuccess || per_cu < 1) { fprintf(stderr, "kernel_launch: occupancy query reports %d blocks per CU\n", per_cu); }
        (void)hipGetLastError();
        grid = cus;
    }
    if (grid < 0) return;
    if (hipMemsetAsync((char*)d_ws + WS_CTL, 0, CTL_ZERO_BYTES, stream) != hipSuccess) return;
    Args a{};
    for (int i = 0; i < 22; ++i) a.in[i] = (const float*)d_in[i];
    a.out = (float*)d_out; a.ws = (unsigned char*)d_ws;
    constexpr int NL = MK_N_LAUNCHES;
    constexpr int LASTP = (MK_LAST_PHASE <= 4) ? 5 : NPHASES;
    if (NL == 1) { a.ph_lo = 0; a.ph_hi = LASTP; a.li = 0; hipLaunchKernelGGL(hymba_fwd, dim3(grid), dim3(NTHREADS), LDS_BYTES, stream, a); }
    else for (int li = 0; li < LASTP; ++li) { a.ph_lo = li; a.ph_hi = li + 1; a.li = li; hipLaunchKernelGGL(hymba_fwd, dim3(grid), dim3(NTHREADS), LDS_BYTES, stream, a);
        if (li == MK_REPEAT_PHASE) hipLaunchKernelGGL(hymba_fwd, dim3(grid), dim3(NTHREADS), LDS_BYTES, stream, a); }
}
```

```cpp
#include <hip/hip_runtime.h>
#include <cstdio>
#include <cstdint>

#ifndef MK_N_LAUNCHES
#define MK_N_LAUNCHES 1
#endif
#ifndef MK_REPEAT_PHASE
#define MK_REPEAT_PHASE -1
#endif
#ifndef MK_LAST_PHASE
#define MK_LAST_PHASE 8
#endif

#define GAS __attribute__((address_space(1)))
#define LAS __attribute__((address_space(3)))
typedef unsigned short bf16_t;
typedef short bf16x8 __attribute__((ext_vector_type(8)));
typedef short s16x4 __attribute__((ext_vector_type(4)));
typedef float f32x4 __attribute__((ext_vector_type(4)));
typedef float f32x2 __attribute__((ext_vector_type(2)));
typedef unsigned u32x4 __attribute__((ext_vector_type(4)));
typedef unsigned u32x2 __attribute__((ext_vector_type(2)));
typedef GAS unsigned gu32;
typedef int i32x4 __attribute__((ext_vector_type(4)));
typedef int i32x8 __attribute__((ext_vector_type(8)));
constexpr float SC_WGU = 64.0f, SC_WD = 32.0f, SC_HB = 4.0f, SC_Y = 16.0f;

constexpr int T = 32768, D = 2048, SEQ = 2048, NBATCH = 16, PROJ = 6144;
constexpr int NH = 8, HD = 128, CHK = 128, NCHUNK = SEQ / CHK;
constexpr int NLB = 8;
constexpr int NE = 32, DE = 1024;
constexpr int CAP = 32768;
constexpr int MAXRT = 288;
constexpr float EPS = 1e-6f;
constexpr int NWAVES = 8, NTHREADS = 512;
constexpr int NPHASES = 8;

constexpr size_t MiB = 1u << 20;
constexpr size_t WS_CTL = 0, CTL_ZERO_BYTES = 65536;
constexpr size_t WS_TOK = 1 * MiB;
constexpr size_t WS_RSS = 5 * MiB;
constexpr size_t WS_APK = 9 * MiB;
constexpr size_t WS_AW  = 9 * MiB + 512 * 1024;
constexpr size_t WS_ROPE = 10 * MiB;
constexpr size_t WS_WGT = 11 * MiB;
constexpr size_t WS_WIN = 12 * MiB;
constexpr size_t WS_WOUT = 36 * MiB;
constexpr size_t WS_WD = 44 * MiB;
constexpr size_t WS_WGU = 172 * MiB;
constexpr size_t WS_R2 = 428 * MiB;
constexpr size_t WS_H2 = WS_R2, WS_X1 = WS_R2 + 128 * MiB;
constexpr size_t WS_R1 = 812 * MiB;
constexpr size_t WS_Y = WS_WGU;
constexpr size_t WS_END = 956 * MiB;
static_assert(WS_Y + (size_t)MAXRT * 256 * 2048 * 2 <= WS_X1, "y overlays Wgu + h2 only");
static_assert(WS_R1 + (size_t)MAXRT * 256 * 1024 * 2 <= WS_END, "hb fits");
constexpr int CW_BAR = 1024;
constexpr int CW_CNT = 8192;
constexpr int CW_Q = 6144;
constexpr int NCONV = 32;

constexpr int RING_BYTES = 131072;
constexpr int LDSCTL_OFF = 143360, MISC_OFF = LDSCTL_OFF + 320;
constexpr int TS_OFF = LDSCTL_OFF + 1024;
constexpr int CN_OFF = LDSCTL_OFF + 1280;
constexpr int RE_OFF = LDSCTL_OFF + 1536;
constexpr int GT_OFF = LDSCTL_OFF + 2048;
constexpr int LDS_BYTES = 147456;

#define LDS_WAIT() asm volatile("s_waitcnt lgkmcnt(0)" ::: "memory")
#define VM_WAIT() asm volatile("s_waitcnt vmcnt(0)" ::: "memory")
__device__ __forceinline__ unsigned f2bf(float f) { unsigned u = __builtin_bit_cast(unsigned, f); return (u + 0x7fffu + ((u >> 16) & 1u)) >> 16; }
typedef __bf16 hwbf16x2 __attribute__((ext_vector_type(2)));
__device__ __forceinline__ unsigned pk2(float lo, float hi) { const f32x2 v = {lo, hi}; return __builtin_bit_cast(unsigned, __builtin_convertvector(v, hwbf16x2)); }
__device__ __forceinline__ float bflo(unsigned w) { return __builtin_bit_cast(float, w << 16); }
__device__ __forceinline__ float bfhi(unsigned w) { return __builtin_bit_cast(float, w & 0xffff0000u); }
__device__ __forceinline__ float sat8(float x) { return __builtin_amdgcn_fmed3f(x, -448.0f, 448.0f); }
__device__ __forceinline__ unsigned pk4_fp8(float a, float b, float c, float d) { int p = 0; a = sat8(a); b = sat8(b); c = sat8(c); d = sat8(d); p = __builtin_amdgcn_cvt_pk_fp8_f32(a, b, p, false); p = __builtin_amdgcn_cvt_pk_fp8_f32(c, d, p, true); return (unsigned)p; }
__device__ __forceinline__ unsigned cvt_pk_bf16(float lo, float hi) { unsigned r; asm volatile("v_cvt_pk_bf16_f32 %0, %1, %2" : "=v"(r) : "v"(lo), "v"(hi)); return r; }
__device__ __forceinline__ int lane_id() { int l; asm volatile("v_mbcnt_lo_u32_b32 %0, -1, 0\n\tv_mbcnt_hi_u32_b32 %0, -1, %0" : "=v"(l)); return l; }
__device__ __forceinline__ float wave_sum(float v) {
#pragma unroll
    for (int o = 1; o < 64; o <<= 1) v += __shfl_xor(v, o);
    return v;
}

namespace pg8 {
constexpr int BM = 256, BK = 64, HALF = 128, HTB = HALF * BK * 2, STAGE_BYTES = 8 * HTB, NXCD = 8, WGM = 2;
__host__ __device__ __forceinline__ int lds_byte(int r, int c) { const int st = (r >> 4) * 2 + (c >> 5), rr = r & 15, cc = c & 31, ob = rr * 64 + cc * 2; return st * 1024 + (ob ^ (((ob >> 9) & 1) << 5)); }
__host__ __device__ __forceinline__ void stage_rc(int b, int& R, int& C) { const int st = b / 1024, sb = b % 1024, swz = sb ^ (((sb >> 9) & 1) << 5); R = (st >> 1) * 16 + swz / 64; C = (st & 1) * 32 + (swz % 64) / 2; }
__host__ __device__ __forceinline__ int perm32(int rho) { const int n = rho >> 4, i = rho & 15; return 8 * (i >> 2) + 4 * n + (i & 3); }

struct Unit { int pm, pn, e, ti; };

template <int NM, int NN> struct StaticOrder {
    static_assert(NM % WGM == 0 && (NM * NN) % NXCD == 0, "whole 8-row groups, whole XCD shares");
    int G, c;
    __device__ void init(int, int, int G_, int c_) { G = G_; c = c_; }
    __device__ bool next(int i, Unit& u) const {
        constexpr int nwg = NM * NN, q = nwg / NXCD, nig = WGM * NN;
        const int L = i * G + c; if (L >= nwg) return false;
        const int wgid = (L % NXCD) * q + L / NXCD;
        const int gid = wgid / nig, w = wgid % nig;
        u.pm = gid * WGM + (w % WGM); u.pn = w / WGM; u.e = 0; u.ti = 0; return true;
    }
};
template <int K, int NM, int NN, bool ROPE = false, bool IDENT = false> struct DenseSched {
    static constexpr bool ident = IDENT;
    StaticOrder<NM, NN> so; const char* A; const char* B;
    __device__ __forceinline__ bool bsel(const Unit& u) const { return ROPE && u.pn < 8; }
    __device__ __forceinline__ bool next(int i, Unit& u) const { return so.next(i, u); }
    __device__ __forceinline__ const char* a_ptr(const Unit& u) const { return IDENT ? A : A + (size_t)u.pm * (256 * K * 2); }
    __device__ __forceinline__ const char* b_ptr(const Unit& u) const { return B + (size_t)u.pn * (256 * K * 2); }
    __device__ __forceinline__ void gather(const Unit& u, int tid, unsigned (&v)[2][2]) const {
#pragma unroll
        for (int i = 0; i < 2; ++i) { int R, C; stage_rc(tid * 16 + i * 8192, R, C);
#pragma unroll
            for (int h = 0; h < 2; ++h) v[h][i] = ((unsigned)(u.pm * 256 + h * 128 + R) * (unsigned)K + (unsigned)C) * 2u; }
    }
    __device__ __forceinline__ const int* tok_ptr(const Unit&) const { return nullptr; }
    __device__ __forceinline__ int count(const Unit&) const { return 0; }
};
template <int K, bool GATHER, bool IDENT = false> struct MoeSched {
    static constexpr bool ident = IDENT;
    int G, c, nrt; const LAS int* ts; const LAS int* cn;
    const char* A; const char* B; size_t bstride; const int* tok;
    __device__ __forceinline__ bool bsel(const Unit&) const { return false; }
    __device__ __forceinline__ bool next(int i, Unit& u) const {
        int L;
        int rt, pnv;
        if (G == 256) { const int b = i * 8 + (c & 7), s_ = c >> 3; rt = (b >> 1) * 8 + (s_ >> 2); pnv = (b & 1) * 4 + (s_ & 3); L = rt * 8 + pnv; }
        else { L = i * G + c; rt = L >> 3; }
        if (rt >= nrt) return false;
        const int e = __builtin_amdgcn_readfirstlane((int)((const LAS unsigned char*)ts + (RE_OFF - TS_OFF))[rt]);
        u.pm = rt; u.pn = L & 7; u.e = e; u.ti = rt - __builtin_amdgcn_readfirstlane(ts[e]); return true;
    }
    __device__ __forceinline__ const char* a_ptr(const Unit& u) const { return GATHER ? A : A + (size_t)u.pm * (256 * K * 2); }
    __device__ __forceinline__ const char* b_ptr(const Unit& u) const { return B + (size_t)u.e * bstride + (size_t)u.pn * (256 * K * 2); }
    __device__ __forceinline__ const int* tok_ptr(const Unit& u) const { return tok + (size_t)u.e * CAP + u.ti * 256; }
    __device__ __forceinline__ int count(const Unit& u) const { return __builtin_amdgcn_readfirstlane(cn[u.e]); }
    __device__ __forceinline__ void gather(const Unit& u, int tid, unsigned (&v)[2][2]) const {
        const int cnt = __builtin_amdgcn_readfirstlane(cn[u.e]);
#pragma unroll
        for (int i = 0; i < 2; ++i) { int R, C; stage_rc(tid * 16 + i * 8192, R, C);
#pragma unroll
            for (int h = 0; h < 2; ++h) { const int rank = u.ti * 256 + h * 128 + R; int t = 0; if (IDENT) t = u.pm * 256 + h * 128 + R; else if (rank < cnt) t = tok[(size_t)u.e * CAP + rank];
                v[h][i] = ((unsigned)t * (unsigned)K + (unsigned)C) * 2u; } }
    }
};

struct EpiBf16 {
    static constexpr bool PERM = true, BSEL = false;
    bf16_t* O; int ldc; float sc;
    __device__ __forceinline__ void operator()(const f32x4 (&acc)[2][2][4][2], const Unit& u, int wr, int wc, int, int) const {
        const int lane_ = lane_id(), fr = lane_ & 15, fq = lane_ >> 4;
        const int row0 = u.pm * BM + wr * 64 + fr, col0 = u.pn * BM + wc * 32 + 8 * fq;
#pragma unroll
        for (int ai = 0; ai < 2; ++ai)
#pragma unroll
            for (int m = 0; m < 4; ++m) { bf16_t* rowp = O + (size_t)(row0 + ai * HALF + m * 16) * ldc + col0;
#pragma unroll
                for (int bj = 0; bj < 2; ++bj) { const f32x4 v0 = acc[ai][bj][m][0] * sc, v1 = acc[ai][bj][m][1] * sc;
                    u32x4 w; w.x = cvt_pk_bf16(v0[0], v0[1]); w.y = cvt_pk_bf16(v0[2], v0[3]); w.z = cvt_pk_bf16(v1[0], v1[1]); w.w = cvt_pk_bf16(v1[2], v1[3]);
                    *(u32x4*)(rowp + bj * HALF) = w; } }
    }
};
struct EpiFp8 {
    static constexpr bool PERM = true, BSEL = false;
    unsigned char* O; int ldc; float sc;
    __device__ __forceinline__ void operator()(const f32x4 (&acc)[2][2][4][2], const Unit& u, int wr, int wc, int, int) const {
        const int lane_ = lane_id(), fr = lane_ & 15, fq = lane_ >> 4;
        const int row0 = u.pm * BM + wr * 64 + fr, col0 = u.pn * BM + wc * 32 + 8 * fq;
#pragma unroll
        for (int ai = 0; ai < 2; ++ai)
#pragma unroll
            for (int m = 0; m < 4; ++m) { unsigned char* rowp = O + (size_t)(row0 + ai * HALF + m * 16) * ldc + col0;
#pragma unroll
                for (int bj = 0; bj < 2; ++bj) { const f32x4 v0 = acc[ai][bj][m][0] * sc, v1 = acc[ai][bj][m][1] * sc;
                    u32x2 w; w.x = pk4_fp8(v0[0], v0[1], v0[2], v0[3]); w.y = pk4_fp8(v1[0], v1[1], v1[2], v1[3]);
                    *(u32x2*)(rowp + bj * HALF) = w; } }
    }
};
struct EpiProj {
    static constexpr bool PERM = true, BSEL = true;
    bf16_t* O; int ldc; const float* rc; const float* rsn;
    __device__ __forceinline__ void operator()(const f32x4 (&acc)[2][2][4][2], const Unit& u, int wr, int wc, int, int) const {
        const int lane_ = lane_id(), fr = lane_ & 15, fq = lane_ >> 4;
        const int row0 = u.pm * BM + wr * 64 + fr;
        if (u.pn >= 8) {
            const int col0 = wc * 32 + 8 * fq;
            const int act = (u.pn >= 12 && u.pn < 16) ? 1 : (u.pn >= 20 ? 2 : 0);
#pragma unroll
            for (int ai = 0; ai < 2; ++ai)
#pragma unroll
                for (int m = 0; m < 4; ++m) { bf16_t* rowp = O + ((size_t)(2 * u.pn) * T + (row0 + ai * HALF + m * 16)) * HD + col0;
#pragma unroll
                    for (int bj = 0; bj < 2; ++bj) { f32x4 v0 = acc[ai][bj][m][0], v1 = acc[ai][bj][m][1];
                        if (act) {
#pragma unroll
                            for (int j = 0; j < 4; ++j) { const float a = v0[j], b = v1[j];
                                const float ya = act == 1 ? a : 1.5957691216057308f * (a + 0.044715f * a * a * a), yb = act == 1 ? b : 1.5957691216057308f * (b + 0.044715f * b * b * b);
                                v0[j] = a * __builtin_amdgcn_rcpf(1.0f + __expf(-ya)); v1[j] = b * __builtin_amdgcn_rcpf(1.0f + __expf(-yb)); } }
                        u32x4 w; w.x = cvt_pk_bf16(v0[0], v0[1]); w.y = cvt_pk_bf16(v0[2], v0[3]); w.z = cvt_pk_bf16(v1[0], v1[1]); w.w = cvt_pk_bf16(v1[2], v1[3]);
                        *(u32x4*)(rowp + (size_t)bj * T * HD) = w; } }
        } else {
            const bool isq = u.pn < 4; const int f0 = 16 * wc + 4 * fq;
            constexpr float L2G[8] = {-4.580368961312479e-2f, -2.272007650008353e-2f, -1.1315313227834146e-2f, -5.646563141142063e-3f, -2.8205190623786626e-3f, -1.4095702546713536e-3f, -7.046129765893727e-4f, -3.522634716290214e-4f};
            float l2g[2];
#pragma unroll
            for (int bj = 0; bj < 2; ++bj) { const int hh = 2 * (u.pn & 3) + bj; float v = L2G[0];
#pragma unroll
                for (int q = 1; q < 8; ++q) v = (hh == q) ? L2G[q] : v;
                l2g[bj] = v; }
#pragma unroll
            for (int ai = 0; ai < 2; ++ai)
#pragma unroll
                for (int m = 0; m < 4; ++m) { const int row = row0 + ai * HALF + m * 16, pos = row & (SEQ - 1), il = pos & 127;
                    const f32x4 cs = *(const f32x4*)(rc + pos * 64 + f0), sn = *(const f32x4*)(rsn + pos * 64 + f0);
                    bf16_t* rowp = O + ((size_t)(2 * u.pn) * T + row) * HD + f0;
#pragma unroll
                    for (int bj = 0; bj < 2; ++bj) { const float sc = isq ? __builtin_amdgcn_exp2f((float)(il - 127) * l2g[bj]) * 0.08838834764831845f : __builtin_amdgcn_exp2f((float)(127 - il) * l2g[bj]);
                        const f32x4 x1 = acc[ai][bj][m][0], x2 = acc[ai][bj][m][1]; const f32x4 y1 = (x1 * cs - x2 * sn) * sc, y2 = (x1 * sn + x2 * cs) * sc;
                        u32x2 w1, w2; w1.x = cvt_pk_bf16(y1[0], y1[1]); w1.y = cvt_pk_bf16(y1[2], y1[3]); w2.x = cvt_pk_bf16(y2[0], y2[1]); w2.y = cvt_pk_bf16(y2[2], y2[3]);
                        *(u32x2*)(rowp + (size_t)bj * T * HD) = w1; *(u32x2*)(rowp + (size_t)bj * T * HD + 64) = w2; } }
        }
    }
};
struct EpiF32Res {
    static constexpr bool PERM = false, BSEL = false;
    const float* base; float* C; int ldc;
    __device__ __forceinline__ void operator()(const f32x4 (&acc)[2][2][4][2], const Unit& u, int wr, int wc, int, int) const {
        const int lane_ = lane_id(), fr = lane_ & 15, fq = lane_ >> 4;
        const int row0 = u.pm * BM + wr * 64 + fr, col0 = u.pn * BM + wc * 32 + 4 * fq;
#pragma unroll
        for (int ai = 0; ai < 2; ++ai)
#pragma unroll
            for (int m = 0; m < 4; ++m) { const size_t off = (size_t)(row0 + ai * HALF + m * 16) * ldc + col0;
#pragma unroll
                for (int bj = 0; bj < 2; ++bj)
#pragma unroll
                    for (int n = 0; n < 2; ++n) { const f32x4 b = *(const f32x4*)(base + off + bj * HALF + n * 16); *(f32x4*)(C + off + bj * HALF + n * 16) = acc[ai][bj][m][n] + b; }
                if (m == 3) asm volatile("" ::: "memory"); }
    }
};
struct EpiSwiGLU {
    static constexpr bool PERM = true, BSEL = false;
    unsigned char* O; const float* rss; const LAS int* cn;
    __device__ __forceinline__ void operator()(const f32x4 (&acc)[2][2][4][2], const Unit& u, int wr, int wc, int, int) const {
        const int lane_ = lane_id(), fr = lane_ & 15, fq = lane_ >> 4;
        const int cnt = __builtin_amdgcn_readfirstlane(cn[u.e]);
        const int col0 = u.pn * HALF + wc * 32 + 8 * fq;
        float rsv[2][4];
#pragma unroll
        for (int ai = 0; ai < 2; ++ai)
#pragma unroll
            for (int m = 0; m < 4; ++m) { const int rank = u.ti * 256 + ai * HALF + wr * 64 + m * 16 + fr; const float v = rss[(size_t)u.e * CAP + (rank < cnt ? rank : 0)]; rsv[ai][m] = rank < cnt ? v * (1.0f / SC_WGU) : 0.f; }
#pragma unroll
        for (int ai = 0; ai < 2; ++ai)
#pragma unroll
            for (int m = 0; m < 4; ++m) { const int r = ai * HALF + wr * 64 + m * 16 + fr;
                const float rs = rsv[ai][m];
                float o[8];
#pragma unroll
                for (int n = 0; n < 2; ++n)
#pragma unroll
                    for (int j = 0; j < 4; ++j) { const float g = acc[ai][0][m][n][j] * rs, uu = acc[ai][1][m][n][j] * rs; o[n * 4 + j] = SC_HB * g * uu * __builtin_amdgcn_rcpf(1.0f + __expf(-g)); }
                u32x2 w; w.x = pk4_fp8(o[0], o[1], o[2], o[3]); w.y = pk4_fp8(o[4], o[5], o[6], o[7]);
                *(u32x2*)(O + (size_t)(u.pm * BM + r) * DE + col0) = w; }
    }
};

template <class Epi, class Sched, int K, bool GATHER, bool ALIGN_EPI, bool SP2, bool FP8 = false>
__device__ __forceinline__ void gemm_phase(LAS unsigned char* lds, const Sched& S, const Epi& E, int wid) {
    const int lane = lane_id(), tid = wid * 64 + lane, wr = wid >> 2, wc = wid & 3, fr = lane & 15, fq = lane >> 4;
    constexpr int nt = K / BK;
    unsigned voffA[2], voffB[2];
#pragma unroll
    for (int i = 0; i < 2; ++i) { int R, C; stage_rc(tid * 16 + i * 8192, R, C); const int Rb = Epi::PERM ? ((R & ~31) + perm32(R & 31)) : R;
        voffA[i] = (unsigned)(R * K + C) * 2u; voffB[i] = (unsigned)(Rb * K + C) * 2u; }
    unsigned voffB2[2]; bool selC = false, selN = false;
    if constexpr (Epi::BSEL) {
#pragma unroll
        for (int i = 0; i < 2; ++i) { int R, C; stage_rc(tid * 16 + i * 8192, R, C); const int Rb = 64 * ((R >> 4) & 1) + 16 * (R >> 5) + (R & 15); voffB2[i] = (unsigned)(Rb * K + C) * 2u; }
    }
    constexpr size_t kstep = (size_t)(BK * 2);
    constexpr size_t hstep = (size_t)HALF * K * 2;
    const unsigned ldsw = (unsigned)wid * 1024u;
    const int aoff = lds_byte(wr * 64 + fr, fq * 8), boff = lds_byte(wc * 32 + fr, fq * 8);
    unsigned vC[2][2];
    LAS int* gtab = (LAS int*)(lds + (GT_OFF));
#define PG8_SA(b, h) (((b) * 2 + (h)) * HTB)
#define PG8_SB(b, h) ((4 + (b) * 2 + (h)) * HTB)
#define PG8_STAGE(bufoff, gbase, voff) do { _Pragma("unroll") for (int _i = 0; _i < 2; ++_i) \
        __builtin_amdgcn_global_load_lds((const unsigned*)((const char*)(gbase) + (voff)[_i]), (LAS unsigned*)(lds + (bufoff) + ldsw + _i * 8192), 16, 0, 0); } while (0)
#define PG8_STAGE_A(bufoff, gp, h, nx) do { if constexpr (GATHER) PG8_STAGE(bufoff, gp, vC[h]); else PG8_STAGE(bufoff, (gp) + (h) * hstep, voffA); } while (0)
#define PG8_SWITCH() do { if constexpr (GATHER) { if (last && has_next) { const int _cnt = S.count(nxt); _Pragma("unroll") for (int _i = 0; _i < 2; ++_i) { int _R, _C; stage_rc(tid * 16 + _i * 8192, _R, _C); \
        _Pragma("unroll") for (int _h = 0; _h < 2; ++_h) { const int _r = _h * 128 + _R; int _t; if constexpr (Sched::ident) _t = nxt.pm * 256 + _r; else { _t = gtab[_r]; _t = (nxt.ti * 256 + _r < _cnt) ? _t : 0; } vC[_h][_i] = ((unsigned)_t * (unsigned)K + (unsigned)_C) * 2u; } } } } } while (0)
#define PG8_STAGE_B(bufoff, gp, nx) do { if constexpr (Epi::BSEL) { const bool _s = (nx) ? selN : selC; if (_s) PG8_STAGE(bufoff, gp, voffB2); else PG8_STAGE(bufoff, gp, voffB); } else PG8_STAGE(bufoff, gp, voffB); } while (0)
#define PG8_LD8(p) __builtin_shufflevector(*(const LAS i32x4*)(p), *(const LAS i32x4*)((p) + 1024), 0, 1, 2, 3, 4, 5, 6, 7)
#define PG8_LDA(dst, b, h) do { _Pragma("unroll") for (int m = 0; m < 4; ++m) { if constexpr (FP8) dst##8[m] = PG8_LD8(lds + PG8_SA(b, h) + aoff + m * 2048); else { _Pragma("unroll") for (int k = 0; k < 2; ++k) dst[m][k] = *(const LAS bf16x8*)(lds + PG8_SA(b, h) + aoff + m * 2048 + k * 1024); } } } while (0)
#define PG8_LDB(dst, b, h) do { _Pragma("unroll") for (int n = 0; n < 2; ++n) { if constexpr (FP8) dst##8[n] = PG8_LD8(lds + PG8_SB(b, h) + boff + n * 2048); else { _Pragma("unroll") for (int k = 0; k < 2; ++k) dst[n][k] = *(const LAS bf16x8*)(lds + PG8_SB(b, h) + boff + n * 2048 + k * 1024); } } } while (0)
#define PG8_MMA(ai, bj, At, Bt) do { __builtin_amdgcn_s_setprio(1); _Pragma("unroll") for (int m = 0; m < 4; ++m) _Pragma("unroll") for (int n = 0; n < 2; ++n) { \
        if constexpr (FP8) acc[ai][bj][m][n] = __builtin_amdgcn_mfma_scale_f32_16x16x128_f8f6f4(Bt##8[n], At##8[m], acc[ai][bj][m][n], 0, 0, 0, 0x7f7f7f7f, 0, 0x7f7f7f7f); \
        else { _Pragma("unroll") for (int k = 0; k < 2; ++k) acc[ai][bj][m][n] = __builtin_amdgcn_mfma_f32_16x16x32_bf16(Bt[n][k], At[m][k], acc[ai][bj][m][n], 0, 0, 0); } } \
        __builtin_amdgcn_s_setprio(0); } while (0)
#define PG8_WAIT_V(n) asm volatile("s_waitcnt vmcnt(" #n ")" ::: "memory")
#define PG8_WAIT_L(n) asm volatile("s_waitcnt lgkmcnt(" #n ")" ::: "memory")
#define PG8_BAR __builtin_amdgcn_s_barrier()
#define PG8_SCHED __builtin_amdgcn_sched_barrier(0)
    Unit cur, nxt; int ui = 0;
    if (!S.next(0, cur)) return;
    f32x4 acc[2][2][4][2];
#pragma unroll
    for (int a = 0; a < 2; ++a)
#pragma unroll
        for (int b = 0; b < 2; ++b)
#pragma unroll
            for (int m = 0; m < 4; ++m)
#pragma unroll
                for (int n = 0; n < 2; ++n) acc[a][b][m][n] = (f32x4){0.f, 0.f, 0.f, 0.f};
    bf16x8 At[4][2], B0[2][2], B1[2][2]; i32x8 At8[4], B08[2], B18[2];
    const char* cA = S.a_ptr(cur); const char* cB = S.b_ptr(cur);
    if constexpr (GATHER) { S.gather(cur, tid, vC); }
    if constexpr (Epi::BSEL) selC = S.bsel(cur);
    if constexpr (SP2) {
        PG8_STAGE_B(PG8_SB(0, 0), cB, false); PG8_STAGE_B(PG8_SB(0, 1), cB + hstep, false); PG8_STAGE_A(PG8_SA(0, 0), cA, 0, false); PG8_STAGE_A(PG8_SA(0, 1), cA, 1, false);
        if (wr == 1) PG8_BAR;
        PG8_WAIT_V(2); PG8_BAR;
        PG8_STAGE_B(PG8_SB(1, 0), cB + kstep, false); PG8_STAGE_A(PG8_SA(1, 0), cA + kstep, 0, false); PG8_STAGE_B(PG8_SB(1, 1), cB + hstep + kstep, false);
        PG8_WAIT_V(6); PG8_BAR;
    } else {
        PG8_STAGE_B(PG8_SB(0, 0), cB, false); PG8_STAGE_A(PG8_SA(0, 0), cA, 0, false); PG8_STAGE_B(PG8_SB(0, 1), cB + hstep, false); PG8_STAGE_A(PG8_SA(0, 1), cA, 1, false);
        if (wr == 1) PG8_BAR;
        PG8_WAIT_V(4); PG8_BAR;
        PG8_STAGE_B(PG8_SB(1, 0), cB + kstep, false); PG8_STAGE_A(PG8_SA(1, 0), cA + kstep, 0, false); PG8_STAGE_B(PG8_SB(1, 1), cB + hstep + kstep, false);
        PG8_WAIT_V(6); PG8_BAR;
    }
    for (;;) {
        const bool has_next = S.next(ui + 1, nxt);
        const char* nA = has_next ? S.a_ptr(nxt) : cA; const char* nB = has_next ? S.b_ptr(nxt) : cB;
        if constexpr (Epi::BSEL) selN = has_next ? S.bsel(nxt) : selC;
        if constexpr (GATHER && !Sched::ident) { if (has_next && wid < 4) __builtin_amdgcn_global_load_lds((const unsigned*)(S.tok_ptr(nxt) + wid * 64 + lane), (LAS unsigned*)(gtab + wid * 64), 4, 0, 0); }
#pragma unroll 1
        for (int t = 0; t < nt; t += 2) {
            const bool last = (t == nt - 2);
            const char* a1 = cA + (size_t)(t + 1) * kstep;
            const char* a2 = last ? nA : cA + (size_t)(t + 2) * kstep; const char* b2 = last ? nB : cB + (size_t)(t + 2) * kstep;
            const char* a3 = a2 + kstep; const char* b3 = b2 + kstep;
            if constexpr (SP2) {
            PG8_LDB(B0, 0, 0); PG8_LDB(B1, 0, 1); PG8_SCHED; PG8_LDA(At, 0, 0); PG8_STAGE_A(PG8_SA(1, 1), a1, 1, false); PG8_SWITCH();
            PG8_WAIT_V(8); PG8_WAIT_L(0); PG8_BAR; PG8_MMA(0, 0, At, B0); PG8_MMA(0, 1, At, B1); PG8_BAR; PG8_SCHED;
            PG8_LDA(At, 0, 1); PG8_STAGE_B(PG8_SB(0, 0), b2, last); PG8_STAGE_B(PG8_SB(0, 1), b2 + hstep, last); PG8_STAGE_A(PG8_SA(0, 0), a2, 0, last);
            PG8_WAIT_V(8); PG8_WAIT_L(0); PG8_BAR; PG8_MMA(1, 0, At, B0); PG8_MMA(1, 1, At, B1); PG8_BAR; PG8_SCHED;
            PG8_LDB(B0, 1, 0); PG8_LDB(B1, 1, 1); PG8_SCHED; PG8_LDA(At, 1, 0); PG8_STAGE_A(PG8_SA(0, 1), a2, 1, last);
            PG8_WAIT_V(8); PG8_WAIT_L(0); PG8_BAR; PG8_MMA(0, 0, At, B0); PG8_MMA(0, 1, At, B1); PG8_BAR; PG8_SCHED;
            PG8_LDA(At, 1, 1); PG8_STAGE_B(PG8_SB(1, 0), b3, last); PG8_STAGE_B(PG8_SB(1, 1), b3 + hstep, last); PG8_STAGE_A(PG8_SA(1, 0), a3, 0, last);
            PG8_WAIT_V(8); PG8_WAIT_L(0); PG8_BAR; PG8_MMA(1, 0, At, B0); PG8_MMA(1, 1, At, B1); PG8_BAR; PG8_SCHED;
            } else {
            PG8_LDB(B0, 0, 0); PG8_SCHED; PG8_LDA(At, 0, 0); PG8_STAGE_A(PG8_SA(1, 1), a1, 1, false); PG8_SWITCH();
            PG8_WAIT_L(8); PG8_BAR; PG8_WAIT_L(0); PG8_MMA(0, 0, At, B0); PG8_BAR; PG8_SCHED;
            PG8_LDB(B1, 0, 1); PG8_STAGE_B(PG8_SB(0, 0), b2, last);
            PG8_BAR; PG8_WAIT_L(0); PG8_MMA(0, 1, At, B1); PG8_BAR;
            PG8_LDA(At, 0, 1); PG8_STAGE_A(PG8_SA(0, 0), a2, 0, last);
            PG8_BAR; PG8_WAIT_L(0); PG8_MMA(1, 0, At, B0); PG8_BAR; PG8_SCHED;
            PG8_STAGE_B(PG8_SB(0, 1), b2 + hstep, last);
            PG8_WAIT_V(6); PG8_BAR; PG8_MMA(1, 1, At, B1); PG8_BAR;
            PG8_LDB(B0, 1, 0); PG8_SCHED; PG8_LDA(At, 1, 0); PG8_STAGE_A(PG8_SA(0, 1), a2, 1, last);
            PG8_WAIT_L(8); PG8_BAR; PG8_WAIT_L(0); PG8_MMA(0, 0, At, B0); PG8_BAR; PG8_SCHED;
            PG8_LDB(B1, 1, 1); PG8_STAGE_B(PG8_SB(1, 0), b3, last);
            PG8_BAR; PG8_WAIT_L(0); PG8_MMA(0, 1, At, B1); PG8_BAR;
            PG8_LDA(At, 1, 1); PG8_STAGE_A(PG8_SA(1, 0), a3, 0, last);
            PG8_BAR; PG8_WAIT_L(0); PG8_MMA(1, 0, At, B0); PG8_BAR; PG8_SCHED;
            PG8_STAGE_B(PG8_SB(1, 1), b3 + hstep, last);
            PG8_WAIT_V(6); PG8_BAR; PG8_MMA(1, 1, At, B1); PG8_BAR;
            }
        }
        if constexpr (ALIGN_EPI) { if (wr == 0) PG8_BAR; }
        E(acc, cur, wr, wc, fr, fq);
        if (!has_next) break;
#pragma unroll
        for (int a = 0; a < 2; ++a)
#pragma unroll
            for (int b = 0; b < 2; ++b)
#pragma unroll
                for (int m = 0; m < 4; ++m)
#pragma unroll
                    for (int n = 0; n < 2; ++n) acc[a][b][m][n] = (f32x4){0.f, 0.f, 0.f, 0.f};
        cur = nxt; cA = nA; cB = nB; ++ui; selC = selN;
        if constexpr (ALIGN_EPI) { if (wr == 1) PG8_BAR; }
    }
    PG8_WAIT_V(0);
    if constexpr (!ALIGN_EPI) { if (wr == 0) PG8_BAR; }
    PG8_BAR;
#undef PG8_SA
#undef PG8_SB
#undef PG8_STAGE
#undef PG8_STAGE_A
#undef PG8_SWITCH
#undef PG8_STAGE_B
#undef PG8_LDA
#undef PG8_LDB
#undef PG8_MMA
#undef PG8_LD8
#undef PG8_WAIT_V
#undef PG8_WAIT_L
#undef PG8_BAR
#undef PG8_SCHED
}
}

#ifndef PG8_SP2
#define PG8_SP2 true
#endif
#ifndef PG8_ALIGN
#define PG8_ALIGN true
#endif

#define XB_TMO      128
#define XB_XCNT(j)  (256  + 64 * (j))
#define XB_XSUB(j)  (1280 + 64 * (j))
#define XB_XGEN(j)  (2304 + 64 * (j))
#define XB_TOP      3328
#define XB_TOPGEN   3392
#define XCD_BAR_WORDS 3456
#define XB_SPIN_CAP (1u << 18)
__device__ __forceinline__ unsigned xb_ld(unsigned* p)              { return __hip_atomic_load(p, __ATOMIC_RELAXED, __HIP_MEMORY_SCOPE_AGENT); }
__device__ __forceinline__ unsigned xb_add(unsigned* p, unsigned v) { return __hip_atomic_fetch_add(p, v, __ATOMIC_RELAXED, __HIP_MEMORY_SCOPE_AGENT); }
__device__ __forceinline__ unsigned xb_xcc_id() { return (unsigned)__builtin_amdgcn_s_getreg((3 << 11) | 20) & 0xFu; }
#define XB_SPIN(cond, bar) do { unsigned _sp = 0; while (cond) { __builtin_amdgcn_s_sleep(1); \
    if ((++_sp & 255u) == 0u) { if (xb_ld(&(bar)[XB_TMO])) break; if (_sp > XB_SPIN_CAP) { atomicAdd(&(bar)[XB_TMO], 1u); break; } } } } while (0)
struct XcdBarrier { unsigned* bar; unsigned x; volatile LAS unsigned* st; };
__device__ __forceinline__ XcdBarrier xcd_barrier_post(unsigned* bar, volatile LAS unsigned* st) {
    XcdBarrier b; b.bar = bar; b.x = xb_xcc_id(); b.st = st;
    if (threadIdx.x == 0) (void)xb_add(&bar[XB_XCNT(b.x)], 1u);
    return b;
}
__device__ __forceinline__ void xcd_barrier_complete(unsigned* bar, unsigned x, unsigned& nloc, unsigned& nx) {
    const unsigned G = gridDim.x * gridDim.y * gridDim.z;
    unsigned sum, cnt, mine, sp = 0u;
    for (;;) {
        sum = 0u; cnt = 0u; mine = 0u;
#pragma unroll
        for (unsigned j = 0; j < 16; ++j) { const unsigned c = xb_ld(&bar[XB_XCNT(j)]); sum += c; cnt += (c > 0u) ? 1u : 0u; mine = (j == x) ? c : mine; }
        if (sum == G) break;
        __builtin_amdgcn_s_sleep(1);
        if ((++sp & 255u) == 0u) { if (xb_ld(&bar[XB_TMO])) break; if (sp > XB_SPIN_CAP) { atomicAdd(&bar[XB_TMO], 1u); break; } }
    }
    nloc = mine > 0u ? mine : 1u; nx = cnt > 0u ? cnt : 1u;
}
__device__ __forceinline__ void xcd_barrier(const XcdBarrier& b) {
    asm volatile("s_waitcnt vmcnt(0)" ::: "memory");
    __syncthreads();
    if (threadIdx.x == 0) {
        unsigned* bar = b.bar;
        __builtin_amdgcn_s_waitcnt(0);
        unsigned nloc = b.st[0], nx = b.st[1];
        if (nloc == 0u) { xcd_barrier_complete(bar, b.x, nloc, nx); b.st[0] = nloc; b.st[1] = nx; }
        const unsigned old = xb_add(&bar[XB_XSUB(b.x)], 1u);
        const unsigned gen = old / nloc;
        if (old + 1u == (gen + 1u) * nloc) {
            __builtin_amdgcn_fence(__ATOMIC_RELEASE, "agent");
            asm volatile("s_waitcnt vmcnt(0)" ::: "memory");
            const unsigned og = xb_add(&bar[XB_TOP], 1u);
            const unsigned tg = og / nx;
            if (og + 1u == (tg + 1u) * nx) xb_add(&bar[XB_TOPGEN], 1u);
            else XB_SPIN(xb_ld(&bar[XB_TOPGEN]) == tg, bar);
            __builtin_amdgcn_fence(__ATOMIC_ACQUIRE, "agent");
            xb_add(&bar[XB_XGEN(b.x)], 1u);
            asm volatile("s_waitcnt vmcnt(0)" ::: "memory");
        } else {
            XB_SPIN(xb_ld(&bar[XB_XGEN(b.x)]) == gen, bar);
            __builtin_amdgcn_fence(__ATOMIC_ACQUIRE, "agent");
            asm volatile("s_waitcnt vmcnt(0)" ::: "memory");
        }
    }
    __syncthreads();
}

struct Frame {
    LAS unsigned char* lds;
    volatile LAS unsigned* MISC;
    unsigned* ctl;
    int wave, vcu, G;
    const float *x, *norm_mix_g, *w_in, *ret_norm_g, *conv_w, *conv_b, *w_rg, *b_rg, *w_ig, *b_ig, *lam, *lru_norm_g, *w_out, *norm_ffn_g,
                *w_group, *b_group, *w_router, *b_router, *w_gate, *w_up, *w_down, *norm_final_g;
    float* out;
    unsigned char* ws;
};

__device__ __forceinline__ unsigned offb(unsigned row, unsigned ch);
__device__ __forceinline__ bf16x8 tr_frag(LAS unsigned char* img, int lane, int c, int ks);
__device__ __forceinline__ bf16x8 tr_rows(LAS unsigned char* img, int lane, int c, int row0) {
    const unsigned q = (lane & 15) >> 2, p = lane & 3;
    const s16x4 a = __builtin_amdgcn_ds_read_tr16_b64_v4i16((LAS s16x4*)(img + offb(row0 + q, 2 * c + (p >> 1)) + 8 * (p & 1)));
    const s16x4 b = __builtin_amdgcn_ds_read_tr16_b64_v4i16((LAS s16x4*)(img + offb(row0 + 4 + q, 2 * c + (p >> 1)) + 8 * (p & 1)));
    bf16x8 r; r[0] = a[0]; r[1] = a[1]; r[2] = a[2]; r[3] = a[3]; r[4] = b[0]; r[5] = b[1]; r[6] = b[2]; r[7] = b[3]; return r;
}
template <bool F8, bool GK>
__device__ __forceinline__ void p0_transpose_item(const float* W, int N, int k0, int n0, void* WTrow0, int KoutB, const float* gk, float scale, LAS unsigned char* img, int lane) {
    const int l31 = lane & 31, lh = lane >> 5, l15 = lane & 15, g = lane >> 4;
    const float* src = W + (size_t)(k0 + lh) * N + n0 + 4 * l31;
#define P0_OUT(pass) do { LDS_WAIT(); asm volatile("" ::: "memory"); const int kk0 = k0 + 64 * (pass); \
        if constexpr (F8) { _Pragma("unroll") for (int c = 0; c < 8; ++c) { const u32x4 q0 = __builtin_bit_cast(u32x4, tr_rows(img, lane, c, 16 * g)), q1 = __builtin_bit_cast(u32x4, tr_rows(img, lane, c, 16 * g + 8)); \
            u32x4 o; o.x = pk4_fp8(bflo(q0.x), bfhi(q0.x), bflo(q0.y), bfhi(q0.y)); o.y = pk4_fp8(bflo(q0.z), bfhi(q0.z), bflo(q0.w), bfhi(q0.w)); \
            o.z = pk4_fp8(bflo(q1.x), bfhi(q1.x), bflo(q1.y), bfhi(q1.y)); o.w = pk4_fp8(bflo(q1.z), bfhi(q1.z), bflo(q1.w), bfhi(q1.w)); \
            *(u32x4*)((unsigned char*)WTrow0 + (size_t)(16 * c + l15) * KoutB + kk0 + 16 * g) = o; } } \
        else { _Pragma("unroll") for (int c = 0; c < 8; ++c) _Pragma("unroll") for (int ks = 0; ks < 2; ++ks) { const bf16x8 f = tr_frag(img, lane, c, ks); \
            *(bf16x8*)((unsigned char*)WTrow0 + (size_t)(16 * c + l15) * KoutB + 2 * (kk0 + 32 * ks + 8 * g)) = f; } } \
        LDS_WAIT(); asm volatile("" ::: "memory"); } while (0)
#pragma unroll 1
    for (int pass = 0; pass < 2; ++pass) {
#pragma unroll
        for (int half = 0; half < 2; ++half) {
            const int st = 2 * pass + half;
            f32x4 v[16]; float gs[16];
#pragma unroll
            for (int i = 0; i < 16; ++i) v[i] = __builtin_nontemporal_load((const f32x4*)(src + (size_t)(32 * st + 2 * i) * N));
#pragma unroll
            for (int i = 0; i < 16; ++i) gs[i] = GK ? gk[k0 + 32 * st + 2 * i + lh] * scale : scale;
#pragma unroll
            for (int i = 0; i < 16; ++i) { const int kl = 32 * half + 2 * i + lh; const f32x4 x = v[i] * gs[i];
                u32x2 w; w.x = pk2(x.x, x.y); w.y = pk2(x.z, x.w); *(LAS u32x2*)(img + offb(kl, l31 >> 1) + 8 * (l31 & 1)) = w; }
        }
        P0_OUT(pass);
    }
#undef P0_OUT
}
constexpr int I_G = (D / 128) * (DE / 128), I_DN = (DE / 128) * (D / 128), NQ_ITEMS = NE * (2 * I_G + I_DN);
__device__ __forceinline__ void convert_queue(Frame& F) {
    LAS unsigned char* scr = F.lds + F.wave * 16384;
    const int lane = lane_id();
    unsigned char* Wd8 = F.ws + WS_WD; unsigned char* Wgu8 = F.ws + WS_WGU;
    for (;;) {
        unsigned it = 0; if (lane == 0) it = atomicAdd(F.ctl + CW_Q, 1u);
        int r = __builtin_amdgcn_readfirstlane((int)it); if (r >= NQ_ITEMS) break;
        const int e = r / (2 * I_G + I_DN); r -= e * (2 * I_G + I_DN);
        if (r < 2 * I_G) { const int up = r >= I_G; if (up) r -= I_G; const int nblk = DE / 128, kb = r / nblk, nb = r % nblk;
            const float* W = (up ? F.w_up : F.w_gate) + (size_t)e * D * DE;
            unsigned char* row0 = Wgu8 + (size_t)e * D * D + (size_t)(256 * nb + 128 * up) * D;
            p0_transpose_item<true, true>(W, DE, 128 * kb, 128 * nb, row0, D, F.norm_ffn_g, SC_WGU, scr, lane); continue; }
        r -= 2 * I_G;
        { const int nblk = D / 128, kb = r / nblk, nb = r % nblk; p0_transpose_item<true, false>(F.w_down + (size_t)e * DE * D, D, 128 * kb, 128 * nb, Wd8 + (size_t)e * D * DE + (size_t)(128 * nb) * DE, DE, nullptr, SC_WD, scr, lane); }
    }
}
__device__ __forceinline__ void p0_prologue(Frame& F) {
    LAS unsigned char* scr = F.lds + F.wave * 16384;
    const int lane = lane_id(), tid = F.wave * 64 + lane;
    const int gw = F.wave * F.G + F.vcu, NGW = F.G * NWAVES;
    bf16_t* Win_t = (bf16_t*)(F.ws + WS_WIN); bf16_t* Wout_t = (bf16_t*)(F.ws + WS_WOUT);
    constexpr int I_IN = (D / 128) * (PROJ / 128), I_OUT = (D / 128) * (D / 128);
    constexpr int NITEMS = I_IN + I_OUT;
    for (int it = gw; it < NITEMS; it += NGW) {
        int r = it;
        if (r < I_IN) { const int nblk = PROJ / 128, kb = r / nblk, nb = r % nblk; p0_transpose_item<false, false>(F.w_in, PROJ, 128 * kb, 128 * nb, Win_t + (size_t)(128 * nb) * D, D * 2, nullptr, 1.0f, scr, lane); continue; } r -= I_IN;
        { const int nblk = D / 128, kb = r / nblk, nb = r % nblk; p0_transpose_item<false, false>(F.w_out, D, 128 * kb, 128 * nb, Wout_t + (size_t)(128 * nb) * D, D * 2, nullptr, 1.0f, scr, lane); }
    }
    bf16_t* Hb = (bf16_t*)(F.ws + WS_R1);
    for (int m = gw; m < T; m += 2 * NGW) {
        const int m2 = m + NGW < T ? m + NGW : m;
        const f32x4* xr = (const f32x4*)(F.x + (size_t)m * D) + lane; const f32x4* xr2 = (const f32x4*)(F.x + (size_t)m2 * D) + lane; const f32x4* gr = (const f32x4*)F.norm_mix_g + lane;
        f32x4 v[8], v2[8]; float s = 0.f, s2 = 0.f;
#pragma unroll
        for (int j = 0; j < 8; ++j) { v[j] = __builtin_nontemporal_load(xr + 64 * j); v2[j] = __builtin_nontemporal_load(xr2 + 64 * j); }
#pragma unroll
        for (int j = 0; j < 8; ++j) { s += (v[j].x * v[j].x + v[j].y * v[j].y) + (v[j].z * v[j].z + v[j].w * v[j].w); s2 += (v2[j].x * v2[j].x + v2[j].y * v2[j].y) + (v2[j].z * v2[j].z + v2[j].w * v2[j].w); }
        const float rs = 1.0f / sqrtf(wave_sum(s) * (1.0f / D) + EPS), rs2 = 1.0f / sqrtf(wave_sum(s2) * (1.0f / D) + EPS);
        u32x2* o = (u32x2*)(Hb + (size_t)m * D) + lane; u32x2* o2 = (u32x2*)(Hb + (size_t)m2 * D) + lane;
#pragma unroll
        for (int j = 0; j < 8; ++j) { const f32x4 g = gr[64 * j]; u32x2 w; w.x = pk2(v[j].x * rs * g.x, v[j].y * rs * g.y); w.y = pk2(v[j].z * rs * g.z, v[j].w * rs * g.w); o[64 * j] = w;
            u32x2 w2; w2.x = pk2(v2[j].x * rs2 * g.x, v2[j].y * rs2 * g.y); w2.y = pk2(v2[j].z * rs2 * g.z, v2[j].w * rs2 * g.w); o2[64 * j] = w2; }
    }
    const int gt = F.vcu * NTHREADS + tid, NGT = F.G * NTHREADS;
    float* rc = (float*)(F.ws + WS_ROPE); float* rsn = rc + SEQ * 64;
    for (int i = gt; i < SEQ * 64; i += NGT) { const int pos = i >> 6, f = i & 63; const float inv = powf(10000.0f, -(float)f / 64.0f); const float ang = (float)pos * inv; float sv, cv; sincosf(ang, &sv, &cv); rc[i] = cv; rsn[i] = sv; }
    bf16_t* whi = (bf16_t*)(F.ws + WS_WGT); bf16_t* wlo = whi + 48 * D;
    for (int i = gt; i < 48 * D; i += NGT) { const int n = i / D, k = i % D; float v = 0.f;
        if (n < 4) v = F.w_group[k * 4 + n]; else if (n < 36) v = F.w_router[k * 32 + (n - 4)];
        v *= F.norm_ffn_g[k]; const unsigned h = f2bf(v); const float hf = __builtin_bit_cast(float, h << 16); whi[i] = (bf16_t)h; wlo[i] = (bf16_t)f2bf(v - hf); }
}

__device__ __forceinline__ unsigned offb(unsigned row, unsigned ch) { return 256u * row + 16u * (ch ^ (((row & 3u) << 2) | ((row >> 2) & 3u))); }
__device__ __forceinline__ bf16x8 row_frag(LAS unsigned char* img, int lane, int rb, int s) { return *(const LAS bf16x8*)(img + offb((lane & 15) + 16 * rb, 4 * s + (lane >> 4))); }
__device__ __forceinline__ bf16x8 tr_frag(LAS unsigned char* img, int lane, int c, int ks) {
    const unsigned g = lane >> 4, q = (lane & 15) >> 2, p = lane & 3;
    const s16x4 a = __builtin_amdgcn_ds_read_tr16_b64_v4i16((LAS s16x4*)(img + offb(32 * ks + 8 * g + q, 2 * c + (p >> 1)) + 8 * (p & 1)));
    const s16x4 b = __builtin_amdgcn_ds_read_tr16_b64_v4i16((LAS s16x4*)(img + offb(32 * ks + 8 * g + 4 + q, 2 * c + (p >> 1)) + 8 * (p & 1)));
    bf16x8 r; r[0] = a[0]; r[1] = a[1]; r[2] = a[2]; r[3] = a[3]; r[4] = b[0]; r[5] = b[1]; r[6] = b[2]; r[7] = b[3]; return r;
}
#define MFMA16(a, b, c) __builtin_amdgcn_mfma_f32_16x16x32_bf16(a, b, c, 0, 0, 0)
__device__ __forceinline__ bf16x8 tr_frag2(LAS unsigned char* img, int lane, int c, int ks) {
    const unsigned g = lane >> 4, q = (lane & 15) >> 2, p = lane & 3;
    const s16x4 a = __builtin_amdgcn_ds_read_tr16_b64_v4i16((LAS s16x4*)(img + offb(32 * ks + 4 * g + q, 2 * c + (p >> 1)) + 8 * (p & 1)));
    const s16x4 b = __builtin_amdgcn_ds_read_tr16_b64_v4i16((LAS s16x4*)(img + offb(32 * ks + 16 + 4 * g + q, 2 * c + (p >> 1)) + 8 * (p & 1)));
    bf16x8 r; r[0] = a[0]; r[1] = a[1]; r[2] = a[2]; r[3] = a[3]; r[4] = b[0]; r[5] = b[1]; r[6] = b[2]; r[7] = b[3]; return r;
}
#define GLDS16(gsrc, ldst) __builtin_amdgcn_global_load_lds((const unsigned*)(gsrc), (LAS unsigned*)(ldst), 16, 0, 0)
#define RAW_BAR() do { asm volatile("s_waitcnt lgkmcnt(0)" ::: "memory"); __builtin_amdgcn_s_barrier(); asm volatile("" ::: "memory"); } while (0)
__device__ __forceinline__ void retention_unit(Frame& F, int b, int h) {
    LAS unsigned char* KI = F.lds; LAS unsigned char* VI0 = F.lds + 32768; LAS unsigned char* SI = F.lds + 98304;
    const int lane = lane_id(), w = F.wave, l15 = lane & 15, lg = lane >> 4;
    const int rtw = (w < 4) ? w : 11 - w;
    const float gC = expf(128.0f * log1pf(-exp2f(-5.0f - (float)h)));
    const bf16_t* proj = (const bf16_t*)(F.ws + WS_R2);
    bf16_t* mix = (bf16_t*)(F.ws + WS_R1);
    f32x4 accS[8];
#pragma unroll
    for (int c = 0; c < 8; ++c) accS[c] = (f32x4){0.f, 0.f, 0.f, 0.f};
    const int il = 16 * rtw + l15;
    unsigned dsrc[4];
#pragma unroll
    for (int i = 0; i < 4; ++i) { const unsigned row = 16 * w + 4 * i + lg; dsrc[i] = row * (HD * 2) + 16u * ((unsigned)l15 ^ (((row & 3u) << 2) | ((row >> 2) & 3u))); }
    const char* kbase = (const char*)(proj + ((size_t)(8 + h) * T + b * SEQ) * HD);
    const size_t vofs = (size_t)8 * T * HD * 2;
    const bf16_t* qbase = proj + ((size_t)h * T + b * SEQ + il) * HD + 8 * lg;
#define RET_DMA(img, base) do { _Pragma("unroll") for (int _i = 0; _i < 4; ++_i) GLDS16((base) + dsrc[_i], (img) + 4096 * w + 1024 * _i); } while (0)
    RET_DMA(KI, kbase); RET_DMA(VI0, kbase + vofs);
    u32x4 qn[4]; u32x2 ov[8];
#pragma unroll
    for (int s = 0; s < 4; ++s) qn[s] = *(const u32x4*)(qbase + 32 * s);
#pragma unroll
    for (int c = 0; c < 8; ++c) *(LAS u32x2*)(SI + offb(16 * c + l15, 2 * w + (lane >> 5)) + 8 * (lg & 1)) = (u32x2){0u, 0u};
#pragma unroll 1
    for (int n = 0; n < NCHUNK; ++n) {
        const int tok0 = b * SEQ + n * CHK;
        LAS unsigned char* VI = VI0 + (n & 1) * 32768;
        asm volatile("s_waitcnt vmcnt(0)" ::: "memory"); RAW_BAR();
        bf16x8 qf[4];
#pragma unroll
        for (int s = 0; s < 4; ++s) qf[s] = __builtin_bit_cast(bf16x8, qn[s]);
        const char* nk = kbase + (size_t)(n + 1) * (CHK * HD * 2);
        if (n + 1 < NCHUNK) {
            RET_DMA(VI0 + ((n + 1) & 1) * 32768, nk + vofs);
#pragma unroll
            for (int s = 0; s < 4; ++s) qn[s] = *(const u32x4*)(qbase + (size_t)(n + 1) * (CHK * HD) + 32 * s);
        }
        if (n > 0) { bf16_t* prow = mix + (size_t)(tok0 - CHK + il) * D + h * HD + 4 * lg;
#pragma unroll
            for (int c = 0; c < 8; ++c) *(u32x2*)(prow + 16 * c) = ov[c]; }
        u32x2 gv[8];
        { const bf16_t* grow = proj + ((size_t)(24 + h) * T + tok0 + il) * HD + 4 * lg;
#pragma unroll
          for (int c = 0; c < 8; ++c) gv[c] = *(const u32x2*)(grow + 16 * c); }
        bf16x8 pf[4];
#pragma unroll
        for (int s = 0; s < 4; ++s) {
            f32x4 sc[2];
#pragma unroll
            for (int t = 0; t < 2; ++t) { const int jt = 2 * s + t; sc[t] = (f32x4){0.f, 0.f, 0.f, 0.f};
#pragma unroll
                for (int k = 0; k < 4; ++k) sc[t] = MFMA16(row_frag(KI, lane, jt, k), qf[k], sc[t]);
                const int j0 = 16 * jt + 4 * lg;
#pragma unroll
                for (int r = 0; r < 4; ++r) sc[t][r] = (j0 + r > il) ? 0.f : sc[t][r]; }
            const u32x4 pw = (u32x4){pk2(sc[0][0], sc[0][1]), pk2(sc[0][2], sc[0][3]), pk2(sc[1][0], sc[1][1]), pk2(sc[1][2], sc[1][3])};
            pf[s] = __builtin_bit_cast(bf16x8, pw);
        }
        bf16x8 ktf[4];
#pragma unroll
        for (int s = 0; s < 4; ++s) ktf[s] = tr_frag2(KI, lane, w, s);
        RAW_BAR();
        if (n + 1 < NCHUNK) RET_DMA(KI, nk);
        f32x4 accO[8];
        bf16x8 vfr[2][4], sfr[2][4];
#pragma unroll
        for (int s = 0; s < 4; ++s) { vfr[0][s] = tr_frag2(VI, lane, 0, s); sfr[0][s] = row_frag(SI, lane, 0, s); }
#pragma unroll
        for (int c = 0; c < 8; ++c) {
            if (c < 7) {
#pragma unroll
                for (int s = 0; s < 4; ++s) { vfr[(c + 1) & 1][s] = tr_frag2(VI, lane, c + 1, s); sfr[(c + 1) & 1][s] = row_frag(SI, lane, c + 1, s); } }
            f32x4 o = (f32x4){0.f, 0.f, 0.f, 0.f};
#pragma unroll
            for (int s = 0; s < 4; ++s) o = MFMA16(vfr[c & 1][s], pf[s], o);
#pragma unroll
            for (int s = 0; s < 4; ++s) o = MFMA16(sfr[c & 1][s], qf[s], o);
            accO[c] = o;
#pragma unroll
            for (int s = 0; s < 4; ++s) accS[c] = MFMA16(ktf[s], vfr[c & 1][s], accS[c]);
            __builtin_amdgcn_sched_barrier(0);
        }
        {
            float s1 = 0.f;
#pragma unroll
            for (int c = 0; c < 8; ++c) s1 += (accO[c][0] + accO[c][1]) + (accO[c][2] + accO[c][3]);
            s1 += __shfl_xor(s1, 16); s1 += __shfl_xor(s1, 32);
            const float mu = s1 * (1.0f / 128.0f); float s2 = 0.f;
#pragma unroll
            for (int c = 0; c < 8; ++c) { const f32x4 d = accO[c] - mu; s2 += (d[0] * d[0] + d[1] * d[1]) + (d[2] * d[2] + d[3] * d[3]); }
            s2 += __shfl_xor(s2, 16); s2 += __shfl_xor(s2, 32);
            const float rstd = 1.0f / sqrtf(s2 * (1.0f / 128.0f) + EPS);
            const float* gn = F.ret_norm_g + h * HD + 4 * lg;
#pragma unroll
            for (int c = 0; c < 8; ++c) {
                const f32x4 gain = *(const f32x4*)(gn + 16 * c);
                const float g[4] = {bflo(gv[c].x), bfhi(gv[c].x), bflo(gv[c].y), bfhi(gv[c].y)}; float o[4];
#pragma unroll
                for (int r = 0; r < 4; ++r) o[r] = (accO[c][r] - mu) * rstd * gain[r] * g[r];
                ov[c].x = pk2(o[0], o[1]); ov[c].y = pk2(o[2], o[3]);
            }
        }
        RAW_BAR();
#pragma unroll
        for (int c = 0; c < 8; ++c) { accS[c] = accS[c] * gC; u32x2 wv; wv.x = pk2(accS[c][0], accS[c][1]); wv.y = pk2(accS[c][2], accS[c][3]);
            *(LAS u32x2*)(SI + offb(16 * c + l15, 2 * w + (lane >> 5)) + 8 * (lg & 1)) = wv; }
    }
    { bf16_t* prow = mix + (size_t)(b * SEQ + (NCHUNK - 1) * CHK + il) * D + h * HD + 4 * lg;
#pragma unroll
      for (int c = 0; c < 8; ++c) *(u32x2*)(prow + 16 * c) = ov[c]; }
    asm volatile("s_waitcnt vmcnt(0)" ::: "memory"); RAW_BAR();
#undef RET_DMA
}
template <int N> __device__ __forceinline__ float dpp_shr(float old, float src) {
    return __builtin_bit_cast(float, __builtin_amdgcn_update_dpp(__builtin_bit_cast(int, old), __builtin_bit_cast(int, src), 0x110 + N, 0xf, 0xf, false));
}
__device__ __forceinline__ float sigmoidf_(float x) { return __builtin_amdgcn_rcpf(1.0f + __expf(-x)); }
__device__ __forceinline__ float gelu_tanh(float z) { const float y2 = 1.5957691216057308f * (z + 0.044715f * z * z * z); return z * __builtin_amdgcn_rcpf(1.0f + __expf(-y2)); }
template <int N> __device__ __forceinline__ float dpp_shr0(float src) {
    return __builtin_bit_cast(float, __builtin_amdgcn_update_dpp(0, __builtin_bit_cast(int, src), 0x110 + N, 0xf, 0xf, true));
}
__device__ __forceinline__ float row_prefix_sum(float v) { v += dpp_shr0<1>(v); v += dpp_shr0<2>(v); v += dpp_shr0<4>(v); v += dpp_shr0<8>(v); return v; }
__device__ __forceinline__ void lru_unit(Frame& F, int b, int nb) {
    constexpr int RAWB = 132 * 256;
    LAS unsigned char* UI0 = F.lds; LAS unsigned char* RAW0 = F.lds + 65536; LAS float* PART = (LAS float*)(F.lds + 65536 + 2 * RAWB); LAS float* CW = PART + 1024;
    static_assert(65536 + 2 * RAWB + 4096 + 2560 <= LDSCTL_OFF, "LRU scratch below the LDS control words");
    const int lane = lane_id(), w = F.wave, tid = w * 64 + lane, l15 = lane & 15, lg = lane >> 4, cb = 128 * nb;
    const bf16_t* proj = (const bf16_t*)(F.ws + WS_R2);
    bf16_t* mix = (bf16_t*)(F.ws + WS_R1);
    const char* zline = (const char*)(F.ws + WS_CTL + 61440);
    const char* ubase = (const char*)(proj + ((size_t)(32 + nb) * T + b * SEQ) * HD);
#define LRU_DMA(n_, buf) do { _Pragma("unroll") for (int _i = 0; _i < 5; ++_i) { if (_i < 4 || w == 0) { const int _r = (_i < 4 ? 16 * w + 4 * _i : 128) + lg; int _pos = 128 * (n_) - 3 + _r; _pos = _pos > SEQ - 1 ? SEQ - 1 : _pos; \
        const char* _src = _pos < 0 ? zline + 16 * l15 : ubase + (size_t)_pos * (HD * 2) + 16 * (l15 ^ (_r & 15)); GLDS16(_src, (buf) + 256 * (_i < 4 ? 16 * w + 4 * _i : 128)); } } } while (0)
    const int sj = tid >> 2, sc0 = tid & 3;
#define LRU_CONV(RAW, UI) do { _Pragma("unroll") for (int q = 0; q < 4; ++q) { const int ch = sc0 + 4 * q; float a8[8]; \
            { const f32x4 b0 = *(const LAS f32x4*)(CW + 512 + 8 * ch), b1 = *(const LAS f32x4*)(CW + 512 + 8 * ch + 4); a8[0] = b0.x; a8[1] = b0.y; a8[2] = b0.z; a8[3] = b0.w; a8[4] = b1.x; a8[5] = b1.y; a8[6] = b1.z; a8[7] = b1.w; } \
            _Pragma("unroll") for (int k = 0; k < 4; ++k) { const int rr = sj + k; const u32x4 uv = *(const LAS u32x4*)((RAW) + 256 * rr + 16 * (ch ^ (rr & 15))); \
                const f32x4 w0 = *(const LAS f32x4*)(CW + k * 128 + 8 * ch), w1 = *(const LAS f32x4*)(CW + k * 128 + 8 * ch + 4); \
                a8[0] += w0.x * bflo(uv.x); a8[1] += w0.y * bfhi(uv.x); a8[2] += w0.z * bflo(uv.y); a8[3] += w0.w * bfhi(uv.y); \
                a8[4] += w1.x * bflo(uv.z); a8[5] += w1.y * bfhi(uv.z); a8[6] += w1.z * bflo(uv.w); a8[7] += w1.w * bfhi(uv.w); } \
            u32x4 o; o.x = pk2(a8[0], a8[1]); o.y = pk2(a8[2], a8[3]); o.z = pk2(a8[4], a8[5]); o.w = pk2(a8[6], a8[7]); \
            *(LAS u32x4*)((UI) + offb(sj, ch)) = o; } } while (0)
    LRU_DMA(0, RAW0);
    for (int i = tid; i < 640; i += NTHREADS) CW[i] = (i < 512) ? F.conv_w[(i >> 7) * 1024 + cb + (i & 127)] : F.conv_b[cb + i - 512];
    bf16x8 wrf[4], wif[4];
#pragma unroll
    for (int s = 0; s < 4; ++s)
#pragma unroll
        for (int jj = 0; jj < 8; ++jj) { const int c = 32 * s + 8 * lg + jj; const size_t o = ((size_t)(nb * 128 + c)) * 128 + 16 * w + l15;
            wrf[s][jj] = (short)f2bf(F.w_rg[o]); wif[s][jj] = (short)f2bf(F.w_ig[o]); }
    const int d0 = cb + 16 * w + 4 * lg;
    const f32x4 brg = *(const f32x4*)(F.b_rg + d0), big = *(const f32x4*)(F.b_ig + d0), lam = *(const f32x4*)(F.lam + d0), ng = *(const f32x4*)(F.lru_norm_g + d0);
    f32x4 sp;
#pragma unroll
    for (int r = 0; r < 4; ++r) sp[r] = 8.0f * log1pf(expf(-lam[r]));
    f32x4 Hc = (f32x4){0.f, 0.f, 0.f, 0.f};
    const bf16_t* zbase = proj + ((size_t)(40 + nb) * T + b * SEQ + l15) * HD + 16 * w + 4 * lg;
    bf16_t* obase = mix + (size_t)(b * SEQ + l15) * D + 1024 + d0;
    asm volatile("s_waitcnt vmcnt(0)" ::: "memory"); RAW_BAR();
    LRU_DMA(1, RAW0 + RAWB);
    LRU_CONV(RAW0, UI0);
    u32x2 zv[8];
#pragma unroll
    for (int tt = 0; tt < 8; ++tt) zv[tt] = *(const u32x2*)(zbase + (size_t)(16 * tt) * HD);
    RAW_BAR();
#pragma unroll 1
    for (int n = 0; n < NCHUNK; ++n) {
        LAS unsigned char* UI = UI0 + (n & 1) * 32768;
        f32x4 hv[8]; float ssq[8];
        f32x4 aR = (f32x4){0.f, 0.f, 0.f, 0.f}, aI = (f32x4){0.f, 0.f, 0.f, 0.f};
#pragma unroll
        for (int s = 0; s < 4; ++s) { const bf16x8 uf = row_frag(UI, lane, 0, s); aR = MFMA16(wrf[s], uf, aR); aI = MFMA16(wif[s], uf, aI); }
#pragma unroll
        for (int tt = 0; tt < 8; ++tt) {
            f32x4 aRn = (f32x4){0.f, 0.f, 0.f, 0.f}, aIn = (f32x4){0.f, 0.f, 0.f, 0.f};
            if (tt < 7) {
#pragma unroll
                for (int s = 0; s < 4; ++s) { const bf16x8 uf = row_frag(UI, lane, tt + 1, s); aRn = MFMA16(wrf[s], uf, aRn); aIn = MFMA16(wif[s], uf, aIn); } }
            const int dl = 16 * w + 4 * lg;
            const u32x2 ucv = *(const LAS u32x2*)(UI + offb(16 * tt + l15, dl >> 3) + (dl & 7) * 2);
            const float uc[4] = {bflo(ucv.x), bfhi(ucv.x), bflo(ucv.y), bfhi(ucv.y)};
            float q = 0.f;
#pragma unroll
            for (int r = 0; r < 4; ++r) {
                const float rg = sigmoidf_(aR[r] + brg[r]), ig = sigmoidf_(aI[r] + big[r]);
                const float L = -sp[r] * rg;
                const float P = row_prefix_sum(L);
                const float bx = __builtin_amdgcn_sqrtf(fmaxf(1.0f - __expf(2.0f * L), 0.f)) * ig * uc[r];
                float hh;
                if (__builtin_expect(__any(P < -40.0f), 0)) {
                    float A = __expf(L), B = bx;
                    { const float Ap = dpp_shr<1>(1.0f, A), Bp = dpp_shr<1>(0.0f, B); B = A * Bp + B; A = A * Ap; }
                    { const float Ap = dpp_shr<2>(1.0f, A), Bp = dpp_shr<2>(0.0f, B); B = A * Bp + B; A = A * Ap; }
                    { const float Ap = dpp_shr<4>(1.0f, A), Bp = dpp_shr<4>(0.0f, B); B = A * Bp + B; A = A * Ap; }
                    { const float Ap = dpp_shr<8>(1.0f, A), Bp = dpp_shr<8>(0.0f, B); B = A * Bp + B; A = A * Ap; }
                    hh = A * Hc[r] + B;
                } else {
                    const float E = __expf(P), Ei = __builtin_amdgcn_rcpf(E);
                    const float C = row_prefix_sum(bx * Ei);
                    hh = E * (Hc[r] + C);
                }
                Hc[r] = __shfl(hh, (lane & 48) | 15);
                hv[tt][r] = hh; q += hh * hh;
            }
            q += __shfl_xor(q, 16); q += __shfl_xor(q, 32);
            ssq[tt] = q; aR = aRn; aI = aIn;
            __builtin_amdgcn_sched_barrier(0);
        }
        if (lg == 0) {
#pragma unroll
            for (int tt = 0; tt < 8; ++tt) PART[w * 128 + 16 * tt + l15] = ssq[tt];
        }
        asm volatile("s_waitcnt vmcnt(0)" ::: "memory"); RAW_BAR();
#pragma unroll
        for (int tt = 0; tt < 8; ++tt) {
            const int tk = 16 * tt + l15; float tot = 0.f;
#pragma unroll
            for (int ww = 0; ww < 8; ++ww) tot += PART[ww * 128 + tk];
            const float rs = __builtin_amdgcn_rsqf(tot * (1.0f / 128.0f) + EPS);
            const float z[4] = {bflo(zv[tt].x), bfhi(zv[tt].x), bflo(zv[tt].y), bfhi(zv[tt].y)}; float o[4];
#pragma unroll
            for (int r = 0; r < 4; ++r) o[r] = hv[tt][r] * rs * ng[r] * z[r];
            u32x2 wv; wv.x = pk2(o[0], o[1]); wv.y = pk2(o[2], o[3]);
            *(u32x2*)(obase + (size_t)(n * CHK + 16 * tt) * D) = wv;
        }
        if (n + 1 < NCHUNK) {
            LRU_CONV(RAW0 + ((n + 1) & 1) * RAWB, UI0 + ((n + 1) & 1) * 32768);
#pragma unroll
            for (int tt = 0; tt < 8; ++tt) zv[tt] = *(const u32x2*)(zbase + (size_t)((n + 1) * CHK + 16 * tt) * HD);
        }
        RAW_BAR();
        if (n + 2 < NCHUNK) LRU_DMA(n + 2, RAW0 + (n & 1) * RAWB);
    }
    asm volatile("s_waitcnt vmcnt(0)" ::: "memory"); RAW_BAR();
#undef LRU_DMA
#undef LRU_CONV
}
__device__ __forceinline__ void router_phase(Frame& F) {
    const bf16_t* dl = (const bf16_t*)(F.ws + WS_X1); bf16_t* x1b = (bf16_t*)(F.ws + WS_X1 + 128 * MiB);
    unsigned char* h2 = F.ws + WS_H2;
    const bf16_t* whi = (const bf16_t*)(F.ws + WS_WGT);
    int* tokl = (int*)(F.ws + WS_TOK); float* rss = (float*)(F.ws + WS_RSS); u32x2* apk = (u32x2*)(F.ws + WS_APK); f32x2* aw = (f32x2*)(F.ws + WS_AW);
    const int w = F.wave, lane = lane_id(), l15 = lane & 15, lg = lane >> 4;
    LAS float* LG = (LAS float*)(F.lds + 65536 + w * 4096);
    LAS unsigned char* WB0 = F.lds;
    unsigned wsrc[3];
#pragma unroll
    for (int i = 0; i < 3; ++i) { const unsigned row = 4 * (3 * w + i) + lg; wsrc[i] = row * (D * 2) + 16u * ((unsigned)l15 ^ (row & 15u)); }
#define RT_DMA(kc, buf) do { _Pragma("unroll") for (int _i = 0; _i < 3; ++_i) GLDS16((const char*)whi + wsrc[_i] + (kc) * 256, (buf) + 1024 * (3 * w + _i)); } while (0)
    for (int base = F.vcu * NWAVES; base < T / 16; base += F.G * NWAVES) {
        const int item = base + w; const int r0 = item * 16;
        const float* xr = F.x + (size_t)(r0 + l15) * D + 8 * lg; unsigned char* hr = h2 + (size_t)(r0 + l15) * D + 8 * lg;
        const bf16_t* dr = dl + (size_t)(r0 + l15) * D + 8 * lg; bf16_t* xo = x1b + (size_t)(r0 + l15) * D + 8 * lg;
        f32x4 acc[3]; float ss = 0.f;
#pragma unroll
        for (int ct = 0; ct < 3; ++ct) acc[ct] = (f32x4){0.f, 0.f, 0.f, 0.f};
        f32x4 xa[8]; u32x4 da[4];
        RT_DMA(0, WB0);
#pragma unroll 1
        for (int kc = 0; kc < 16; ++kc) {
            LAS unsigned char* WB = WB0 + (kc & 1) * 24576;
            asm volatile("s_waitcnt vmcnt(0)" ::: "memory"); RAW_BAR();
            if (kc + 1 < 16) { RT_DMA(kc + 1, WB0 + ((kc + 1) & 1) * 24576); }
#pragma unroll
            for (int j = 0; j < 4; ++j) { xa[2 * j] = *(const f32x4*)(xr + 128 * kc + 32 * j); xa[2 * j + 1] = *(const f32x4*)(xr + 128 * kc + 32 * j + 4); da[j] = *(const u32x4*)(dr + 128 * kc + 32 * j); }
#pragma unroll
            for (int j = 0; j < 4; ++j) {
                const f32x4 a0 = xa[2 * j] + (f32x4){bflo(da[j].x), bfhi(da[j].x), bflo(da[j].y), bfhi(da[j].y)}, a1 = xa[2 * j + 1] + (f32x4){bflo(da[j].z), bfhi(da[j].z), bflo(da[j].w), bfhi(da[j].w)};
                ss += (a0.x * a0.x + a0.y * a0.y) + (a0.z * a0.z + a0.w * a0.w) + (a1.x * a1.x + a1.y * a1.y) + (a1.z * a1.z + a1.w * a1.w);
                const float av[8] = {a0.x, a0.y, a0.z, a0.w, a1.x, a1.y, a1.z, a1.w};
                unsigned hw[4], lw[4];
#pragma unroll
                for (int i = 0; i < 4; ++i) { hw[i] = pk2(av[2 * i], av[2 * i + 1]); lw[i] = pk2(av[2 * i] - bflo(hw[i]), av[2 * i + 1] - bfhi(hw[i])); }
                const u32x4 xh4 = (u32x4){hw[0], hw[1], hw[2], hw[3]}, xl4 = (u32x4){lw[0], lw[1], lw[2], lw[3]};
                *(u32x2*)(hr + 128 * kc + 32 * j) = (u32x2){pk4_fp8(av[0], av[1], av[2], av[3]), pk4_fp8(av[4], av[5], av[6], av[7])};
                *(u32x4*)(xo + 128 * kc + 32 * j) = xh4;
                const bf16x8 xh = __builtin_bit_cast(bf16x8, xh4), xl = __builtin_bit_cast(bf16x8, xl4);
#pragma unroll
                for (int ct = 0; ct < 3; ++ct) { const unsigned rh = 16 * ct + l15, rl = 48 + 16 * ct + l15;
                    const bf16x8 bh = *(const LAS bf16x8*)(WB + 256 * rh + 16 * ((4 * j + lg) ^ (rh & 15))), bl = *(const LAS bf16x8*)(WB + 256 * rl + 16 * ((4 * j + lg) ^ (rl & 15)));
                    acc[ct] = MFMA16(xh, bh, acc[ct]); acc[ct] = MFMA16(xh, bl, acc[ct]); acc[ct] = MFMA16(xl, bh, acc[ct]); }
            }
        }
        ss += __shfl_xor(ss, 16); ss += __shfl_xor(ss, 32);
#pragma unroll
        for (int ct = 0; ct < 3; ++ct)
#pragma unroll
            for (int r = 0; r < 4; ++r) LG[(4 * lg + r) * 48 + 16 * ct + l15] = acc[ct][r];
        LDS_WAIT();
        if (lane < 16) {
            const int t = r0 + lane; const float rs = 1.0f / sqrtf(ss * (1.0f / D) + EPS);
            const LAS float* L = LG + lane * 48;
            float gl[4];
#pragma unroll
            for (int j = 0; j < 4; ++j) gl[j] = L[j] * rs + F.b_group[j];
            int g = 0; float gm = gl[0];
#pragma unroll
            for (int j = 1; j < 4; ++j) if (gl[j] > gm) { gm = gl[j]; g = j; }
            float den = 0.f;
#pragma unroll
            for (int j = 0; j < 4; ++j) den += expf(gl[j] - gm);
            const float gp = 1.0f / den;
            float v[8];
#pragma unroll
            for (int q = 0; q < 8; ++q) v[q] = L[4 + 8 * g + q] * rs + F.b_router[8 * g + q];
            int ia = 0; float va = v[0];
#pragma unroll
            for (int q = 1; q < 8; ++q) if (v[q] > va) { va = v[q]; ia = q; }
            int ib = -1; float vb = -3.0e38f;
#pragma unroll
            for (int q = 0; q < 8; ++q) if (q != ia && v[q] > vb) { vb = v[q]; ib = q; }
            const float wa = 1.0f / (1.0f + expf(vb - va)), wb = 1.0f - wa;
            const int ea = 8 * g + ia, eb = 8 * g + ib;
            const unsigned ra = atomicAdd(F.ctl + CW_CNT + 64 * ea, 1u), rb = atomicAdd(F.ctl + CW_CNT + 64 * eb, 1u);
            tokl[(size_t)ea * CAP + ra] = t; tokl[(size_t)eb * CAP + rb] = t; rss[(size_t)ea * CAP + ra] = rs; rss[(size_t)eb * CAP + rb] = rs;
            apk[t] = (u32x2){((unsigned)ea << 16) | ra, ((unsigned)eb << 16) | rb}; aw[t] = (f32x2){wa * gp, wb * gp};
        }
        LDS_WAIT();
    }
#undef RT_DMA
}
__device__ __forceinline__ void compute_tile_start(Frame& F) {
    LAS int* ts = (LAS int*)(F.lds + TS_OFF); LAS int* cn = (LAS int*)(F.lds + CN_OFF);
    const int tid = F.wave * 64 + lane_id();
    if (tid < NE) { int c = (int)__hip_atomic_load(F.ctl + CW_CNT + 64 * tid, __ATOMIC_RELAXED, __HIP_MEMORY_SCOPE_AGENT); cn[tid] = c < 0 ? 0 : (c > CAP ? CAP : c); }
    __syncthreads();
    if (tid == 0) { int a = 0; for (int e = 0; e < NE; ++e) { ts[e] = a; a += (cn[e] + 255) >> 8; } ts[NE] = a > MAXRT ? MAXRT : a; }
    __syncthreads();
    if (tid < MAXRT) { int e = 0; for (int j = 1; j < NE; ++j) e = (ts[j] <= tid) ? j : e; ((LAS unsigned char*)(F.lds + RE_OFF))[tid] = (unsigned char)e; }
    __syncthreads();
}
__device__ __forceinline__ void combine_phase(Frame& F) {
    const bf16_t* x1 = (const bf16_t*)(F.ws + WS_X1 + 128 * MiB); const unsigned char* Y = F.ws + WS_Y;
    const u32x2* apk = (const u32x2*)(F.ws + WS_APK); const f32x2* aw = (const f32x2*)(F.ws + WS_AW);
    const LAS int* ts = (const LAS int*)(F.lds + TS_OFF);
    const int gw = F.vcu * NWAVES + F.wave, NGW = F.G * NWAVES, lane = lane_id();
    int m = gw; if (m >= T) return;
    u32x2 pk[2]; f32x2 ww[2];
#pragma unroll
    for (int r = 0; r < 2; ++r) { const int mr = m + r * NGW < T ? m + r * NGW : m; pk[r] = apk[mr]; ww[r] = aw[mr]; }
    for (; m < T; m += 2 * NGW) {
        u32x4 xa[2][4]; u32x2 p[2][4], q[2][4]; float w0[2], w1[2]; int mr[2];
#pragma unroll
        for (int r = 0; r < 2; ++r) {
            mr[r] = m + r * NGW < T ? m + r * NGW : m;
            const int e0 = (pk[r].x >> 16) & 31, e1 = (pk[r].y >> 16) & 31;
            const size_t row0 = (size_t)256 * ts[e0] + (pk[r].x & 0xffffu), row1 = (size_t)256 * ts[e1] + (pk[r].y & 0xffffu);
            w0[r] = ww[r].x * (1.0f / SC_Y); w1[r] = ww[r].y * (1.0f / SC_Y);
            const bf16_t* xr = x1 + (size_t)mr[r] * D + 8 * lane; const unsigned char* y0 = Y + row0 * D + 8 * lane; const unsigned char* y1 = Y + row1 * D + 8 * lane;
#pragma unroll
            for (int j = 0; j < 4; ++j) { xa[r][j] = *(const u32x4*)(xr + 512 * j); p[r][j] = *(const u32x2*)(y0 + 512 * j); q[r][j] = *(const u32x2*)(y1 + 512 * j); }
        }
#pragma unroll
        for (int r = 0; r < 2; ++r) { const int mn = m + (2 + r) * NGW < T ? m + (2 + r) * NGW : mr[r]; pk[r] = apk[mn]; ww[r] = aw[mn]; }
#pragma unroll
        for (int r = 0; r < 2; ++r) {
            float v[4][8]; float ss = 0.f;
#pragma unroll
            for (int j = 0; j < 4; ++j) {
                const f32x2 p0 = __builtin_amdgcn_cvt_pk_f32_fp8((int)p[r][j].x, false), p1 = __builtin_amdgcn_cvt_pk_f32_fp8((int)p[r][j].x, true), p2 = __builtin_amdgcn_cvt_pk_f32_fp8((int)p[r][j].y, false), p3 = __builtin_amdgcn_cvt_pk_f32_fp8((int)p[r][j].y, true);
                const f32x2 q0 = __builtin_amdgcn_cvt_pk_f32_fp8((int)q[r][j].x, false), q1 = __builtin_amdgcn_cvt_pk_f32_fp8((int)q[r][j].x, true), q2 = __builtin_amdgcn_cvt_pk_f32_fp8((int)q[r][j].y, false), q3 = __builtin_amdgcn_cvt_pk_f32_fp8((int)q[r][j].y, true);
                const u32x4 xw = xa[r][j];
                v[j][0] = bflo(xw.x) + w0[r] * p0.x + w1[r] * q0.x; v[j][1] = bfhi(xw.x) + w0[r] * p0.y + w1[r] * q0.y;
                v[j][2] = bflo(xw.y) + w0[r] * p1.x + w1[r] * q1.x; v[j][3] = bfhi(xw.y) + w0[r] * p1.y + w1[r] * q1.y;
                v[j][4] = bflo(xw.z) + w0[r] * p2.x + w1[r] * q2.x; v[j][5] = bfhi(xw.z) + w0[r] * p2.y + w1[r] * q2.y;
                v[j][6] = bflo(xw.w) + w0[r] * p3.x + w1[r] * q3.x; v[j][7] = bfhi(xw.w) + w0[r] * p3.y + w1[r] * q3.y;
#pragma unroll
                for (int i = 0; i < 8; ++i) ss += v[j][i] * v[j][i];
            }
            const float rs = 1.0f / sqrtf(wave_sum(ss) * (1.0f / D) + EPS);
            if (r == 0 || m + NGW < T) {
                float* orow = F.out + (size_t)mr[r] * D + 8 * lane; const float* gf = F.norm_final_g + 8 * lane;
#pragma unroll
                for (int j = 0; j < 4; ++j) { const f32x4 g0 = *(const f32x4*)(gf + 512 * j), g1 = *(const f32x4*)(gf + 512 * j + 4);
                    *(f32x4*)(orow + 512 * j) = (f32x4){v[j][0] * rs * g0.x, v[j][1] * rs * g0.y, v[j][2] * rs * g0.z, v[j][3] * rs * g0.w};
                    *(f32x4*)(orow + 512 * j + 4) = (f32x4){v[j][4] * rs * g1.x, v[j][5] * rs * g1.y, v[j][6] * rs * g1.z, v[j][7] * rs * g1.w}; }
            }
        }
    }
}
__device__ __forceinline__ void final_norm_only(Frame& F, const float* src) {
    const int gw = F.vcu * NWAVES + F.wave, NGW = F.G * NWAVES, lane = lane_id();
    for (int m = gw; m < T; m += NGW) {
        const f32x4* xr = (const f32x4*)(src + (size_t)m * D) + lane; const f32x4* gr = (const f32x4*)F.norm_final_g + lane;
        f32x4 v[8]; float s = 0.f;
#pragma unroll
        for (int j = 0; j < 8; ++j) { v[j] = xr[64 * j]; s += (v[j].x * v[j].x + v[j].y * v[j].y) + (v[j].z * v[j].z + v[j].w * v[j].w); }
        const float rs = 1.0f / sqrtf(wave_sum(s) * (1.0f / D) + EPS);
        f32x4* o = (f32x4*)(F.out + (size_t)m * D) + lane;
#pragma unroll
        for (int j = 0; j < 8; ++j) { const f32x4 g = gr[64 * j]; o[64 * j] = (f32x4){v[j].x * rs * g.x, v[j].y * rs * g.y, v[j].z * rs * g.z, v[j].w * rs * g.w}; }
    }
}

struct Args { const float* in[22]; float* out; unsigned char* ws; int ph_lo, ph_hi, li, pad; };
__global__ void __launch_bounds__(NTHREADS, 2) hymba_fwd(Args args) {
    extern __shared__ __attribute__((aligned(16))) unsigned char lds[];
    Frame F;
    F.lds = (LAS unsigned char*)lds;
    F.MISC = (volatile LAS unsigned*)(F.lds + MISC_OFF);
    F.wave = __builtin_amdgcn_readfirstlane(threadIdx.x >> 6);
    F.G = gridDim.x; { const int bx = blockIdx.x; F.vcu = (F.G % 8 == 0) ? (bx % 8) * (F.G / 8) + bx / 8 : bx; }
    unsigned char* ws = args.ws; F.ws = ws; F.ctl = (unsigned*)(ws + WS_CTL); F.out = args.out;
    F.x = args.in[0]; F.norm_mix_g = args.in[1]; F.w_in = args.in[2]; F.ret_norm_g = args.in[3]; F.conv_w = args.in[4]; F.conv_b = args.in[5]; F.w_rg = args.in[6]; F.b_rg = args.in[7];
    F.w_ig = args.in[8]; F.b_ig = args.in[9]; F.lam = args.in[10]; F.lru_norm_g = args.in[11]; F.w_out = args.in[12]; F.norm_ffn_g = args.in[13]; F.w_group = args.in[14]; F.b_group = args.in[15];
    F.w_router = args.in[16]; F.b_router = args.in[17]; F.w_gate = args.in[18]; F.w_up = args.in[19]; F.w_down = args.in[20]; F.norm_final_g = args.in[21];
    for (int u = threadIdx.x; u < (LDS_BYTES - LDSCTL_OFF) / 4; u += NTHREADS) ((LAS unsigned*)(F.lds + LDSCTL_OFF))[u] = 0u;
    __syncthreads();
    const int lo = args.ph_lo, hi = args.ph_hi;
    XcdBarrier bar; bar.bar = F.ctl + CW_BAR; bar.x = 0; bar.st = nullptr;
    if (hi - lo > 1) bar = xcd_barrier_post(F.ctl + CW_BAR, F.MISC + 8);
#define IN(k) (lo <= (k) && (k) < hi)
#define BOTH(k) (IN(k) && IN((k) + 1))
#define GRID_BAR() xcd_barrier(bar)

    if (IN(0)) { p0_prologue(F); if (BOTH(0)) GRID_BAR(); }
    if (IN(1)) {
        const int G1 = (F.G > 2 * NCONV) ? F.G - NCONV : F.G;
        if ((int)blockIdx.x < G1) {
        pg8::DenseSched<D, T / 256, PROJ / 256, true, true> S; S.so.init(T, PROJ, G1, (int)blockIdx.x); S.A = (const char*)(ws + WS_R1); S.B = (const char*)(ws + WS_WIN);
        pg8::EpiProj E{(bf16_t*)(ws + WS_R2), PROJ, (const float*)(ws + WS_ROPE), (const float*)(ws + WS_ROPE) + SEQ * 64};
        pg8::gemm_phase<pg8::EpiProj, pg8::DenseSched<D, T / 256, PROJ / 256, true, true>, D, true, PG8_ALIGN, PG8_SP2>(F.lds, S, E, F.wave);
        }
        convert_queue(F);
        if (BOTH(1)) GRID_BAR();
    }
    if (IN(2)) {
        for (int u = (int)blockIdx.x; u < 128; u += F.G) retention_unit(F, u >> 3, u & 7);
        for (int u = (int)((blockIdx.x + (unsigned)F.G - (128u % (unsigned)F.G)) % (unsigned)F.G); u < 128; u += F.G) lru_unit(F, u >> 3, u & 7);
        if (BOTH(2)) GRID_BAR();
    }
    if (IN(3)) {
        pg8::DenseSched<D, T / 256, D / 256, false, true> S; S.so.init(T, D, F.G, (int)blockIdx.x); S.A = (const char*)(ws + WS_R1); S.B = (const char*)(ws + WS_WOUT);
        pg8::EpiBf16 E{(bf16_t*)(ws + WS_X1), D, 1.0f};
        pg8::gemm_phase<pg8::EpiBf16, pg8::DenseSched<D, T / 256, D / 256, false, true>, D, true, PG8_ALIGN, PG8_SP2>(F.lds, S, E, F.wave);
        if (BOTH(3)) GRID_BAR();
    }
#if MK_LAST_PHASE <= 4
    if (IN(4)) { final_norm_only(F, (const float*)(ws + WS_X1)); }
#else
    if (IN(4)) { router_phase(F); if (BOTH(4)) GRID_BAR(); }
    if (IN(5)) {
        compute_tile_start(F);
        const LAS int* ts = (const LAS int*)(F.lds + TS_OFF); const LAS int* cn = (const LAS int*)(F.lds + CN_OFF);
        pg8::MoeSched<D / 2, true> S; S.G = F.G; S.c = (int)blockIdx.x; S.nrt = __builtin_amdgcn_readfirstlane(ts[NE]); S.ts = ts; S.cn = cn;
        S.A = (const char*)(ws + WS_H2); S.B = (const char*)(ws + WS_WGU); S.bstride = (size_t)D * D; S.tok = (const int*)(ws + WS_TOK);
        pg8::EpiSwiGLU E{ws + WS_R1, (const float*)(ws + WS_RSS), cn};
        pg8::gemm_phase<pg8::EpiSwiGLU, pg8::MoeSched<D / 2, true>, D / 2, true, PG8_ALIGN, PG8_SP2, true>(F.lds, S, E, F.wave);
        if (BOTH(5)) GRID_BAR();
    }
    if (IN(6)) {
        compute_tile_start(F);
        const LAS int* ts = (const LAS int*)(F.lds + TS_OFF); const LAS int* cn = (const LAS int*)(F.lds + CN_OFF);
        pg8::MoeSched<DE / 2, true, true> S; S.G = F.G; S.c = (int)blockIdx.x; S.nrt = __builtin_amdgcn_readfirstlane(ts[NE]); S.ts = ts; S.cn = cn;
        S.A = (const char*)(ws + WS_R1); S.B = (const char*)(ws + WS_WD); S.bstride = (size_t)D * DE; S.tok = nullptr;
        pg8::EpiFp8 E{ws + WS_Y, D, SC_Y / (SC_HB * SC_WD)};
        pg8::gemm_phase<pg8::EpiFp8, pg8::MoeSched<DE / 2, true, true>, DE / 2, true, PG8_ALIGN, PG8_SP2, true>(F.lds, S, E, F.wave);
        if (BOTH(6)) GRID_BAR();
    }
    if (IN(7)) { compute_tile_start(F); combine_phase(F); }
#endif
#undef IN
#undef BOTH
#undef GRID_BAR
}

extern "C" void kernel_launch(void* const* d_in, const int* in_sizes, int n_in, void* d_out, int out_size, void* d_ws, size_t ws_size, hipStream_t stream) {
    static int grid = 0;
    if (grid == 0) {
        if (n_in != 22 || in_sizes[0] != T * D || out_size != T * D || ws_size < WS_END) { fprintf(stderr, "kernel_launch: unexpected shapes (n_in %d, in0 %d, out %d, ws %zu < %zu); nothing launched\n", n_in, n_in > 0 ? in_sizes[0] : -1, out_size, ws_size, (size_t)WS_END); grid = -1; return; }
        int dev = 0, cus = 0, per_cu = 0;
        if (hipGetDevice(&dev) != hipSuccess || hipDeviceGetAttribute(&cus, hipDeviceAttributeMultiprocessorCount, dev) != hipSuccess) { grid = -1; return; }
        if (hipFuncSetAttribute((const void*)hymba_fwd, hipFuncAttributeMaxDynamicSharedMemorySize, LDS_BYTES) != hipSuccess) { fprintf(stderr, "kernel_launch: hipFuncSetAttribute failed\n"); grid = -1; return; }
        if (hipOccupancyMaxActiveBlocksPerMultiprocessor(&per_cu, (const void*)hymba_fwd, NTHREADS, LDS_BYTES) != hipSuccess || per_cu < 1) { fprintf(stderr, "kernel_launch: occupancy query reports %d blocks per CU\n", per_cu); }
        (void)hipGetLastError();
        grid = cus;
    }
    if (grid < 0) return;
    if (hipMemsetAsync((char*)d_ws + WS_CTL, 0, CTL_ZERO_BYTES, stream) != hipSuccess) return;
    Args a{};
    for (int i = 0; i < 22; ++i) a.in[i] = (const float*)d_in[i];
    a.out = (float*)d_out; a.ws = (unsigned char*)d_ws;
    constexpr int NL = MK_N_LAUNCHES;
    constexpr int LASTP = (MK_LAST_PHASE <= 4) ? 5 : NPHASES;
    if (NL == 1) { a.ph_lo = 0; a.ph_hi = LASTP; a.li = 0; hipLaunchKernelGGL(hymba_fwd, dim3(grid), dim3(NTHREADS), LDS_BYTES, stream, a); }
    else for (int li = 0; li < LASTP; ++li) { a.ph_lo = li; a.ph_hi = li + 1; a.li = li; hipLaunchKernelGGL(hymba_fwd, dim3(grid), dim3(NTHREADS), LDS_BYTES, stream, a);
        if (li == MK_REPEAT_PHASE) hipLaunchKernelGGL(hymba_fwd, dim3(grid), dim3(NTHREADS), LDS_BYTES, stream, a); }
}
```

```cpp
#include <hip/hip_runtime.h>
#include <cstdio>
#include <cstdint>

#ifndef MK_N_LAUNCHES
#define MK_N_LAUNCHES 1
#endif
#ifndef MK_REPEAT_PHASE
#define MK_REPEAT_PHASE -1
#endif
#ifndef MK_LAST_PHASE
#define MK_LAST_PHASE 8
#endif

#define GAS __attribute__((address_space(1)))
#define LAS __attribute__((address_space(3)))
typedef unsigned short bf16_t;
typedef short bf16x8 __attribute__((ext_vector_type(8)));
typedef short s16x4 __attribute__((ext_vector_type(4)));
typedef float f32x4 __attribute__((ext_vector_type(4)));
typedef float f32x2 __attribute__((ext_vector_type(2)));
typedef unsigned u32x4 __attribute__((ext_vector_type(4)));
typedef unsigned u32x2 __attribute__((ext_vector_type(2)));
typedef GAS unsigned gu32;
typedef int i32x4 __attribute__((ext_vector_type(4)));
typedef int i32x8 __attribute__((ext_vector_type(8)));
constexpr float SC_WGU = 64.0f, SC_WD = 32.0f, SC_HB = 4.0f, SC_Y = 16.0f;

constexpr int T = 32768, D = 2048, SEQ = 2048, NBATCH = 16, PROJ = 6144;
constexpr int NH = 8, HD = 128, CHK = 128, NCHUNK = SEQ / CHK;
constexpr int NLB = 8;
constexpr int NE = 32, DE = 1024;
constexpr int CAP = 32768;
constexpr int MAXRT = 288;
constexpr float EPS = 1e-6f;
constexpr int NWAVES = 8, NTHREADS = 512;
constexpr int NPHASES = 8;

constexpr size_t MiB = 1u << 20;
constexpr size_t WS_CTL = 0, CTL_ZERO_BYTES = 65536;
constexpr size_t WS_TOK = 1 * MiB;
constexpr size_t WS_RSS = 5 * MiB;
constexpr size_t WS_APK = 9 * MiB;
constexpr size_t WS_AW  = 9 * MiB + 512 * 1024;
constexpr size_t WS_ROPE = 10 * MiB;
constexpr size_t WS_WGT = 11 * MiB;
constexpr size_t WS_WIN = 12 * MiB;
constexpr size_t WS_WOUT = 36 * MiB;
constexpr size_t WS_WD = 44 * MiB;
constexpr size_t WS_WGU = 172 * MiB;
constexpr size_t WS_R2 = 428 * MiB;
constexpr size_t WS_H2 = WS_R2, WS_X1 = WS_R2 + 128 * MiB;
constexpr size_t WS_R1 = 812 * MiB;
constexpr size_t WS_Y = WS_WGU;
constexpr size_t WS_END = 956 * MiB;
static_assert(WS_Y + (size_t)MAXRT * 256 * 2048 * 2 <= WS_X1, "y overlays Wgu + h2 only");
static_assert(WS_R1 + (size_t)MAXRT * 256 * 1024 * 2 <= WS_END, "hb fits");
constexpr int CW_BAR = 1024;
constexpr int CW_CNT = 8192;
constexpr int CW_Q = 6144;
constexpr int NCONV = 32;

constexpr int RING_BYTES = 131072;
constexpr int LDSCTL_OFF = 143360, MISC_OFF = LDSCTL_OFF + 320;
constexpr int TS_OFF = LDSCTL_OFF + 1024;
constexpr int CN_OFF = LDSCTL_OFF + 1280;
constexpr int RE_OFF = LDSCTL_OFF + 1536;
constexpr int GT_OFF = LDSCTL_OFF + 2048;
constexpr int LDS_BYTES = 147456;

#define LDS_WAIT() asm volatile("s_waitcnt lgkmcnt(0)" ::: "memory")
#define VM_WAIT() asm volatile("s_waitcnt vmcnt(0)" ::: "memory")
__device__ __forceinline__ unsigned f2bf(float f) { unsigned u = __builtin_bit_cast(unsigned, f); return (u + 0x7fffu + ((u >> 16) & 1u)) >> 16; }
typedef __bf16 hwbf16x2 __attribute__((ext_vector_type(2)));
__device__ __forceinline__ unsigned pk2(float lo, float hi) { const f32x2 v = {lo, hi}; return __builtin_bit_cast(unsigned, __builtin_convertvector(v, hwbf16x2)); }
__device__ __forceinline__ float bflo(unsigned w) { return __builtin_bit_cast(float, w << 16); }
__device__ __forceinline__ float bfhi(unsigned w) { return __builtin_bit_cast(float, w & 0xffff0000u); }
__device__ __forceinline__ float sat8(float x) { return __builtin_amdgcn_fmed3f(x, -448.0f, 448.0f); }
__device__ __forceinline__ unsigned pk4_fp8(float a, float b, float c, float d) { int p = 0; a = sat8(a); b = sat8(b); c = sat8(c); d = sat8(d); p = __builtin_amdgcn_cvt_pk_fp8_f32(a, b, p, false); p = __builtin_amdgcn_cvt_pk_fp8_f32(c, d, p, true); return (unsigned)p; }
__device__ __forceinline__ unsigned cvt_pk_bf16(float lo, float hi) { unsigned r; asm volatile("v_cvt_pk_bf16_f32 %0, %1, %2" : "=v"(r) : "v"(lo), "v"(hi)); return r; }
__device__ __forceinline__ int lane_id() { int l; asm volatile("v_mbcnt_lo_u32_b32 %0, -1, 0\n\tv_mbcnt_hi_u32_b32 %0, -1, %0" : "=v"(l)); return l; }
__device__ __forceinline__ float wave_sum(float v) {
#pragma unroll
    for (int o = 1; o < 64; o <<= 1) v += __shfl_xor(v, o);
    return v;
}

namespace pg8 {
constexpr int BM = 256, BK = 64, HALF = 128, HTB = HALF * BK * 2, STAGE_BYTES = 8 * HTB, NXCD = 8, WGM = 2;
__host__ __device__ __forceinline__ int lds_byte(int r, int c) { const int st = (r >> 4) * 2 + (c >> 5), rr = r & 15, cc = c & 31, ob = rr * 64 + cc * 2; return st * 1024 + (ob ^ (((ob >> 9) & 1) << 5)); }
__host__ __device__ __forceinline__ void stage_rc(int b, int& R, int& C) { const int st = b / 1024, sb = b % 1024, swz = sb ^ (((sb >> 9) & 1) << 5); R = (st >> 1) * 16 + swz / 64; C = (st & 1) * 32 + (swz % 64) / 2; }
__host__ __device__ __forceinline__ int perm32(int rho) { const int n = rho >> 4, i = rho & 15; return 8 * (i >> 2) + 4 * n + (i & 3); }

struct Unit { int pm, pn, e, ti; };

template <int NM, int NN> struct StaticOrder {
    static_assert(NM % WGM == 0 && (NM * NN) % NXCD == 0, "whole 8-row groups, whole XCD shares");
    int G, c;
    __device__ void init(int, int, int G_, int c_) { G = G_; c = c_; }
    __device__ bool next(int i, Unit& u) const {
        constexpr int nwg = NM * NN, q = nwg / NXCD, nig = WGM * NN;
        const int L = i * G + c; if (L >= nwg) return false;
        const int wgid = (L % NXCD) * q + L / NXCD;
        const int gid = wgid / nig, w = wgid % nig;
        u.pm = gid * WGM + (w % WGM); u.pn = w / WGM; u.e = 0; u.ti = 0; return true;
    }
};
template <int K, int NM, int NN, bool ROPE = false, bool IDENT = false> struct DenseSched {
    static constexpr bool ident = IDENT;
    StaticOrder<NM, NN> so; const char* A; const char* B;
    __device__ __forceinline__ bool bsel(const Unit& u) const { return ROPE && u.pn < 8; }
    __device__ __forceinline__ bool next(int i, Unit& u) const { return so.next(i, u); }
    __device__ __forceinline__ const char* a_ptr(const Unit& u) const { return IDENT ? A : A + (size_t)u.pm * (256 * K * 2); }
    __device__ __forceinline__ const char* b_ptr(const Unit& u) const { return B + (size_t)u.pn * (256 * K * 2); }
    __device__ __forceinline__ void gather(const Unit& u, int tid, unsigned (&v)[2][2]) const {
#pragma unroll
        for (int i = 0; i < 2; ++i) { int R, C; stage_rc(tid * 16 + i * 8192, R, C);
#pragma unroll
            for (int h = 0; h < 2; ++h) v[h][i] = ((unsigned)(u.pm * 256 + h * 128 + R) * (unsigned)K + (unsigned)C) * 2u; }
    }
    __device__ __forceinline__ const int* tok_ptr(const Unit&) const { return nullptr; }
    __device__ __forceinline__ int count(const Unit&) const { return 0; }
};
template <int K, bool GATHER, bool IDENT = false> struct MoeSched {
    static constexpr bool ident = IDENT;
    int G, c, nrt; const LAS int* ts; const LAS int* cn;
    const char* A; const char* B; size_t bstride; const int* tok;
    __device__ __forceinline__ bool bsel(const Unit&) const { return false; }
    __device__ __forceinline__ bool next(int i, Unit& u) const {
        int L;
        int rt, pnv;
        if (G == 256) { const int b = i * 8 + (c & 7), s_ = c >> 3; rt = (b >> 1) * 8 + (s_ >> 2); pnv = (b & 1) * 4 + (s_ & 3); L = rt * 8 + pnv; }
        else { L = i * G + c; rt = L >> 3; }
        if (rt >= nrt) return false;
        const int e = __builtin_amdgcn_readfirstlane((int)((const LAS unsigned char*)ts + (RE_OFF - TS_OFF))[rt]);
        u.pm = rt; u.pn = L & 7; u.e = e; u.ti = rt - __builtin_amdgcn_readfirstlane(ts[e]); return true;
    }
    __device__ __forceinline__ const char* a_ptr(const Unit& u) const { return GATHER ? A : A + (size_t)u.pm * (256 * K * 2); }
    __device__ __forceinline__ const char* b_ptr(const Unit& u) const { return B + (size_t)u.e * bstride + (size_t)u.pn * (256 * K * 2); }
    __device__ __forceinline__ const int* tok_ptr(const Unit& u) const { return tok + (size_t)u.e * CAP + u.ti * 256; }
    __device__ __forceinline__ int count(const Unit& u) const { return __builtin_amdgcn_readfirstlane(cn[u.e]); }
    __device__ __forceinline__ void gather(const Unit& u, int tid, unsigned (&v)[2][2]) const {
        const int cnt = __builtin_amdgcn_readfirstlane(cn[u.e]);
#pragma unroll
        for (int i = 0; i < 2; ++i) { int R, C; stage_rc(tid * 16 + i * 8192, R, C);
#pragma unroll
            for (int h = 0; h < 2; ++h) { const int rank = u.ti * 256 + h * 128 + R; int t = 0; if (IDENT) t = u.pm * 256 + h * 128 + R; else if (rank < cnt) t = tok[(size_t)u.e * CAP + rank];
                v[h][i] = ((unsigned)t * (unsigned)K + (unsigned)C) * 2u; } }
    }
};

struct EpiBf16 {
    static constexpr bool PERM = true, BSEL = false;
    bf16_t* O; int ldc; float sc;
    __device__ __forceinline__ void operator()(const f32x4 (&acc)[2][2][4][2], const Unit& u, int wr, int wc, int, int) const {
        const int lane_ = lane_id(), fr = lane_ & 15, fq = lane_ >> 4;
        const int row0 = u.pm * BM + wr * 64 + fr, col0 = u.pn * BM + wc * 32 + 8 * fq;
#pragma unroll
        for (int ai = 0; ai < 2; ++ai)
#pragma unroll
            for (int m = 0; m < 4; ++m) { bf16_t* rowp = O + (size_t)(row0 + ai * HALF + m * 16) * ldc + col0;
#pragma unroll
                for (int bj = 0; bj < 2; ++bj) { const f32x4 v0 = acc[ai][bj][m][0] * sc, v1 = acc[ai][bj][m][1] * sc;
                    u32x4 w; w.x = cvt_pk_bf16(v0[0], v0[1]); w.y = cvt_pk_bf16(v0[2], v0[3]); w.z = cvt_pk_bf16(v1[0], v1[1]); w.w = cvt_pk_bf16(v1[2], v1[3]);
                    *(u32x4*)(rowp + bj * HALF) = w; } }
    }
};
struct EpiFp8 {
    static constexpr bool PERM = true, BSEL = false;
    unsigned char* O; int ldc; float sc;
    __device__ __forceinline__ void operator()(const f32x4 (&acc)[2][2][4][2], const Unit& u, int wr, int wc, int, int) const {
        const int lane_ = lane_id(), fr = lane_ & 15, fq = lane_ >> 4;
        const int row0 = u.pm * BM + wr * 64 + fr, col0 = u.pn * BM + wc * 32 + 8 * fq;
#pragma unroll
        for (int ai = 0; ai < 2; ++ai)
#pragma unroll
            for (int m = 0; m < 4; ++m) { unsigned char* rowp = O + (size_t)(row0 + ai * HALF + m * 16) * ldc + col0;
#pragma unroll
                for (int bj = 0; bj < 2; ++bj) { const f32x4 v0 = acc[ai][bj][m][0] * sc, v1 = acc[ai][bj][m][1] * sc;
                    u32x2 w; w.x = pk4_fp8(v0[0], v0[1], v0[2], v0[3]); w.y = pk4_fp8(v1[0], v1[1], v1[2], v1[3]);
                    *(u32x2*)(rowp + bj * HALF) = w; } }
    }
};
struct EpiProj {
    static constexpr bool PERM = true, BSEL = true;
    bf16_t* O; int ldc; const float* rc; const float* rsn;
    __device__ __forceinline__ void operator()(const f32x4 (&acc)[2][2][4][2], const Unit& u, int wr, int wc, int, int) const {
        const int lane_ = lane_id(), fr = lane_ & 15, fq = lane_ >> 4;
        const int row0 = u.pm * BM + wr * 64 + fr;
        if (u.pn >= 8) {
            const int col0 = wc * 32 + 8 * fq;
            const int act = (u.pn >= 12 && u.pn < 16) ? 1 : (u.pn >= 20 ? 2 : 0);
#pragma unroll
            for (int ai = 0; ai < 2; ++ai)
#pragma unroll
                for (int m = 0; m < 4; ++m) { bf16_t* rowp = O + ((size_t)(2 * u.pn) * T + (row0 + ai * HALF + m * 16)) * HD + col0;
#pragma unroll
                    for (int bj = 0; bj < 2; ++bj) { f32x4 v0 = acc[ai][bj][m][0], v1 = acc[ai][bj][m][1];
                        if (act) {
#pragma unroll
                            for (int j = 0; j < 4; ++j) { const float a = v0[j], b = v1[j];
                                const float ya = act == 1 ? a : 1.5957691216057308f * (a + 0.044715f * a * a * a), yb = act == 1 ? b : 1.5957691216057308f * (b + 0.044715f * b * b * b);
                                v0[j] = a * __builtin_amdgcn_rcpf(1.0f + __expf(-ya)); v1[j] = b * __builtin_amdgcn_rcpf(1.0f + __expf(-yb)); } }
                        u32x4 w; w.x = cvt_pk_bf16(v0[0], v0[1]); w.y = cvt_pk_bf16(v0[2], v0[3]); w.z = cvt_pk_bf16(v1[0], v1[1]); w.w = cvt_pk_bf16(v1[2], v1[3]);
                        *(u32x4*)(rowp + (size_t)bj * T * HD) = w; } }
        } else {
            const bool isq = u.pn < 4; const int f0 = 16 * wc + 4 * fq;
            constexpr float L2G[8] = {-4.580368961312479e-2f, -2.272007650008353e-2f, -1.1315313227834146e-2f, -5.646563141142063e-3f, -2.8205190623786626e-3f, -1.4095702546713536e-3f, -7.046129765893727e-4f, -3.522634716290214e-4f};
            float l2g[2];
#pragma unroll
            for (int bj = 0; bj < 2; ++bj) { const int hh = 2 * (u.pn & 3) + bj; float v = L2G[0];
#pragma unroll
                for (int q = 1; q < 8; ++q) v = (hh == q) ? L2G[q] : v;
                l2g[bj] = v; }
#pragma unroll
            for (int ai = 0; ai < 2; ++ai)
#pragma unroll
                for (int m = 0; m < 4; ++m) { const int row = row0 + ai * HALF + m * 16, pos = row & (SEQ - 1), il = pos & 127;
                    const f32x4 cs = *(const f32x4*)(rc + pos * 64 + f0), sn = *(const f32x4*)(rsn + pos * 64 + f0);
                    bf16_t* rowp = O + ((size_t)(2 * u.pn) * T + row) * HD + f0;
#pragma unroll
                    for (int bj = 0; bj < 2; ++bj) { const float sc = isq ? __builtin_amdgcn_exp2f((float)(il - 127) * l2g[bj]) * 0.08838834764831845f : __builtin_amdgcn_exp2f((float)(127 - il) * l2g[bj]);
                        const f32x4 x1 = acc[ai][bj][m][0], x2 = acc[ai][bj][m][1]; const f32x4 y1 = (x1 * cs - x2 * sn) * sc, y2 = (x1 * sn + x2 * cs) * sc;
                        u32x2 w1, w2; w1.x = cvt_pk_bf16(y1[0], y1[1]); w1.y = cvt_pk_bf16(y1[2], y1[3]); w2.x = cvt_pk_bf16(y2[0], y2[1]); w2.y = cvt_pk_bf16(y2[2], y2[3]);
                        *(u32x2*)(rowp + (size_t)bj * T * HD) = w1; *(u32x2*)(rowp + (size_t)bj * T * HD + 64) = w2; } }
        }
    }
};
struct EpiF32Res {
    static constexpr bool PERM = false, BSEL = false;
    const float* base; float* C; int ldc;
    __device__ __forceinline__ void operator()(const f32x4 (&acc)[2][2][4][2], const Unit& u, int wr, int wc, int, int) const {
        const int lane_ = lane_id(), fr = lane_ & 15, fq = lane_ >> 4;
        const int row0 = u.pm * BM + wr * 64 + fr, col0 = u.pn * BM + wc * 32 + 4 * fq;
#pragma unroll
        for (int ai = 0; ai < 2; ++ai)
#pragma unroll
            for (int m = 0; m < 4; ++m) { const size_t off = (size_t)(row0 + ai * HALF + m * 16) * ldc + col0;
#pragma unroll
                for (int bj = 0; bj < 2; ++bj)
#pragma unroll
                    for (int n = 0; n < 2; ++n) { const f32x4 b = *(const f32x4*)(base + off + bj * HALF + n * 16); *(f32x4*)(C + off + bj * HALF + n * 16) = acc[ai][bj][m][n] + b; }
                if (m == 3) asm volatile("" ::: "memory"); }
    }
};
struct EpiSwiGLU {
    static constexpr bool PERM = true, BSEL = false;
    unsigned char* O; const float* rss; const LAS int* cn;
    __device__ __forceinline__ void operator()(const f32x4 (&acc)[2][2][4][2], const Unit& u, int wr, int wc, int, int) const {
        const int lane_ = lane_id(), fr = lane_ & 15, fq = lane_ >> 4;
        const int cnt = __builtin_amdgcn_readfirstlane(cn[u.e]);
        const int col0 = u.pn * HALF + wc * 32 + 8 * fq;
        float rsv[2][4];
#pragma unroll
        for (int ai = 0; ai < 2; ++ai)
#pragma unroll
            for (int m = 0; m < 4; ++m) { const int rank = u.ti * 256 + ai * HALF + wr * 64 + m * 16 + fr; const float v = rss[(size_t)u.e * CAP + (rank < cnt ? rank : 0)]; rsv[ai][m] = rank < cnt ? v * (1.0f / SC_WGU) : 0.f; }
#pragma unroll
        for (int ai = 0; ai < 2; ++ai)
#pragma unroll
            for (int m = 0; m < 4; ++m) { const int r = ai * HALF + wr * 64 + m * 16 + fr;
                const float rs = rsv[ai][m];
                float o[8];
#pragma unroll
                for (int n = 0; n < 2; ++n)
#pragma unroll
                    for (int j = 0; j < 4; ++j) { const float g = acc[ai][0][m][n][j] * rs, uu = acc[ai][1][m][n][j] * rs; o[n * 4 + j] = SC_HB * g * uu * __builtin_amdgcn_rcpf(1.0f + __expf(-g)); }
                u32x2 w; w.x = pk4_fp8(o[0], o[1], o[2], o[3]); w.y = pk4_fp8(o[4], o[5], o[6], o[7]);
                *(u32x2*)(O + (size_t)(u.pm * BM + r) * DE + col0) = w; }
    }
};

template <class Epi, class Sched, int K, bool GATHER, bool ALIGN_EPI, bool SP2, bool FP8 = false>
__device__ __forceinline__ void gemm_phase(LAS unsigned char* lds, const Sched& S, const Epi& E, int wid) {
    const int lane = lane_id(), tid = wid * 64 + lane, wr = wid >> 2, wc = wid & 3, fr = lane & 15, fq = lane >> 4;
    constexpr int nt = K / BK;
    unsigned voffA[2], voffB[2];
#pragma unroll
    for (int i = 0; i < 2; ++i) { int R, C; stage_rc(tid * 16 + i * 8192, R, C); const int Rb = Epi::PERM ? ((R & ~31) + perm32(R & 31)) : R;
        voffA[i] = (unsigned)(R * K + C) * 2u; voffB[i] = (unsigned)(Rb * K + C) * 2u; }
    unsigned voffB2[2]; bool selC = false, selN = false;
    if constexpr (Epi::BSEL) {
#pragma unroll
        for (int i = 0; i < 2; ++i) { int R, C; stage_rc(tid * 16 + i * 8192, R, C); const int Rb = 64 * ((R >> 4) & 1) + 16 * (R >> 5) + (R & 15); voffB2[i] = (unsigned)(Rb * K + C) * 2u; }
    }
    constexpr size_t kstep = (size_t)(BK * 2);
    constexpr size_t hstep = (size_t)HALF * K * 2;
    const unsigned ldsw = (unsigned)wid * 1024u;
    const int aoff = lds_byte(wr * 64 + fr, fq * 8), boff = lds_byte(wc * 32 + fr, fq * 8);
    unsigned vC[2][2];
    LAS int* gtab = (LAS int*)(lds + (GT_OFF));
#define PG8_SA(b, h) (((b) * 2 + (h)) * HTB)
#define PG8_SB(b, h) ((4 + (b) * 2 + (h)) * HTB)
#define PG8_STAGE(bufoff, gbase, voff) do { _Pragma("unroll") for (int _i = 0; _i < 2; ++_i) \
        __builtin_amdgcn_global_load_lds((const unsigned*)((const char*)(gbase) + (voff)[_i]), (LAS unsigned*)(lds + (bufoff) + ldsw + _i * 8192), 16, 0, 0); } while (0)
#define PG8_STAGE_A(bufoff, gp, h, nx) do { if constexpr (GATHER) PG8_STAGE(bufoff, gp, vC[h]); else PG8_STAGE(bufoff, (gp) + (h) * hstep, voffA); } while (0)
#define PG8_SWITCH() do { if constexpr (GATHER) { if (last && has_next) { const int _cnt = S.count(nxt); _Pragma("unroll") for (int _i = 0; _i < 2; ++_i) { int _R, _C; stage_rc(tid * 16 + _i * 8192, _R, _C); \
        _Pragma("unroll") for (int _h = 0; _h < 2; ++_h) { const int _r = _h * 128 + _R; int _t; if constexpr (Sched::ident) _t = nxt.pm * 256 + _r; else { _t = gtab[_r]; _t = (nxt.ti * 256 + _r < _cnt) ? _t : 0; } vC[_h][_i] = ((unsigned)_t * (unsigned)K + (unsigned)_C) * 2u; } } } } } while (0)
#define PG8_STAGE_B(bufoff, gp, nx) do { if constexpr (Epi::BSEL) { const bool _s = (nx) ? selN : selC; if (_s) PG8_STAGE(bufoff, gp, voffB2); else PG8_STAGE(bufoff, gp, voffB); } else PG8_STAGE(bufoff, gp, voffB); } while (0)
#define PG8_LD8(p) __builtin_shufflevector(*(const LAS i32x4*)(p), *(const LAS i32x4*)((p) + 1024), 0, 1, 2, 3, 4, 5, 6, 7)
#define PG8_LDA(dst, b, h) do { _Pragma("unroll") for (int m = 0; m < 4; ++m) { if constexpr (FP8) dst##8[m] = PG8_LD8(lds + PG8_SA(b, h) + aoff + m * 2048); else { _Pragma("unroll") for (int k = 0; k < 2; ++k) dst[m][k] = *(const LAS bf16x8*)(lds + PG8_SA(b, h) + aoff + m * 2048 + k * 1024); } } } while (0)
#define PG8_LDB(dst, b, h) do { _Pragma("unroll") for (int n = 0; n < 2; ++n) { if constexpr (FP8) dst##8[n] = PG8_LD8(lds + PG8_SB(b, h) + boff + n * 2048); else { _Pragma("unroll") for (int k = 0; k < 2; ++k) dst[n][k] = *(const LAS bf16x8*)(lds + PG8_SB(b, h) + boff + n * 2048 + k * 1024); } } } while (0)
#define PG8_MMA(ai, bj, At, Bt) do { __builtin_amdgcn_s_setprio(1); _Pragma("unroll") for (int m = 0; m < 4; ++m) _Pragma("unroll") for (int n = 0; n < 2; ++n) { \
        if constexpr (FP8) acc[ai][bj][m][n] = __builtin_amdgcn_mfma_scale_f32_16x16x128_f8f6f4(Bt##8[n], At##8[m], acc[ai][bj][m][n], 0, 0, 0, 0x7f7f7f7f, 0, 0x7f7f7f7f); \
        else { _Pragma("unroll") for (int k = 0; k < 2; ++k) acc[ai][bj][m][n] = __builtin_amdgcn_mfma_f32_16x16x32_bf16(Bt[n][k], At[m][k], acc[ai][bj][m][n], 0, 0, 0); } } \
        __builtin_amdgcn_s_setprio(0); } while (0)
#define PG8_WAIT_V(n) asm volatile("s_waitcnt vmcnt(" #n ")" ::: "memory")
#define PG8_WAIT_L(n) asm volatile("s_waitcnt lgkmcnt(" #n ")" ::: "memory")
#define PG8_BAR __builtin_amdgcn_s_barrier()
#define PG8_SCHED __builtin_amdgcn_sched_barrier(0)
    Unit cur, nxt; int ui = 0;
    if (!S.next(0, cur)) return;
    f32x4 acc[2][2][4][2];
#pragma unroll
    for (int a = 0; a < 2; ++a)
#pragma unroll
        for (int b = 0; b < 2; ++b)
#pragma unroll
            for (int m = 0; m < 4; ++m)
#pragma unroll
                for (int n = 0; n < 2; ++n) acc[a][b][m][n] = (f32x4){0.f, 0.f, 0.f, 0.f};
    bf16x8 At[4][2], B0[2][2], B1[2][2]; i32x8 At8[4], B08[2], B18[2];
    const char* cA = S.a_ptr(cur); const char* cB = S.b_ptr(cur);
    if constexpr (GATHER) { S.gather(cur, tid, vC); }
    if constexpr (Epi::BSEL) selC = S.bsel(cur);
    if constexpr (SP2) {
        PG8_STAGE_B(PG8_SB(0, 0), cB, false); PG8_STAGE_B(PG8_SB(0, 1), cB + hstep, false); PG8_STAGE_A(PG8_SA(0, 0), cA, 0, false); PG8_STAGE_A(PG8_SA(0, 1), cA, 1, false);
        if (wr == 1) PG8_BAR;
        PG8_WAIT_V(2); PG8_BAR;
        PG8_STAGE_B(PG8_SB(1, 0), cB + kstep, false); PG8_STAGE_A(PG8_SA(1, 0), cA + kstep, 0, false); PG8_STAGE_B(PG8_SB(1, 1), cB + hstep + kstep, false);
        PG8_WAIT_V(6); PG8_BAR;
    } else {
        PG8_STAGE_B(PG8_SB(0, 0), cB, false); PG8_STAGE_A(PG8_SA(0, 0), cA, 0, false); PG8_STAGE_B(PG8_SB(0, 1), cB + hstep, false); PG8_STAGE_A(PG8_SA(0, 1), cA, 1, false);
        if (wr == 1) PG8_BAR;
        PG8_WAIT_V(4); PG8_BAR;
        PG8_STAGE_B(PG8_SB(1, 0), cB + kstep, false); PG8_STAGE_A(PG8_SA(1, 0), cA + kstep, 0, false); PG8_STAGE_B(PG8_SB(1, 1), cB + hstep + kstep, false);
        PG8_WAIT_V(6); PG8_BAR;
    }
    for (;;) {
        const bool has_next = S.next(ui + 1, nxt);
        const char* nA = has_next ? S.a_ptr(nxt) : cA; const char* nB = has_next ? S.b_ptr(nxt) : cB;
        if constexpr (Epi::BSEL) selN = has_next ? S.bsel(nxt) : selC;
        if constexpr (GATHER && !Sched::ident) { if (has_next && wid < 4) __builtin_amdgcn_global_load_lds((const unsigned*)(S.tok_ptr(nxt) + wid * 64 + lane), (LAS unsigned*)(gtab + wid * 64), 4, 0, 0); }
#pragma unroll 1
        for (int t = 0; t < nt; t += 2) {
            const bool last = (t == nt - 2);
            const char* a1 = cA + (size_t)(t + 1) * kstep;
            const char* a2 = last ? nA : cA + (size_t)(t + 2) * kstep; const char* b2 = last ? nB : cB + (size_t)(t + 2) * kstep;
            const char* a3 = a2 + kstep; const char* b3 = b2 + kstep;
            if constexpr (SP2) {
            PG8_LDB(B0, 0, 0); PG8_LDB(B1, 0, 1); PG8_SCHED; PG8_LDA(At, 0, 0); PG8_STAGE_A(PG8_SA(1, 1), a1, 1, false); PG8_SWITCH();
            PG8_WAIT_V(8); PG8_WAIT_L(0); PG8_BAR; PG8_MMA(0, 0, At, B0); PG8_MMA(0, 1, At, B1); PG8_BAR; PG8_SCHED;
            PG8_LDA(At, 0, 1); PG8_STAGE_B(PG8_SB(0, 0), b2, last); PG8_STAGE_B(PG8_SB(0, 1), b2 + hstep, last); PG8_STAGE_A(PG8_SA(0, 0), a2, 0, last);
            PG8_WAIT_V(8); PG8_WAIT_L(0); PG8_BAR; PG8_MMA(1, 0, At, B0); PG8_MMA(1, 1, At, B1); PG8_BAR; PG8_SCHED;
            PG8_LDB(B0, 1, 0); PG8_LDB(B1, 1, 1); PG8_SCHED; PG8_LDA(At, 1, 0); PG8_STAGE_A(PG8_SA(0, 1), a2, 1, last);
            PG8_WAIT_V(8); PG8_WAIT_L(0); PG8_BAR; PG8_MMA(0, 0, At, B0); PG8_MMA(0, 1, At, B1); PG8_BAR; PG8_SCHED;
            PG8_LDA(At, 1, 1); PG8_STAGE_B(PG8_SB(1, 0), b3, last); PG8_STAGE_B(PG8_SB(1, 1), b3 + hstep, last); PG8_STAGE_A(PG8_SA(1, 0), a3, 0, last);
            PG8_WAIT_V(8); PG8_WAIT_L(0); PG8_BAR; PG8_MMA(1, 0, At, B0); PG8_MMA(1, 1, At, B1); PG8_BAR; PG8_SCHED;
            } else {
            PG8_LDB(B0, 0, 0); PG8_SCHED; PG8_LDA(At, 0, 0); PG8_STAGE_A(PG8_SA(1, 1), a1, 1, false); PG8_SWITCH();
            PG8_WAIT_L(8); PG8_BAR; PG8_WAIT_L(0); PG8_MMA(0, 0, At, B0); PG8_BAR; PG8_SCHED;
            PG8_LDB(B1, 0, 1); PG8_STAGE_B(PG8_SB(0, 0), b2, last);
            PG8_BAR; PG8_WAIT_L(0); PG8_MMA(0, 1, At, B1); PG8_BAR;
            PG8_LDA(At, 0, 1); PG8_STAGE_A(PG8_SA(0, 0), a2, 0, last);
            PG8_BAR; PG8_WAIT_L(0); PG8_MMA(1, 0, At, B0); PG8_BAR; PG8_SCHED;
            PG8_STAGE_B(PG8_SB(0, 1), b2 + hstep, last);
            PG8_WAIT_V(6); PG8_BAR; PG8_MMA(1, 1, At, B1); PG8_BAR;
            PG8_LDB(B0, 1, 0); PG8_SCHED; PG8_LDA(At, 1, 0); PG8_STAGE_A(PG8_SA(0, 1), a2, 1, last);
            PG8_WAIT_L(8); PG8_BAR; PG8_WAIT_L(0); PG8_MMA(0, 0, At, B0); PG8_BAR; PG8_SCHED;
            PG8_LDB(B1, 1, 1); PG8_STAGE_B(PG8_SB(1, 0), b3, last);
            PG8_BAR; PG8_WAIT_L(0); PG8_MMA(0, 1, At, B1); PG8_BAR;
            PG8_LDA(At, 1, 1); PG8_STAGE_A(PG8_SA(1, 0), a3, 0, last);
            PG8_BAR; PG8_WAIT_L(0); PG8_MMA(1, 0, At, B0); PG8_BAR; PG8_SCHED;
            PG8_STAGE_B(PG8_SB(1, 1), b3 + hstep, last);
            PG8_WAIT_V(6); PG8_BAR; PG8_MMA(1, 1, At, B1); PG8_BAR;
            }
        }
        if constexpr (ALIGN_EPI) { if (wr == 0) PG8_BAR; }
        E(acc, cur, wr, wc, fr, fq);
        if (!has_next) break;
#pragma unroll
        for (int a = 0; a < 2; ++a)
#pragma unroll
            for (int b = 0; b < 2; ++b)
#pragma unroll
                for (int m = 0; m < 4; ++m)
#pragma unroll
                    for (int n = 0; n < 2; ++n) acc[a][b][m][n] = (f32x4){0.f, 0.f, 0.f, 0.f};
        cur = nxt; cA = nA; cB = nB; ++ui; selC = selN;
        if constexpr (ALIGN_EPI) { if (wr == 1) PG8_BAR; }
    }
    PG8_WAIT_V(0);
    if constexpr (!ALIGN_EPI) { if (wr == 0) PG8_BAR; }
    PG8_BAR;
#undef PG8_SA
#undef PG8_SB
#undef PG8_STAGE
#undef PG8_STAGE_A
#undef PG8_SWITCH
#undef PG8_STAGE_B
#undef PG8_LDA
#undef PG8_LDB
#undef PG8_MMA
#undef PG8_LD8
#undef PG8_WAIT_V
#undef PG8_WAIT_L
#undef PG8_BAR
#undef PG8_SCHED
}
}

#ifndef PG8_SP2
#define PG8_SP2 true
#endif
#ifndef PG8_ALIGN
#define PG8_ALIGN true
#endif

#define XB_TMO      128
#define XB_XCNT(j)  (256  + 64 * (j))
#define XB_XSUB(j)  (1280 + 64 * (j))
#define XB_XGEN(j)  (2304 + 64 * (j))
#define XB_TOP      3328
#define XB_TOPGEN   3392
#define XCD_BAR_WORDS 3456
#define XB_SPIN_CAP (1u << 18)
__device__ __forceinline__ unsigned xb_ld(unsigned* p)              { return __hip_atomic_load(p, __ATOMIC_RELAXED, __HIP_MEMORY_SCOPE_AGENT); }
__device__ __forceinline__ unsigned xb_add(unsigned* p, unsigned v) { return __hip_atomic_fetch_add(p, v, __ATOMIC_RELAXED, __HIP_MEMORY_SCOPE_AGENT); }
__device__ __forceinline__ unsigned xb_xcc_id() { return (unsigned)__builtin_amdgcn_s_getreg((3 << 11) | 20) & 0xFu; }
#define XB_SPIN(cond, bar) do { unsigned _sp = 0; while (cond) { __builtin_amdgcn_s_sleep(1); \
    if ((++_sp & 255u) == 0u) { if (xb_ld(&(bar)[XB_TMO])) break; if (_sp > XB_SPIN_CAP) { atomicAdd(&(bar)[XB_TMO], 1u); break; } } } } while (0)
struct XcdBarrier { unsigned* bar; unsigned x; volatile LAS unsigned* st; };
__device__ __forceinline__ XcdBarrier xcd_barrier_post(unsigned* bar, volatile LAS unsigned* st) {
    XcdBarrier b; b.bar = bar; b.x = xb_xcc_id(); b.st = st;
    if (threadIdx.x == 0) (void)xb_add(&bar[XB_XCNT(b.x)], 1u);
    return b;
}
__device__ __forceinline__ void xcd_barrier_complete(unsigned* bar, unsigned x, unsigned& nloc, unsigned& nx) {
    const unsigned G = gridDim.x * gridDim.y * gridDim.z;
    unsigned sum, cnt, mine, sp = 0u;
    for (;;) {
        sum = 0u; cnt = 0u; mine = 0u;
#pragma unroll
        for (unsigned j = 0; j < 16; ++j) { const unsigned c = xb_ld(&bar[XB_XCNT(j)]); sum += c; cnt += (c > 0u) ? 1u : 0u; mine = (j == x) ? c : mine; }
        if (sum == G) break;
        __builtin_amdgcn_s_sleep(1);
        if ((++sp & 255u) == 0u) { if (xb_ld(&bar[XB_TMO])) break; if (sp > XB_SPIN_CAP) { atomicAdd(&bar[XB_TMO], 1u); break; } }
    }
    nloc = mine > 0u ? mine : 1u; nx = cnt > 0u ? cnt : 1u;
}
__device__ __forceinline__ void xcd_barrier(const XcdBarrier& b) {
    asm volatile("s_waitcnt vmcnt(0)" ::: "memory");
    __syncthreads();
    if (threadIdx.x == 0) {
        unsigned* bar = b.bar;
        __builtin_amdgcn_s_waitcnt(0);
        unsigned nloc = b.st[0], nx = b.st[1];
        if (nloc == 0u) { xcd_barrier_complete(bar, b.x, nloc, nx); b.st[0] = nloc; b.st[1] = nx; }
        const unsigned old = xb_add(&bar[XB_XSUB(b.x)], 1u);
        const unsigned gen = old / nloc;
        if (old + 1u == (gen + 1u) * nloc) {
            __builtin_amdgcn_fence(__ATOMIC_RELEASE, "agent");
            asm volatile("s_waitcnt vmcnt(0)" ::: "memory");
            const unsigned og = xb_add(&bar[XB_TOP], 1u);
            const unsigned tg = og / nx;
            if (og + 1u == (tg + 1u) * nx) xb_add(&bar[XB_TOPGEN], 1u);
            else XB_SPIN(xb_ld(&bar[XB_TOPGEN]) == tg, bar);
            __builtin_amdgcn_fence(__ATOMIC_ACQUIRE, "agent");
            xb_add(&bar[XB_XGEN(b.x)], 1u);
            asm volatile("s_waitcnt vmcnt(0)" ::: "memory");
        } else {
            XB_SPIN(xb_ld(&bar[XB_XGEN(b.x)]) == gen, bar);
            __builtin_amdgcn_fence(__ATOMIC_ACQUIRE, "agent");
            asm volatile("s_waitcnt vmcnt(0)" ::: "memory");
        }
    }
    __syncthreads();
}

struct Frame {
    LAS unsigned char* lds;
    volatile LAS unsigned* MISC;
    unsigned* ctl;
    int wave, vcu, G;
    const float *x, *norm_mix_g, *w_in, *ret_norm_g, *conv_w, *conv_b, *w_rg, *b_rg, *w_ig, *b_ig, *lam, *lru_norm_g, *w_out, *norm_ffn_g,
                *w_group, *b_group, *w_router, *b_router, *w_gate, *w_up, *w_down, *norm_final_g;
    float* out;
    unsigned char* ws;
};

__device__ __forceinline__ unsigned offb(unsigned row, unsigned ch);
__device__ __forceinline__ bf16x8 tr_frag(LAS unsigned char* img, int lane, int c, int ks);
__device__ __forceinline__ bf16x8 tr_rows(LAS unsigned char* img, int lane, int c, int row0) {
    const unsigned q = (lane & 15) >> 2, p = lane & 3;
    const s16x4 a = __builtin_amdgcn_ds_read_tr16_b64_v4i16((LAS s16x4*)(img + offb(row0 + q, 2 * c + (p >> 1)) + 8 * (p & 1)));
    const s16x4 b = __builtin_amdgcn_ds_read_tr16_b64_v4i16((LAS s16x4*)(img + offb(row0 + 4 + q, 2 * c + (p >> 1)) + 8 * (p & 1)));
    bf16x8 r; r[0] = a[0]; r[1] = a[1]; r[2] = a[2]; r[3] = a[3]; r[4] = b[0]; r[5] = b[1]; r[6] = b[2]; r[7] = b[3]; return r;
}
template <bool F8, bool GK>
__device__ __forceinline__ void p0_transpose_item(const float* W, int N, int k0, int n0, void* WTrow0, int KoutB, const float* gk, float scale, LAS unsigned char* img, int lane) {
    const int l31 = lane & 31, lh = lane >> 5, l15 = lane & 15, g = lane >> 4;
    const float* src = W + (size_t)(k0 + lh) * N + n0 + 4 * l31;
#define P0_OUT(pass) do { LDS_WAIT(); asm volatile("" ::: "memory"); const int kk0 = k0 + 64 * (pass); \
        if constexpr (F8) { _Pragma("unroll") for (int c = 0; c < 8; ++c) { const u32x4 q0 = __builtin_bit_cast(u32x4, tr_rows(img, lane, c, 16 * g)), q1 = __builtin_bit_cast(u32x4, tr_rows(img, lane, c, 16 * g + 8)); \
            u32x4 o; o.x = pk4_fp8(bflo(q0.x), bfhi(q0.x), bflo(q0.y), bfhi(q0.y)); o.y = pk4_fp8(bflo(q0.z), bfhi(q0.z), bflo(q0.w), bfhi(q0.w)); \
            o.z = pk4_fp8(bflo(q1.x), bfhi(q1.x), bflo(q1.y), bfhi(q1.y)); o.w = pk4_fp8(bflo(q1.z), bfhi(q1.z), bflo(q1.w), bfhi(q1.w)); \
            *(u32x4*)((unsigned char*)WTrow0 + (size_t)(16 * c + l15) * KoutB + kk0 + 16 * g) = o; } } \
        else { _Pragma("unroll") for (int c = 0; c < 8; ++c) _Pragma("unroll") for (int ks = 0; ks < 2; ++ks) { const bf16x8 f = tr_frag(img, lane, c, ks); \
            *(bf16x8*)((unsigned char*)WTrow0 + (size_t)(16 * c + l15) * KoutB + 2 * (kk0 + 32 * ks + 8 * g)) = f; } } \
        LDS_WAIT(); asm volatile("" ::: "memory"); } while (0)
#pragma unroll 1
    for (int pass = 0; pass < 2; ++pass) {
#pragma unroll
        for (int half = 0; half < 2; ++half) {
            const int st = 2 * pass + half;
            f32x4 v[16]; float gs[16];
#pragma unroll
            for (int i = 0; i < 16; ++i) v[i] = __builtin_nontemporal_load((const f32x4*)(src + (size_t)(32 * st + 2 * i) * N));
#pragma unroll
            for (int i = 0; i < 16; ++i) gs[i] = GK ? gk[k0 + 32 * st + 2 * i + lh] * scale : scale;
#pragma unroll
            for (int i = 0; i < 16; ++i) { const int kl = 32 * half + 2 * i + lh; const f32x4 x = v[i] * gs[i];
                u32x2 w; w.x = pk2(x.x, x.y); w.y = pk2(x.z, x.w); *(LAS u32x2*)(img + offb(kl, l31 >> 1) + 8 * (l31 & 1)) = w; }
        }
        P0_OUT(pass);
    }
#undef P0_OUT
}
constexpr int I_G = (D / 128) * (DE / 128), I_DN = (DE / 128) * (D / 128), NQ_ITEMS = NE * (2 * I_G + I_DN);
__device__ __forceinline__ void convert_queue(Frame& F) {
    LAS unsigned char* scr = F.lds + F.wave * 16384;
    const int lane = lane_id();
    unsigned char* Wd8 = F.ws + WS_WD; unsigned char* Wgu8 = F.ws + WS_WGU;
    for (;;) {
        unsigned it = 0; if (lane == 0) it = atomicAdd(F.ctl + CW_Q, 1u);
        int r = __builtin_amdgcn_readfirstlane((int)it); if (r >= NQ_ITEMS) break;
        const int e = r / (2 * I_G + I_DN); r -= e * (2 * I_G + I_DN);
        if (r < 2 * I_G) { const int up = r >= I_G; if (up) r -= I_G; const int nblk = DE / 128, kb = r / nblk, nb = r % nblk;
            const float* W = (up ? F.w_up : F.w_gate) + (size_t)e * D * DE;
            unsigned char* row0 = Wgu8 + (size_t)e * D * D + (size_t)(256 * nb + 128 * up) * D;
            p0_transpose_item<true, true>(W, DE, 128 * kb, 128 * nb, row0, D, F.norm_ffn_g, SC_WGU, scr, lane); continue; }
        r -= 2 * I_G;
        { const int nblk = D / 128, kb = r / nblk, nb = r % nblk; p0_transpose_item<true, false>(F.w_down + (size_t)e * DE * D, D, 128 * kb, 128 * nb, Wd8 + (size_t)e * D * DE + (size_t)(128 * nb) * DE, DE, nullptr, SC_WD, scr, lane); }
    }
}
__device__ __forceinline__ void p0_prologue(Frame& F) {
    LAS unsigned char* scr = F.lds + F.wave * 16384;
    const int lane = lane_id(), tid = F.wave * 64 + lane;
    const int gw = F.wave * F.G + F.vcu, NGW = F.G * NWAVES;
    bf16_t* Win_t = (bf16_t*)(F.ws + WS_WIN); bf16_t* Wout_t = (bf16_t*)(F.ws + WS_WOUT);
    constexpr int I_IN = (D / 128) * (PROJ / 128), I_OUT = (D / 128) * (D / 128);
    constexpr int NITEMS = I_IN + I_OUT;
    for (int it = gw; it < NITEMS; it += NGW) {
        int r = it;
        if (r < I_IN) { const int nblk = PROJ / 128, kb = r / nblk, nb = r % nblk; p0_transpose_item<false, false>(F.w_in, PROJ, 128 * kb, 128 * nb, Win_t + (size_t)(128 * nb) * D, D * 2, nullptr, 1.0f, scr, lane); continue; } r -= I_IN;
        { const int nblk = D / 128, kb = r / nblk, nb = r % nblk; p0_transpose_item<false, false>(F.w_out, D, 128 * kb, 128 * nb, Wout_t + (size_t)(128 * nb) * D, D * 2, nullptr, 1.0f, scr, lane); }
    }
    bf16_t* Hb = (bf16_t*)(F.ws + WS_R1);
    for (int m = gw; m < T; m += 2 * NGW) {
        const int m2 = m + NGW < T ? m + NGW : m;
        const f32x4* xr = (const f32x4*)(F.x + (size_t)m * D) + lane; const f32x4* xr2 = (const f32x4*)(F.x + (size_t)m2 * D) + lane; const f32x4* gr = (const f32x4*)F.norm_mix_g + lane;
        f32x4 v[8], v2[8]; float s = 0.f, s2 = 0.f;
#pragma unroll
        for (int j = 0; j < 8; ++j) { v[j] = __builtin_nontemporal_load(xr + 64 * j); v2[j] = __builtin_nontemporal_load(xr2 + 64 * j); }
#pragma unroll
        for (int j = 0; j < 8; ++j) { s += (v[j].x * v[j].x + v[j].y * v[j].y) + (v[j].z * v[j].z + v[j].w * v[j].w); s2 += (v2[j].x * v2[j].x + v2[j].y * v2[j].y) + (v2[j].z * v2[j].z + v2[j].w * v2[j].w); }
        const float rs = 1.0f / sqrtf(wave_sum(s) * (1.0f / D) + EPS), rs2 = 1.0f / sqrtf(wave_sum(s2) * (1.0f / D) + EPS);
        u32x2* o = (u32x2*)(Hb + (size_t)m * D) + lane; u32x2* o2 = (u32x2*)(Hb + (size_t)m2 * D) + lane;
#pragma unroll
        for (int j = 0; j < 8; ++j) { const f32x4 g = gr[64 * j]; u32x2 w; w.x = pk2(v[j].x * rs * g.x, v[j].y * rs * g.y); w.y = pk2(v[j].z * rs * g.z, v[j].w * rs * g.w); o[64 * j] = w;
            u32x2 w2; w2.x = pk2(v2[j].x * rs2 * g.x, v2[j].y * rs2 * g.y); w2.y = pk2(v2[j].z * rs2 * g.z, v2[j].w * rs2 * g.w); o2[64 * j] = w2; }
    }
    const int gt = F.vcu * NTHREADS + tid, NGT = F.G * NTHREADS;
    float* rc = (float*)(F.ws + WS_ROPE); float* rsn = rc + SEQ * 64;
    for (int i = gt; i < SEQ * 64; i += NGT) { const int pos = i >> 6, f = i & 63; const float inv = powf(10000.0f, -(float)f / 64.0f); const float ang = (float)pos * inv; float sv, cv; sincosf(ang, &sv, &cv); rc[i] = cv; rsn[i] = sv; }
    bf16_t* whi = (bf16_t*)(F.ws + WS_WGT); bf16_t* wlo = whi + 48 * D;
    for (int i = gt; i < 48 * D; i += NGT) { const int n = i / D, k = i % D; float v = 0.f;
        if (n < 4) v = F.w_group[k * 4 + n]; else if (n < 36) v = F.w_router[k * 32 + (n - 4)];
        v *= F.norm_ffn_g[k]; const unsigned h = f2bf(v); const float hf = __builtin_bit_cast(float, h << 16); whi[i] = (bf16_t)h; wlo[i] = (bf16_t)f2bf(v - hf); }
}

__device__ __forceinline__ unsigned offb(unsigned row, unsigned ch) { return 256u * row + 16u * (ch ^ (((row & 3u) << 2) | ((row >> 2) & 3u))); }
__device__ __forceinline__ bf16x8 row_frag(LAS unsigned char* img, int lane, int rb, int s) { return *(const LAS bf16x8*)(img + offb((lane & 15) + 16 * rb, 4 * s + (lane >> 4))); }
__device__ __forceinline__ bf16x8 tr_frag(LAS unsigned char* img, int lane, int c, int ks) {
    const unsigned g = lane >> 4, q = (lane & 15) >> 2, p = lane & 3;
    const s16x4 a = __builtin_amdgcn_ds_read_tr16_b64_v4i16((LAS s16x4*)(img + offb(32 * ks + 8 * g + q, 2 * c + (p >> 1)) + 8 * (p & 1)));
    const s16x4 b = __builtin_amdgcn_ds_read_tr16_b64_v4i16((LAS s16x4*)(img + offb(32 * ks + 8 * g + 4 + q, 2 * c + (p >> 1)) + 8 * (p & 1)));
    bf16x8 r; r[0] = a[0]; r[1] = a[1]; r[2] = a[2]; r[3] = a[3]; r[4] = b[0]; r[5] = b[1]; r[6] = b[2]; r[7] = b[3]; return r;
}
#define MFMA16(a, b, c) __builtin_amdgcn_mfma_f32_16x16x32_bf16(a, b, c, 0, 0, 0)
__device__ __forceinline__ bf16x8 tr_frag2(LAS unsigned char* img, int lane, int c, int ks) {
    const unsigned g = lane >> 4, q = (lane & 15) >> 2, p = lane & 3;
    const s16x4 a = __builtin_amdgcn_ds_read_tr16_b64_v4i16((LAS s16x4*)(img + offb(32 * ks + 4 * g + q, 2 * c + (p >> 1)) + 8 * (p & 1)));
    const s16x4 b = __builtin_amdgcn_ds_read_tr16_b64_v4i16((LAS s16x4*)(img + offb(32 * ks + 16 + 4 * g + q, 2 * c + (p >> 1)) + 8 * (p & 1)));
    bf16x8 r; r[0] = a[0]; r[1] = a[1]; r[2] = a[2]; r[3] = a[3]; r[4] = b[0]; r[5] = b[1]; r[6] = b[2]; r[7] = b[3]; return r;
}
__device__ __forceinline__ void glds16_asm(const void* gsrc, unsigned lds_dst) { unsigned keep;
    asm volatile("s_mov_b32 %0, m0\n\ts_mov_b32 m0, %2\n\ts_nop 0\n\tglobal_load_lds_dwordx4 %1, off\n\ts_mov_b32 m0, %0" : "=&s"(keep) : "v"(gsrc), "s"(lds_dst) : "memory"); }
#define GLDS16(gsrc, ldst) glds16_asm((const void*)(gsrc), (unsigned)(unsigned long)(LAS unsigned char*)(ldst))
#define RAW_BAR() do { asm volatile("s_waitcnt lgkmcnt(0)" ::: "memory"); __builtin_amdgcn_s_barrier(); asm volatile("" ::: "memory"); } while (0)
__device__ __forceinline__ void retention_unit(Frame& F, int b, int h) {
    LAS unsigned char* KI = F.lds; LAS unsigned char* VI0 = F.lds + 32768; LAS unsigned char* SI = F.lds + 98304;
    const int lane = lane_id(), w = F.wave, l15 = lane & 15, lg = lane >> 4;
    const int rtw = (w < 4) ? w : 11 - w;
    const float gC = expf(128.0f * log1pf(-exp2f(-5.0f - (float)h)));
    LAS float* GN = (LAS float*)(F.lds + 131072);
    if (w < 2) GN[w * 64 + lane] = F.ret_norm_g[h * HD + w * 64 + lane];
    const bf16_t* proj = (const bf16_t*)(F.ws + WS_R2);
    bf16_t* mix = (bf16_t*)(F.ws + WS_R1);
    f32x4 accS[8];
#pragma unroll
    for (int c = 0; c < 8; ++c) accS[c] = (f32x4){0.f, 0.f, 0.f, 0.f};
    const int il = 16 * rtw + l15;
    unsigned dsrc[4];
#pragma unroll
    for (int i = 0; i < 4; ++i) { const unsigned row = 16 * w + 4 * i + lg; dsrc[i] = row * (HD * 2) + 16u * ((unsigned)l15 ^ (((row & 3u) << 2) | ((row >> 2) & 3u))); }
    const char* kbase = (const char*)(proj + ((size_t)(8 + h) * T + b * SEQ) * HD);
    const size_t vofs = (size_t)8 * T * HD * 2;
    const bf16_t* qbase = proj + ((size_t)h * T + b * SEQ + il) * HD + 8 * lg;
#define RET_DMA(img, base) do { _Pragma("unroll") for (int _i = 0; _i < 4; ++_i) GLDS16((base) + dsrc[_i], (img) + 4096 * w + 1024 * _i); } while (0)
    RET_DMA(KI, kbase); RET_DMA(VI0, kbase + vofs);
    u32x4 qn[4]; u32x2 ov[8];
#pragma unroll
    for (int s = 0; s < 4; ++s) qn[s] = *(const u32x4*)(qbase + 32 * s);
#pragma unroll
    for (int c = 0; c < 8; ++c) *(LAS u32x2*)(SI + offb(16 * c + l15, 2 * w + (lane >> 5)) + 8 * (lg & 1)) = (u32x2){0u, 0u};
#pragma unroll 1
    for (int n = 0; n < NCHUNK; ++n) {
        const int tok0 = b * SEQ + n * CHK;
        LAS unsigned char* VI = VI0 + (n & 1) * 32768;
        asm volatile("s_waitcnt vmcnt(0)" ::: "memory"); RAW_BAR();
        bf16x8 qf[4];
#pragma unroll
        for (int s = 0; s < 4; ++s) qf[s] = __builtin_bit_cast(bf16x8, qn[s]);
        const char* nk = kbase + (size_t)(n + 1) * (CHK * HD * 2);
        if (n + 1 < NCHUNK) {
            RET_DMA(VI0 + ((n + 1) & 1) * 32768, nk + vofs);
#pragma unroll
            for (int s = 0; s < 4; ++s) qn[s] = *(const u32x4*)(qbase + (size_t)(n + 1) * (CHK * HD) + 32 * s);
        }
        if (n > 0) { bf16_t* prow = mix + (size_t)(tok0 - CHK + il) * D + h * HD + 4 * lg;
#pragma unroll
            for (int c = 0; c < 8; ++c) *(u32x2*)(prow + 16 * c) = ov[c]; }
        u32x2 gv[8];
        { const bf16_t* grow = proj + ((size_t)(24 + h) * T + tok0 + il) * HD + 4 * lg;
#pragma unroll
          for (int c = 0; c < 8; ++c) gv[c] = *(const u32x2*)(grow + 16 * c); }
        bf16x8 pf[4];
#pragma unroll
        for (int s = 0; s < 4; ++s) {
            f32x4 sc[2];
#pragma unroll
            for (int t = 0; t < 2; ++t) { const int jt = 2 * s + t; sc[t] = (f32x4){0.f, 0.f, 0.f, 0.f};
#pragma unroll
                for (int k = 0; k < 4; ++k) sc[t] = MFMA16(row_frag(KI, lane, jt, k), qf[k], sc[t]);
                const int j0 = 16 * jt + 4 * lg;
#pragma unroll
                for (int r = 0; r < 4; ++r) sc[t][r] = (j0 + r > il) ? 0.f : sc[t][r]; }
            const u32x4 pw = (u32x4){pk2(sc[0][0], sc[0][1]), pk2(sc[0][2], sc[0][3]), pk2(sc[1][0], sc[1][1]), pk2(sc[1][2], sc[1][3])};
            pf[s] = __builtin_bit_cast(bf16x8, pw);
        }
        bf16x8 ktf[4];
#pragma unroll
        for (int s = 0; s < 4; ++s) ktf[s] = tr_frag2(KI, lane, w, s);
        RAW_BAR();
        if (n + 1 < NCHUNK) RET_DMA(KI, nk);
        f32x4 accO[8];
        bf16x8 vfr[2][4], sfr[2][4];
#pragma unroll
        for (int s = 0; s < 4; ++s) { vfr[0][s] = tr_frag2(VI, lane, 0, s); sfr[0][s] = row_frag(SI, lane, 0, s); }
#pragma unroll
        for (int c = 0; c < 8; ++c) {
            if (c < 7) {
#pragma unroll
                for (int s = 0; s < 4; ++s) { vfr[(c + 1) & 1][s] = tr_frag2(VI, lane, c + 1, s); sfr[(c + 1) & 1][s] = row_frag(SI, lane, c + 1, s); } }
            f32x4 o = (f32x4){0.f, 0.f, 0.f, 0.f};
#pragma unroll
            for (int s = 0; s < 4; ++s) o = MFMA16(vfr[c & 1][s], pf[s], o);
#pragma unroll
            for (int s = 0; s < 4; ++s) o = MFMA16(sfr[c & 1][s], qf[s], o);
            accO[c] = o;
#pragma unroll
            for (int s = 0; s < 4; ++s) accS[c] = MFMA16(ktf[s], vfr[c & 1][s], accS[c]);
            __builtin_amdgcn_sched_barrier(0);
        }
        {
            float s1 = 0.f;
#pragma unroll
            for (int c = 0; c < 8; ++c) s1 += (accO[c][0] + accO[c][1]) + (accO[c][2] + accO[c][3]);
            s1 += __shfl_xor(s1, 16); s1 += __shfl_xor(s1, 32);
            const float mu = s1 * (1.0f / 128.0f); float s2 = 0.f;
#pragma unroll
            for (int c = 0; c < 8; ++c) { const f32x4 d = accO[c] - mu; s2 += (d[0] * d[0] + d[1] * d[1]) + (d[2] * d[2] + d[3] * d[3]); }
            s2 += __shfl_xor(s2, 16); s2 += __shfl_xor(s2, 32);
            const float rstd = 1.0f / sqrtf(s2 * (1.0f / 128.0f) + EPS);
#pragma unroll
            for (int c = 0; c < 8; ++c) {
                const f32x4 gain = *(const LAS f32x4*)(GN + 16 * c + 4 * lg);
                const float g[4] = {bflo(gv[c].x), bfhi(gv[c].x), bflo(gv[c].y), bfhi(gv[c].y)}; float o[4];
#pragma unroll
                for (int r = 0; r < 4; ++r) o[r] = (accO[c][r] - mu) * rstd * gain[r] * g[r];
                ov[c].x = pk2(o[0], o[1]); ov[c].y = pk2(o[2], o[3]);
            }
        }
        RAW_BAR();
#pragma unroll
        for (int c = 0; c < 8; ++c) { accS[c] = accS[c] * gC; u32x2 wv; wv.x = pk2(accS[c][0], accS[c][1]); wv.y = pk2(accS[c][2], accS[c][3]);
            *(LAS u32x2*)(SI + offb(16 * c + l15, 2 * w + (lane >> 5)) + 8 * (lg & 1)) = wv; }
    }
    { bf16_t* prow = mix + (size_t)(b * SEQ + (NCHUNK - 1) * CHK + il) * D + h * HD + 4 * lg;
#pragma unroll
      for (int c = 0; c < 8; ++c) *(u32x2*)(prow + 16 * c) = ov[c]; }
    asm volatile("s_waitcnt vmcnt(0)" ::: "memory"); RAW_BAR();
#undef RET_DMA
}
template <int N> __device__ __forceinline__ float dpp_shr(float old, float src) {
    return __builtin_bit_cast(float, __builtin_amdgcn_update_dpp(__builtin_bit_cast(int, old), __builtin_bit_cast(int, src), 0x110 + N, 0xf, 0xf, false));
}
__device__ __forceinline__ float sigmoidf_(float x) { return __builtin_amdgcn_rcpf(1.0f + __expf(-x)); }
__device__ __forceinline__ float gelu_tanh(float z) { const float y2 = 1.5957691216057308f * (z + 0.044715f * z * z * z); return z * __builtin_amdgcn_rcpf(1.0f + __expf(-y2)); }
template <int N> __device__ __forceinline__ float dpp_shr0(float src) {
    return __builtin_bit_cast(float, __builtin_amdgcn_update_dpp(0, __builtin_bit_cast(int, src), 0x110 + N, 0xf, 0xf, true));
}
__device__ __forceinline__ float row_prefix_sum(float v) { v += dpp_shr0<1>(v); v += dpp_shr0<2>(v); v += dpp_shr0<4>(v); v += dpp_shr0<8>(v); return v; }
__device__ __forceinline__ void lru_unit(Frame& F, int b, int nb) {
    constexpr int RAWB = 132 * 256;
    LAS unsigned char* UI0 = F.lds; LAS unsigned char* RAW0 = F.lds + 65536; LAS float* PART = (LAS float*)(F.lds + 65536 + 2 * RAWB); LAS float* CW = PART + 1024;
    static_assert(65536 + 2 * RAWB + 4096 + 2560 <= LDSCTL_OFF, "LRU scratch below the LDS control words");
    const int lane = lane_id(), w = F.wave, tid = w * 64 + lane, l15 = lane & 15, lg = lane >> 4, cb = 128 * nb;
    const bf16_t* proj = (const bf16_t*)(F.ws + WS_R2);
    bf16_t* mix = (bf16_t*)(F.ws + WS_R1);
    const char* zline = (const char*)(F.ws + WS_CTL + 61440);
    const char* ubase = (const char*)(proj + ((size_t)(32 + nb) * T + b * SEQ) * HD);
#define LRU_DMA(n_, buf) do { _Pragma("unroll") for (int _i = 0; _i < 5; ++_i) { if (_i < 4 || w == 0) { const int _r = (_i < 4 ? 16 * w + 4 * _i : 128) + lg; int _pos = 128 * (n_) - 3 + _r; _pos = _pos > SEQ - 1 ? SEQ - 1 : _pos; \
        const char* _src = _pos < 0 ? zline + 16 * l15 : ubase + (size_t)_pos * (HD * 2) + 16 * (l15 ^ (_r & 15)); GLDS16(_src, (buf) + 256 * (_i < 4 ? 16 * w + 4 * _i : 128)); } } } while (0)
    const int sj = tid >> 2, sc0 = tid & 3;
#define LRU_CONV(RAW, UI) do { _Pragma("unroll") for (int q = 0; q < 4; ++q) { const int ch = sc0 + 4 * q; float a8[8]; \
            { const f32x4 b0 = *(const LAS f32x4*)(CW + 512 + 8 * ch), b1 = *(const LAS f32x4*)(CW + 512 + 8 * ch + 4); a8[0] = b0.x; a8[1] = b0.y; a8[2] = b0.z; a8[3] = b0.w; a8[4] = b1.x; a8[5] = b1.y; a8[6] = b1.z; a8[7] = b1.w; } \
            _Pragma("unroll") for (int k = 0; k < 4; ++k) { const int rr = sj + k; const u32x4 uv = *(const LAS u32x4*)((RAW) + 256 * rr + 16 * (ch ^ (rr & 15))); \
                const f32x4 w0 = *(const LAS f32x4*)(CW + k * 128 + 8 * ch), w1 = *(const LAS f32x4*)(CW + k * 128 + 8 * ch + 4); \
                a8[0] += w0.x * bflo(uv.x); a8[1] += w0.y * bfhi(uv.x); a8[2] += w0.z * bflo(uv.y); a8[3] += w0.w * bfhi(uv.y); \
                a8[4] += w1.x * bflo(uv.z); a8[5] += w1.y * bfhi(uv.z); a8[6] += w1.z * bflo(uv.w); a8[7] += w1.w * bfhi(uv.w); } \
            u32x4 o; o.x = pk2(a8[0], a8[1]); o.y = pk2(a8[2], a8[3]); o.z = pk2(a8[4], a8[5]); o.w = pk2(a8[6], a8[7]); \
            *(LAS u32x4*)((UI) + offb(sj, ch)) = o; } } while (0)
    LRU_DMA(0, RAW0);
    for (int i = tid; i < 640; i += NTHREADS) CW[i] = (i < 512) ? F.conv_w[(i >> 7) * 1024 + cb + (i & 127)] : F.conv_b[cb + i - 512];
    bf16x8 wrf[4], wif[4];
#pragma unroll
    for (int s = 0; s < 4; ++s)
#pragma unroll
        for (int jj = 0; jj < 8; ++jj) { const int c = 32 * s + 8 * lg + jj; const size_t o = ((size_t)(nb * 128 + c)) * 128 + 16 * w + l15;
            wrf[s][jj] = (short)f2bf(F.w_rg[o]); wif[s][jj] = (short)f2bf(F.w_ig[o]); }
    const int d0 = cb + 16 * w + 4 * lg;
    const f32x4 brg = *(const f32x4*)(F.b_rg + d0), big = *(const f32x4*)(F.b_ig + d0), lam = *(const f32x4*)(F.lam + d0), ng = *(const f32x4*)(F.lru_norm_g + d0);
    f32x4 spl;
#pragma unroll
    for (int r = 0; r < 4; ++r) spl[r] = -8.0f * log1pf(expf(-lam[r])) * 1.4426950408889634f;
    f32x4 Hc = (f32x4){0.f, 0.f, 0.f, 0.f};
    const bf16_t* zbase = proj + ((size_t)(40 + nb) * T + b * SEQ + l15) * HD + 16 * w + 4 * lg;
    bf16_t* obase = mix + (size_t)(b * SEQ + l15) * D + 1024 + d0;
    asm volatile("s_waitcnt vmcnt(0)" ::: "memory"); RAW_BAR();
    LRU_DMA(1, RAW0 + RAWB);
    LRU_CONV(RAW0, UI0);
    u32x2 zv[8];
#pragma unroll
    for (int tt = 0; tt < 8; ++tt) zv[tt] = *(const u32x2*)(zbase + (size_t)(16 * tt) * HD);
    RAW_BAR();
#pragma unroll 1
    for (int n = 0; n < NCHUNK; ++n) {
        LAS unsigned char* UI = UI0 + (n & 1) * 32768;
        f32x4 hv[8]; float ssq[8];
        f32x4 aR = (f32x4){0.f, 0.f, 0.f, 0.f}, aI = (f32x4){0.f, 0.f, 0.f, 0.f};
#pragma unroll
        for (int s = 0; s < 4; ++s) { const bf16x8 uf = row_frag(UI, lane, 0, s); aR = MFMA16(wrf[s], uf, aR); aI = MFMA16(wif[s], uf, aI); }
#pragma unroll
        for (int tt = 0; tt < 8; ++tt) {
            f32x4 aRn = (f32x4){0.f, 0.f, 0.f, 0.f}, aIn = (f32x4){0.f, 0.f, 0.f, 0.f};
            if (tt < 7) {
#pragma unroll
                for (int s = 0; s < 4; ++s) { const bf16x8 uf = row_frag(UI, lane, tt + 1, s); aRn = MFMA16(wrf[s], uf, aRn); aIn = MFMA16(wif[s], uf, aIn); } }
            const int dl = 16 * w + 4 * lg;
            const u32x2 ucv = *(const LAS u32x2*)(UI + offb(16 * tt + l15, dl >> 3) + (dl & 7) * 2);
            const f32x4 uc = (f32x4){bflo(ucv.x), bfhi(ucv.x), bflo(ucv.y), bfhi(ucv.y)};
            const f32x4 xr = (aR + brg) * -1.4426950408889634f, xi = (aI + big) * -1.4426950408889634f;
            f32x4 er, ei;
#pragma unroll
            for (int r = 0; r < 4; ++r) { er[r] = __builtin_amdgcn_exp2f(xr[r]); ei[r] = __builtin_amdgcn_exp2f(xi[r]); }
            er = er + 1.0f; ei = ei + 1.0f;
            f32x4 rg, ig;
#pragma unroll
            for (int r = 0; r < 4; ++r) { rg[r] = __builtin_amdgcn_rcpf(er[r]); ig[r] = __builtin_amdgcn_rcpf(ei[r]); }
            const f32x4 la = spl * rg;
            f32x4 A, B;
#pragma unroll
            for (int r = 0; r < 4; ++r) A[r] = __builtin_amdgcn_exp2f(la[r]);
            { f32x4 om = 1.0f - A * A;
#pragma unroll
              for (int r = 0; r < 4; ++r) om[r] = __builtin_amdgcn_sqrtf(fmaxf(om[r], 0.f));
              B = om * ig * uc; }
#define LRU_STEP(N) do { _Pragma("unroll") for (int r = 0; r < 4; ++r) { const float Ap = dpp_shr<N>(1.0f, A[r]), Bp = dpp_shr0<N>(B[r]); B[r] = A[r] * Bp + B[r]; A[r] = A[r] * Ap; } } while (0)
            LRU_STEP(1); LRU_STEP(2); LRU_STEP(4); LRU_STEP(8);
#undef LRU_STEP
            const f32x4 hh = A * Hc + B;
            float q = 0.f;
#pragma unroll
            for (int r = 0; r < 4; ++r) { Hc[r] = __shfl(hh[r], (lane & 48) | 15); q += hh[r] * hh[r]; }
            hv[tt] = hh;
            q += __shfl_xor(q, 16); q += __shfl_xor(q, 32);
            ssq[tt] = q; aR = aRn; aI = aIn;
            __builtin_amdgcn_sched_barrier(0);
        }
        if (lg == 0) {
#pragma unroll
            for (int tt = 0; tt < 8; ++tt) PART[w * 128 + 16 * tt + l15] = ssq[tt];
        }
        asm volatile("s_waitcnt vmcnt(0)" ::: "memory"); RAW_BAR();
#pragma unroll
        for (int tt = 0; tt < 8; ++tt) {
            const int tk = 16 * tt + l15; float tot = 0.f;
#pragma unroll
            for (int ww = 0; ww < 8; ++ww) tot += PART[ww * 128 + tk];
            const float rs = __builtin_amdgcn_rsqf(tot * (1.0f / 128.0f) + EPS);
            const float z[4] = {bflo(zv[tt].x), bfhi(zv[tt].x), bflo(zv[tt].y), bfhi(zv[tt].y)}; float o[4];
#pragma unroll
            for (int r = 0; r < 4; ++r) o[r] = hv[tt][r] * rs * ng[r] * z[r];
            u32x2 wv; wv.x = pk2(o[0], o[1]); wv.y = pk2(o[2], o[3]);
            *(u32x2*)(obase + (size_t)(n * CHK + 16 * tt) * D) = wv;
        }
        if (n + 1 < NCHUNK) {
            LRU_CONV(RAW0 + ((n + 1) & 1) * RAWB, UI0 + ((n + 1) & 1) * 32768);
#pragma unroll
            for (int tt = 0; tt < 8; ++tt) zv[tt] = *(const u32x2*)(zbase + (size_t)((n + 1) * CHK + 16 * tt) * HD);
        }
        RAW_BAR();
        if (n + 2 < NCHUNK) LRU_DMA(n + 2, RAW0 + (n & 1) * RAWB);
    }
    asm volatile("s_waitcnt vmcnt(0)" ::: "memory"); RAW_BAR();
#undef LRU_DMA
#undef LRU_CONV
}
__device__ __forceinline__ void router_phase(Frame& F) {
    const bf16_t* dl = (const bf16_t*)(F.ws + WS_X1); bf16_t* x1b = (bf16_t*)(F.ws + WS_X1 + 128 * MiB);
    unsigned char* h2 = F.ws + WS_H2;
    const bf16_t* whi = (const bf16_t*)(F.ws + WS_WGT);
    int* tokl = (int*)(F.ws + WS_TOK); float* rss = (float*)(F.ws + WS_RSS); u32x2* apk = (u32x2*)(F.ws + WS_APK); f32x2* aw = (f32x2*)(F.ws + WS_AW);
    const int w = F.wave, lane = lane_id(), l15 = lane & 15, lg = lane >> 4;
    LAS float* LG = (LAS float*)(F.lds + 65536 + w * 4096);
    LAS unsigned char* WB0 = F.lds;
    unsigned wsrc[3];
#pragma unroll
    for (int i = 0; i < 3; ++i) { const unsigned row = 4 * (3 * w + i) + lg; wsrc[i] = row * (D * 2) + 16u * ((unsigned)l15 ^ (row & 15u)); }
#define RT_DMA(kc, buf) do { _Pragma("unroll") for (int _i = 0; _i < 3; ++_i) GLDS16((const char*)whi + wsrc[_i] + (kc) * 256, (buf) + 1024 * (3 * w + _i)); } while (0)
    for (int base = F.vcu * NWAVES; base < T / 16; base += F.G * NWAVES) {
        const int item = base + w; const int r0 = item * 16;
        const float* xr = F.x + (size_t)(r0 + l15) * D + 8 * lg; unsigned char* hr = h2 + (size_t)(r0 + l15) * D + 8 * lg;
        const bf16_t* dr = dl + (size_t)(r0 + l15) * D + 8 * lg; bf16_t* xo = x1b + (size_t)(r0 + l15) * D + 8 * lg;
        f32x4 acc[3]; float ss = 0.f;
#pragma unroll
        for (int ct = 0; ct < 3; ++ct) acc[ct] = (f32x4){0.f, 0.f, 0.f, 0.f};
        f32x4 xa[8]; u32x4 da[4];
        RT_DMA(0, WB0);
#pragma unroll 1
        for (int kc = 0; kc < 16; ++kc) {
            LAS unsigned char* WB = WB0 + (kc & 1) * 24576;
            asm volatile("s_waitcnt vmcnt(0)" ::: "memory"); RAW_BAR();
            if (kc + 1 < 16) { RT_DMA(kc + 1, WB0 + ((kc + 1) & 1) * 24576); }
#pragma unroll
            for (int j = 0; j < 4; ++j) { xa[2 * j] = *(const f32x4*)(xr + 128 * kc + 32 * j); xa[2 * j + 1] = *(const f32x4*)(xr + 128 * kc + 32 * j + 4); da[j] = *(const u32x4*)(dr + 128 * kc + 32 * j); }
#pragma unroll
            for (int j = 0; j < 4; ++j) {
                const f32x4 a0 = xa[2 * j] + (f32x4){bflo(da[j].x), bfhi(da[j].x), bflo(da[j].y), bfhi(da[j].y)}, a1 = xa[2 * j + 1] + (f32x4){bflo(da[j].z), bfhi(da[j].z), bflo(da[j].w), bfhi(da[j].w)};
                ss += (a0.x * a0.x + a0.y * a0.y) + (a0.z * a0.z + a0.w * a0.w) + (a1.x * a1.x + a1.y * a1.y) + (a1.z * a1.z + a1.w * a1.w);
                const float av[8] = {a0.x, a0.y, a0.z, a0.w, a1.x, a1.y, a1.z, a1.w};
                unsigned hw[4], lw[4];
#pragma unroll
                for (int i = 0; i < 4; ++i) { hw[i] = pk2(av[2 * i], av[2 * i + 1]); lw[i] = pk2(av[2 * i] - bflo(hw[i]), av[2 * i + 1] - bfhi(hw[i])); }
                const u32x4 xh4 = (u32x4){hw[0], hw[1], hw[2], hw[3]}, xl4 = (u32x4){lw[0], lw[1], lw[2], lw[3]};
                *(u32x2*)(hr + 128 * kc + 32 * j) = (u32x2){pk4_fp8(av[0], av[1], av[2], av[3]), pk4_fp8(av[4], av[5], av[6], av[7])};
                *(u32x4*)(xo + 128 * kc + 32 * j) = xh4;
                const bf16x8 xh = __builtin_bit_cast(bf16x8, xh4), xl = __builtin_bit_cast(bf16x8, xl4);
#pragma unroll
                for (int ct = 0; ct < 3; ++ct) { const unsigned rh = 16 * ct + l15, rl = 48 + 16 * ct + l15;
                    const bf16x8 bh = *(const LAS bf16x8*)(WB + 256 * rh + 16 * ((4 * j + lg) ^ (rh & 15))), bl = *(const LAS bf16x8*)(WB + 256 * rl + 16 * ((4 * j + lg) ^ (rl & 15)));
                    acc[ct] = MFMA16(xh, bh, acc[ct]); acc[ct] = MFMA16(xh, bl, acc[ct]); acc[ct] = MFMA16(xl, bh, acc[ct]); }
            }
        }
        ss += __shfl_xor(ss, 16); ss += __shfl_xor(ss, 32);
#pragma unroll
        for (int ct = 0; ct < 3; ++ct)
#pragma unroll
            for (int r = 0; r < 4; ++r) LG[(4 * lg + r) * 48 + 16 * ct + l15] = acc[ct][r];
        LDS_WAIT();
        if (lane < 16) {
            const int t = r0 + lane; const float rs = 1.0f / sqrtf(ss * (1.0f / D) + EPS);
            const LAS float* L = LG + lane * 48;
            float gl[4];
#pragma unroll
            for (int j = 0; j < 4; ++j) gl[j] = L[j] * rs + F.b_group[j];
            int g = 0; float gm = gl[0];
#pragma unroll
            for (int j = 1; j < 4; ++j) if (gl[j] > gm) { gm = gl[j]; g = j; }
            float den = 0.f;
#pragma unroll
            for (int j = 0; j < 4; ++j) den += expf(gl[j] - gm);
            const float gp = 1.0f / den;
            float v[8];
#pragma unroll
            for (int q = 0; q < 8; ++q) v[q] = L[4 + 8 * g + q] * rs + F.b_router[8 * g + q];
            int ia = 0; float va = v[0];
#pragma unroll
            for (int q = 1; q < 8; ++q) if (v[q] > va) { va = v[q]; ia = q; }
            int ib = -1; float vb = -3.0e38f;
#pragma unroll
            for (int q = 0; q < 8; ++q) if (q != ia && v[q] > vb) { vb = v[q]; ib = q; }
            const float wa = 1.0f / (1.0f + expf(vb - va)), wb = 1.0f - wa;
            const int ea = 8 * g + ia, eb = 8 * g + ib;
            const unsigned ra = atomicAdd(F.ctl + CW_CNT + 64 * ea, 1u), rb = atomicAdd(F.ctl + CW_CNT + 64 * eb, 1u);
            tokl[(size_t)ea * CAP + ra] = t; tokl[(size_t)eb * CAP + rb] = t; rss[(size_t)ea * CAP + ra] = rs; rss[(size_t)eb * CAP + rb] = rs;
            apk[t] = (u32x2){((unsigned)ea << 16) | ra, ((unsigned)eb << 16) | rb}; aw[t] = (f32x2){wa * gp, wb * gp};
        }
        LDS_WAIT();
    }
#undef RT_DMA
}
__device__ __forceinline__ void compute_tile_start(Frame& F) {
    LAS int* ts = (LAS int*)(F.lds + TS_OFF); LAS int* cn = (LAS int*)(F.lds + CN_OFF);
    const int tid = F.wave * 64 + lane_id();
    if (tid < NE) { int c = (int)__hip_atomic_load(F.ctl + CW_CNT + 64 * tid, __ATOMIC_RELAXED, __HIP_MEMORY_SCOPE_AGENT); cn[tid] = c < 0 ? 0 : (c > CAP ? CAP : c); }
    __syncthreads();
    if (tid == 0) { int a = 0; for (int e = 0; e < NE; ++e) { ts[e] = a; a += (cn[e] + 255) >> 8; } ts[NE] = a > MAXRT ? MAXRT : a; }
    __syncthreads();
    if (tid < MAXRT) { int e = 0; for (int j = 1; j < NE; ++j) e = (ts[j] <= tid) ? j : e; ((LAS unsigned char*)(F.lds + RE_OFF))[tid] = (unsigned char)e; }
    __syncthreads();
}
__device__ __forceinline__ void combine_phase(Frame& F) {
    const bf16_t* x1 = (const bf16_t*)(F.ws + WS_X1 + 128 * MiB); const unsigned char* Y = F.ws + WS_Y;
    const u32x2* apk = (const u32x2*)(F.ws + WS_APK); const f32x2* aw = (const f32x2*)(F.ws + WS_AW);
    const LAS int* ts = (const LAS int*)(F.lds + TS_OFF);
    const int gw = F.vcu * NWAVES + F.wave, NGW = F.G * NWAVES, lane = lane_id();
    int m = gw; if (m >= T) return;
    u32x2 pk[2]; f32x2 ww[2];
#pragma unroll
    for (int r = 0; r < 2; ++r) { const int mr = m + r * NGW < T ? m + r * NGW : m; pk[r] = apk[mr]; ww[r] = aw[mr]; }
    for (; m < T; m += 2 * NGW) {
        u32x4 xa[2][4]; u32x2 p[2][4], q[2][4]; float w0[2], w1[2]; int mr[2];
#pragma unroll
        for (int r = 0; r < 2; ++r) {
            mr[r] = m + r * NGW < T ? m + r * NGW : m;
            const int e0 = (pk[r].x >> 16) & 31, e1 = (pk[r].y >> 16) & 31;
            const size_t row0 = (size_t)256 * ts[e0] + (pk[r].x & 0xffffu), row1 = (size_t)256 * ts[e1] + (pk[r].y & 0xffffu);
            w0[r] = ww[r].x * (1.0f / SC_Y); w1[r] = ww[r].y * (1.0f / SC_Y);
            const bf16_t* xr = x1 + (size_t)mr[r] * D + 8 * lane; const unsigned char* y0 = Y + row0 * D + 8 * lane; const unsigned char* y1 = Y + row1 * D + 8 * lane;
#pragma unroll
            for (int j = 0; j < 4; ++j) { xa[r][j] = *(const u32x4*)(xr + 512 * j); p[r][j] = *(const u32x2*)(y0 + 512 * j); q[r][j] = *(const u32x2*)(y1 + 512 * j); }
        }
#pragma unroll
        for (int r = 0; r < 2; ++r) { const int mn = m + (2 + r) * NGW < T ? m + (2 + r) * NGW : mr[r]; pk[r] = apk[mn]; ww[r] = aw[mn]; }
#pragma unroll
        for (int r = 0; r < 2; ++r) {
            float v[4][8]; float ss = 0.f;
#pragma unroll
            for (int j = 0; j < 4; ++j) {
                const f32x2 p0 = __builtin_amdgcn_cvt_pk_f32_fp8((int)p[r][j].x, false), p1 = __builtin_amdgcn_cvt_pk_f32_fp8((int)p[r][j].x, true), p2 = __builtin_amdgcn_cvt_pk_f32_fp8((int)p[r][j].y, false), p3 = __builtin_amdgcn_cvt_pk_f32_fp8((int)p[r][j].y, true);
                const f32x2 q0 = __builtin_amdgcn_cvt_pk_f32_fp8((int)q[r][j].x, false), q1 = __builtin_amdgcn_cvt_pk_f32_fp8((int)q[r][j].x, true), q2 = __builtin_amdgcn_cvt_pk_f32_fp8((int)q[r][j].y, false), q3 = __builtin_amdgcn_cvt_pk_f32_fp8((int)q[r][j].y, true);
                const u32x4 xw = xa[r][j];
                v[j][0] = bflo(xw.x) + w0[r] * p0.x + w1[r] * q0.x; v[j][1] = bfhi(xw.x) + w0[r] * p0.y + w1[r] * q0.y;
                v[j][2] = bflo(xw.y) + w0[r] * p1.x + w1[r] * q1.x; v[j][3] = bfhi(xw.y) + w0[r] * p1.y + w1[r] * q1.y;
                v[j][4] = bflo(xw.z) + w0[r] * p2.x + w1[r] * q2.x; v[j][5] = bfhi(xw.z) + w0[r] * p2.y + w1[r] * q2.y;
                v[j][6] = bflo(xw.w) + w0[r] * p3.x + w1[r] * q3.x; v[j][7] = bfhi(xw.w) + w0[r] * p3.y + w1[r] * q3.y;
#pragma unroll
                for (int i = 0; i < 8; ++i) ss += v[j][i] * v[j][i];
            }
            const float rs = 1.0f / sqrtf(wave_sum(ss) * (1.0f / D) + EPS);
            if (r == 0 || m + NGW < T) {
                float* orow = F.out + (size_t)mr[r] * D + 8 * lane; const float* gf = F.norm_final_g + 8 * lane;
#pragma unroll
                for (int j = 0; j < 4; ++j) { const f32x4 g0 = *(const f32x4*)(gf + 512 * j), g1 = *(const f32x4*)(gf + 512 * j + 4);
                    *(f32x4*)(orow + 512 * j) = (f32x4){v[j][0] * rs * g0.x, v[j][1] * rs * g0.y, v[j][2] * rs * g0.z, v[j][3] * rs * g0.w};
                    *(f32x4*)(orow + 512 * j + 4) = (f32x4){v[j][4] * rs * g1.x, v[j][5] * rs * g1.y, v[j][6] * rs * g1.z, v[j][7] * rs * g1.w}; }
            }
        }
    }
}
__device__ __forceinline__ void final_norm_only(Frame& F, const float* src) {
    const int gw = F.vcu * NWAVES + F.wave, NGW = F.G * NWAVES, lane = lane_id();
    for (int m = gw; m < T; m += NGW) {
        const f32x4* xr = (const f32x4*)(src + (size_t)m * D) + lane; const f32x4* gr = (const f32x4*)F.norm_final_g + lane;
        f32x4 v[8]; float s = 0.f;
#pragma unroll
        for (int j = 0; j < 8; ++j) { v[j] = xr[64 * j]; s += (v[j].x * v[j].x + v[j].y * v[j].y) + (v[j].z * v[j].z + v[j].w * v[j].w); }
        const float rs = 1.0f / sqrtf(wave_sum(s) * (1.0f / D) + EPS);
        f32x4* o = (f32x4*)(F.out + (size_t)m * D) + lane;
#pragma unroll
        for (int j = 0; j < 8; ++j) { const f32x4 g = gr[64 * j]; o[64 * j] = (f32x4){v[j].x * rs * g.x, v[j].y * rs * g.y, v[j].z * rs * g.z, v[j].w * rs * g.w}; }
    }
}

struct Args { const float* in[22]; float* out; unsigned char* ws; int ph_lo, ph_hi, li, pad; };
__global__ void __launch_bounds__(NTHREADS, 2) hymba_fwd(Args args) {
    extern __shared__ __attribute__((aligned(16))) unsigned char lds[];
    Frame F;
    F.lds = (LAS unsigned char*)lds;
    F.MISC = (volatile LAS unsigned*)(F.lds + MISC_OFF);
    F.wave = __builtin_amdgcn_readfirstlane(threadIdx.x >> 6);
    F.G = gridDim.x; { const int bx = blockIdx.x; F.vcu = (F.G % 8 == 0) ? (bx % 8) * (F.G / 8) + bx / 8 : bx; }
    unsigned char* ws = args.ws; F.ws = ws; F.ctl = (unsigned*)(ws + WS_CTL); F.out = args.out;
    F.x = args.in[0]; F.norm_mix_g = args.in[1]; F.w_in = args.in[2]; F.ret_norm_g = args.in[3]; F.conv_w = args.in[4]; F.conv_b = args.in[5]; F.w_rg = args.in[6]; F.b_rg = args.in[7];
    F.w_ig = args.in[8]; F.b_ig = args.in[9]; F.lam = args.in[10]; F.lru_norm_g = args.in[11]; F.w_out = args.in[12]; F.norm_ffn_g = args.in[13]; F.w_group = args.in[14]; F.b_group = args.in[15];
    F.w_router = args.in[16]; F.b_router = args.in[17]; F.w_gate = args.in[18]; F.w_up = args.in[19]; F.w_down = args.in[20]; F.norm_final_g = args.in[21];
    for (int u = threadIdx.x; u < (LDS_BYTES - LDSCTL_OFF) / 4; u += NTHREADS) ((LAS unsigned*)(F.lds + LDSCTL_OFF))[u] = 0u;
    __syncthreads();
    const int lo = args.ph_lo, hi = args.ph_hi;
    XcdBarrier bar; bar.bar = F.ctl + CW_BAR; bar.x = 0; bar.st = nullptr;
    if (hi - lo > 1) bar = xcd_barrier_post(F.ctl + CW_BAR, F.MISC + 8);
#define IN(k) (lo <= (k) && (k) < hi)
#define BOTH(k) (IN(k) && IN((k) + 1))
#define GRID_BAR() xcd_barrier(bar)

    if (IN(0)) { p0_prologue(F); if (BOTH(0)) GRID_BAR(); }
    if (IN(1)) {
        const int G1 = (F.G > 2 * NCONV) ? F.G - NCONV : F.G;
        if ((int)blockIdx.x < G1) {
        pg8::DenseSched<D, T / 256, PROJ / 256, true, true> S; S.so.init(T, PROJ, G1, (int)blockIdx.x); S.A = (const char*)(ws + WS_R1); S.B = (const char*)(ws + WS_WIN);
        pg8::EpiProj E{(bf16_t*)(ws + WS_R2), PROJ, (const float*)(ws + WS_ROPE), (const float*)(ws + WS_ROPE) + SEQ * 64};
        pg8::gemm_phase<pg8::EpiProj, pg8::DenseSched<D, T / 256, PROJ / 256, true, true>, D, true, PG8_ALIGN, PG8_SP2>(F.lds, S, E, F.wave);
        }
        convert_queue(F);
        if (BOTH(1)) GRID_BAR();
    }
    if (IN(2)) {
        for (int u = (int)blockIdx.x; u < 128; u += F.G) retention_unit(F, u >> 3, u & 7);
        for (int u = (int)((blockIdx.x + (unsigned)F.G - (128u % (unsigned)F.G)) % (unsigned)F.G); u < 128; u += F.G) lru_unit(F, u >> 3, u & 7);
        if (BOTH(2)) GRID_BAR();
    }
    if (IN(3)) {
        pg8::DenseSched<D, T / 256, D / 256, false, true> S; S.so.init(T, D, F.G, (int)blockIdx.x); S.A = (const char*)(ws + WS_R1); S.B = (const char*)(ws + WS_WOUT);
        pg8::EpiBf16 E{(bf16_t*)(ws + WS_X1), D, 1.0f};
        pg8::gemm_phase<pg8::EpiBf16, pg8::DenseSched<D, T / 256, D / 256, false, true>, D, true, PG8_ALIGN, PG8_SP2>(F.lds, S, E, F.wave);
        if (BOTH(3)) GRID_BAR();
    }
#if MK_LAST_PHASE <= 4
    if (IN(4)) { final_norm_only(F, (const float*)(ws + WS_X1)); }
#else
    if (IN(4)) { router_phase(F); if (BOTH(4)) GRID_BAR(); }
    if (IN(5)) {
        compute_tile_start(F);
        const LAS int* ts = (const LAS int*)(F.lds + TS_OFF); const LAS int* cn = (const LAS int*)(F.lds + CN_OFF);
        pg8::MoeSched<D / 2, true> S; S.G = F.G; S.c = (int)blockIdx.x; S.nrt = __builtin_amdgcn_readfirstlane(ts[NE]); S.ts = ts; S.cn = cn;
        S.A = (const char*)(ws + WS_H2); S.B = (const char*)(ws + WS_WGU); S.bstride = (size_t)D * D; S.tok = (const int*)(ws + WS_TOK);
        pg8::EpiSwiGLU E{ws + WS_R1, (const float*)(ws + WS_RSS), cn};
        pg8::gemm_phase<pg8::EpiSwiGLU, pg8::MoeSched<D / 2, true>, D / 2, true, PG8_ALIGN, PG8_SP2, true>(F.lds, S, E, F.wave);
        if (BOTH(5)) GRID_BAR();
    }
    if (IN(6)) {
        compute_tile_start(F);
        const LAS int* ts = (const LAS int*)(F.lds + TS_OFF); const LAS int* cn = (const LAS int*)(F.lds + CN_OFF);
        pg8::MoeSched<DE / 2, true, true> S; S.G = F.G; S.c = (int)blockIdx.x; S.nrt = __builtin_amdgcn_readfirstlane(ts[NE]); S.ts = ts; S.cn = cn;
        S.A = (const char*)(ws + WS_R1); S.B = (const char*)(ws + WS_WD); S.bstride = (size_t)D * DE; S.tok = nullptr;
        pg8::EpiFp8 E{ws + WS_Y, D, SC_Y / (SC_HB * SC_WD)};
        pg8::gemm_phase<pg8::EpiFp8, pg8::MoeSched<DE / 2, true, true>, DE / 2, true, PG8_ALIGN, PG8_SP2, true>(F.lds, S, E, F.wave);
        if (BOTH(6)) GRID_BAR();
    }
    if (IN(7)) { compute_tile_start(F); combine_phase(F); }
#endif
#undef IN
#undef BOTH
#undef GRID_BAR
}

extern "C" void kernel_launch(void* const* d_in, const int* in_sizes, int n_in, void* d_out, int out_size, void* d_ws, size_t ws_size, hipStream_t stream) {
    static int grid = 0;
    if (grid == 0) {
        if (n_in != 22 || in_sizes[0] != T * D || out_size != T * D || ws_size < WS_END) { fprintf(stderr, "kernel_launch: unexpected shapes (n_in %d, in0 %d, out %d, ws %zu < %zu); nothing launched\n", n_in, n_in > 0 ? in_sizes[0] : -1, out_size, ws_size, (size_t)WS_END); grid = -1; return; }
        int dev = 0, cus = 0, per_cu = 0;
        if (hipGetDevice(&dev) != hipSuccess || hipDeviceGetAttribute(&cus, hipDeviceAttributeMultiprocessorCount, dev) != hipSuccess) { grid = -1; return; }
        if (hipFuncSetAttribute((const void*)hymba_fwd, hipFuncAttributeMaxDynamicSharedMemorySize, LDS_BYTES) != hipSuccess) { fprintf(stderr, "kernel_launch: hipFuncSetAttribute failed\n"); grid = -1; return; }
        if (hipOccupancyMaxActiveBlocksPerMultiprocessor(&per_cu, (const void*)hymba_fwd, NTHREADS, LDS_BYTES) != hipSuccess || per_cu < 1) { fprintf(stderr, "kernel_launch: occupancy query reports %d blocks per CU\n", per_cu); }
        (void)hipGetLastError();
        grid = cus;
    }
    if (grid < 0) return;
    if (hipMemsetAsync((char*)d_ws + WS_CTL, 0, CTL_ZERO_BYTES, stream) != hipSuccess) return;
    Args a{};
    for (int i = 0; i < 22; ++i) a.in[i] = (const float*)d_in[i];
    a.out = (float*)d_out; a.ws = (unsigned char*)d_ws;
    constexpr int NL = MK_N_LAUNCHES;
    constexpr int LASTP = (MK_LAST_PHASE <= 4) ? 5 : NPHASES;
    if (NL == 1) { a.ph_lo = 0; a.ph_hi = LASTP; a.li = 0; hipLaunchKernelGGL(hymba_fwd, dim3(grid), dim3(NTHREADS), LDS_BYTES, stream, a); }
    else for (int li = 0; li < LASTP; ++li) { a.ph_lo = li; a.ph_hi = li + 1; a.li = li; hipLaunchKernelGGL(hymba_fwd, dim3(grid), dim3(NTHREADS), LDS_BYTES, stream, a);
        if (li == MK_REPEAT_PHASE) hipLaunchKernelGGL(hymba_fwd, dim3(grid), dim3(NTHREADS), LDS_BYTES, stream, a); }
}
```

```cpp
#include <hip/hip_runtime.h>
#include <cstdio>
#include <cstdint>

#ifndef MK_N_LAUNCHES
#define MK_N_LAUNCHES 1
#endif
#ifndef MK_REPEAT_PHASE
#define MK_REPEAT_PHASE -1
#endif
#ifndef MK_LAST_PHASE
#define MK_LAST_PHASE 8
#endif

#define GAS __attribute__((address_space(1)))
#define LAS __attribute__((address_space(3)))
typedef unsigned short bf16_t;
typedef short bf16x8 __attribute__((ext_vector_type(8)));
typedef short s16x4 __attribute__((ext_vector_type(4)));
typedef float f32x4 __attribute__((ext_vector_type(4)));
typedef float f32x2 __attribute__((ext_vector_type(2)));
typedef unsigned u32x4 __attribute__((ext_vector_type(4)));
typedef unsigned u32x2 __attribute__((ext_vector_type(2)));
typedef GAS unsigned gu32;
typedef int i32x4 __attribute__((ext_vector_type(4)));
typedef int i32x8 __attribute__((ext_vector_type(8)));
constexpr float SC_WGU = 64.0f, SC_WD = 32.0f, SC_HB = 4.0f, SC_Y = 16.0f;

constexpr int T = 32768, D = 2048, SEQ = 2048, NBATCH = 16, PROJ = 6144;
constexpr int NH = 8, HD = 128, CHK = 128, NCHUNK = SEQ / CHK;
constexpr int NLB = 8;
constexpr int NE = 32, DE = 1024;
constexpr int CAP = 32768;
constexpr int MAXRT = 288;
constexpr float EPS = 1e-6f;
constexpr int NWAVES = 8, NTHREADS = 512;
constexpr int NPHASES = 8;

constexpr size_t MiB = 1u << 20;
constexpr size_t WS_CTL = 0, CTL_ZERO_BYTES = 65536;
constexpr size_t WS_TOK = 1 * MiB;
constexpr size_t WS_RSS = 5 * MiB;
constexpr size_t WS_APK = 9 * MiB;
constexpr size_t WS_AW  = 9 * MiB + 512 * 1024;
constexpr size_t WS_ROPE = 10 * MiB;
constexpr size_t WS_WGT = 11 * MiB;
constexpr size_t WS_WIN = 12 * MiB;
constexpr size_t WS_WOUT = 36 * MiB;
constexpr size_t WS_WD = 44 * MiB;
constexpr size_t WS_WGU = 172 * MiB;
constexpr size_t WS_R2 = 428 * MiB;
constexpr size_t WS_H2 = WS_R2, WS_X1 = WS_R2 + 128 * MiB;
constexpr size_t WS_R1 = 812 * MiB;
constexpr size_t WS_Y = WS_WGU;
constexpr size_t WS_END = 956 * MiB;
static_assert(WS_Y + (size_t)MAXRT * 256 * 2048 * 2 <= WS_X1, "y overlays Wgu + h2 only");
static_assert(WS_R1 + (size_t)MAXRT * 256 * 1024 * 2 <= WS_END, "hb fits");
constexpr int CW_BAR = 1024;
constexpr int CW_CNT = 8192;
constexpr int CW_Q = 6144;
constexpr int NCONV = 32;

constexpr int RING_BYTES = 131072;
constexpr int LDSCTL_OFF = 143360, MISC_OFF = LDSCTL_OFF + 320;
constexpr int TS_OFF = LDSCTL_OFF + 1024;
constexpr int CN_OFF = LDSCTL_OFF + 1280;
constexpr int RE_OFF = LDSCTL_OFF + 1536;
constexpr int GT_OFF = LDSCTL_OFF + 2048;
constexpr int LDS_BYTES = 147456;

#define LDS_WAIT() asm volatile("s_waitcnt lgkmcnt(0)" ::: "memory")
#define VM_WAIT() asm volatile("s_waitcnt vmcnt(0)" ::: "memory")
__device__ __forceinline__ unsigned f2bf(float f) { unsigned u = __builtin_bit_cast(unsigned, f); return (u + 0x7fffu + ((u >> 16) & 1u)) >> 16; }
typedef __bf16 hwbf16x2 __attribute__((ext_vector_type(2)));
__device__ __forceinline__ unsigned pk2(float lo, float hi) { const f32x2 v = {lo, hi}; return __builtin_bit_cast(unsigned, __builtin_convertvector(v, hwbf16x2)); }
__device__ __forceinline__ float bflo(unsigned w) { return __builtin_bit_cast(float, w << 16); }
__device__ __forceinline__ float bfhi(unsigned w) { return __builtin_bit_cast(float, w & 0xffff0000u); }
__device__ __forceinline__ float sat8(float x) { return __builtin_amdgcn_fmed3f(x, -448.0f, 448.0f); }
__device__ __forceinline__ unsigned pk4_fp8(float a, float b, float c, float d) { int p = 0; a = sat8(a); b = sat8(b); c = sat8(c); d = sat8(d); p = __builtin_amdgcn_cvt_pk_fp8_f32(a, b, p, false); p = __builtin_amdgcn_cvt_pk_fp8_f32(c, d, p, true); return (unsigned)p; }
__device__ __forceinline__ unsigned cvt_pk_bf16(float lo, float hi) { unsigned r; asm volatile("v_cvt_pk_bf16_f32 %0, %1, %2" : "=v"(r) : "v"(lo), "v"(hi)); return r; }
__device__ __forceinline__ int lane_id() { int l; asm volatile("v_mbcnt_lo_u32_b32 %0, -1, 0\n\tv_mbcnt_hi_u32_b32 %0, -1, %0" : "=v"(l)); return l; }
__device__ __forceinline__ float wave_sum(float v) {
#pragma unroll
    for (int o = 1; o < 64; o <<= 1) v += __shfl_xor(v, o);
    return v;
}

namespace pg8 {
constexpr int BM = 256, BK = 64, HALF = 128, HTB = HALF * BK * 2, STAGE_BYTES = 8 * HTB, NXCD = 8, WGM = 2;
__host__ __device__ __forceinline__ int lds_byte(int r, int c) { const int st = (r >> 4) * 2 + (c >> 5), rr = r & 15, cc = c & 31, ob = rr * 64 + cc * 2; return st * 1024 + (ob ^ (((ob >> 9) & 1) << 5)); }
__host__ __device__ __forceinline__ void stage_rc(int b, int& R, int& C) { const int st = b / 1024, sb = b % 1024, swz = sb ^ (((sb >> 9) & 1) << 5); R = (st >> 1) * 16 + swz / 64; C = (st & 1) * 32 + (swz % 64) / 2; }
__host__ __device__ __forceinline__ int perm32(int rho) { const int n = rho >> 4, i = rho & 15; return 8 * (i >> 2) + 4 * n + (i & 3); }

struct Unit { int pm, pn, e, ti; };

template <int NM, int NN> struct StaticOrder {
    static_assert(NM % WGM == 0 && (NM * NN) % NXCD == 0, "whole 8-row groups, whole XCD shares");
    int G, c;
    __device__ void init(int, int, int G_, int c_) { G = G_; c = c_; }
    __device__ bool next(int i, Unit& u) const {
        constexpr int nwg = NM * NN, q = nwg / NXCD, nig = WGM * NN;
        const int L = i * G + c; if (L >= nwg) return false;
        const int wgid = (L % NXCD) * q + L / NXCD;
        const int gid = wgid / nig, w = wgid % nig;
        u.pm = gid * WGM + (w % WGM); u.pn = w / WGM; u.e = 0; u.ti = 0; return true;
    }
};
template <int K, int NM, int NN, bool ROPE = false, bool IDENT = false> struct DenseSched {
    static constexpr bool ident = IDENT;
    StaticOrder<NM, NN> so; const char* A; const char* B;
    __device__ __forceinline__ bool bsel(const Unit& u) const { return ROPE && u.pn < 8; }
    __device__ __forceinline__ bool next(int i, Unit& u) const { return so.next(i, u); }
    __device__ __forceinline__ const char* a_ptr(const Unit& u) const { return IDENT ? A : A + (size_t)u.pm * (256 * K * 2); }
    __device__ __forceinline__ const char* b_ptr(const Unit& u) const { return B + (size_t)u.pn * (256 * K * 2); }
    __device__ __forceinline__ void gather(const Unit& u, int tid, unsigned (&v)[2][2]) const {
#pragma unroll
        for (int i = 0; i < 2; ++i) { int R, C; stage_rc(tid * 16 + i * 8192, R, C);
#pragma unroll
            for (int h = 0; h < 2; ++h) v[h][i] = ((unsigned)(u.pm * 256 + h * 128 + R) * (unsigned)K + (unsigned)C) * 2u; }
    }
    __device__ __forceinline__ const int* tok_ptr(const Unit&) const { return nullptr; }
    __device__ __forceinline__ int count(const Unit&) const { return 0; }
};
template <int K, bool GATHER, bool IDENT = false> struct MoeSched {
    static constexpr bool ident = IDENT;
    int G, c, nrt; const LAS int* ts; const LAS int* cn;
    const char* A; const char* B; size_t bstride; const int* tok;
    __device__ __forceinline__ bool bsel(const Unit&) const { return false; }
    __device__ __forceinline__ bool next(int i, Unit& u) const {
        int L;
        int rt, pnv;
        if (G == 256) { const int b = i * 8 + (c & 7), s_ = c >> 3; rt = (b >> 1) * 8 + (s_ >> 2); pnv = (b & 1) * 4 + (s_ & 3); L = rt * 8 + pnv; }
        else { L = i * G + c; rt = L >> 3; }
        if (rt >= nrt) return false;
        const int e = __builtin_amdgcn_readfirstlane((int)((const LAS unsigned char*)ts + (RE_OFF - TS_OFF))[rt]);
        u.pm = rt; u.pn = L & 7; u.e = e; u.ti = rt - __builtin_amdgcn_readfirstlane(ts[e]); return true;
    }
    __device__ __forceinline__ const char* a_ptr(const Unit& u) const { return GATHER ? A : A + (size_t)u.pm * (256 * K * 2); }
    __device__ __forceinline__ const char* b_ptr(const Unit& u) const { return B + (size_t)u.e * bstride + (size_t)u.pn * (256 * K * 2); }
    __device__ __forceinline__ const int* tok_ptr(const Unit& u) const { return tok + (size_t)u.e * CAP + u.ti * 256; }
    __device__ __forceinline__ int count(const Unit& u) const { return __builtin_amdgcn_readfirstlane(cn[u.e]); }
    __device__ __forceinline__ void gather(const Unit& u, int tid, unsigned (&v)[2][2]) const {
        const int cnt = __builtin_amdgcn_readfirstlane(cn[u.e]);
#pragma unroll
        for (int i = 0; i < 2; ++i) { int R, C; stage_rc(tid * 16 + i * 8192, R, C);
#pragma unroll
            for (int h = 0; h < 2; ++h) { const int rank = u.ti * 256 + h * 128 + R; int t = 0; if (IDENT) t = u.pm * 256 + h * 128 + R; else if (rank < cnt) t = tok[(size_t)u.e * CAP + rank];
                v[h][i] = ((unsigned)t * (unsigned)K + (unsigned)C) * 2u; } }
    }
};

struct EpiBf16 {
    static constexpr bool PERM = true, BSEL = false;
    bf16_t* O; int ldc; float sc;
    __device__ __forceinline__ void operator()(const f32x4 (&acc)[2][2][4][2], const Unit& u, int wr, int wc, int, int) const {
        const int lane_ = lane_id(), fr = lane_ & 15, fq = lane_ >> 4;
        const int row0 = u.pm * BM + wr * 64 + fr, col0 = u.pn * BM + wc * 32 + 8 * fq;
#pragma unroll
        for (int ai = 0; ai < 2; ++ai)
#pragma unroll
            for (int m = 0; m < 4; ++m) { bf16_t* rowp = O + (size_t)(row0 + ai * HALF + m * 16) * ldc + col0;
#pragma unroll
                for (int bj = 0; bj < 2; ++bj) { const f32x4 v0 = acc[ai][bj][m][0] * sc, v1 = acc[ai][bj][m][1] * sc;
                    u32x4 w; w.x = cvt_pk_bf16(v0[0], v0[1]); w.y = cvt_pk_bf16(v0[2], v0[3]); w.z = cvt_pk_bf16(v1[0], v1[1]); w.w = cvt_pk_bf16(v1[2], v1[3]);
                    *(u32x4*)(rowp + bj * HALF) = w; } }
    }
};
struct EpiFp8 {
    static constexpr bool PERM = true, BSEL = false;
    unsigned char* O; int ldc; float sc;
    __device__ __forceinline__ void operator()(const f32x4 (&acc)[2][2][4][2], const Unit& u, int wr, int wc, int, int) const {
        const int lane_ = lane_id(), fr = lane_ & 15, fq = lane_ >> 4;
        const int row0 = u.pm * BM + wr * 64 + fr, col0 = u.pn * BM + wc * 32 + 8 * fq;
#pragma unroll
        for (int ai = 0; ai < 2; ++ai)
#pragma unroll
            for (int m = 0; m < 4; ++m) { unsigned char* rowp = O + (size_t)(row0 + ai * HALF + m * 16) * ldc + col0;
#pragma unroll
                for (int bj = 0; bj < 2; ++bj) { const f32x4 v0 = acc[ai][bj][m][0] * sc, v1 = acc[ai][bj][m][1] * sc;
                    u32x2 w; w.x = pk4_fp8(v0[0], v0[1], v0[2], v0[3]); w.y = pk4_fp8(v1[0], v1[1], v1[2], v1[3]);
                    *(u32x2*)(rowp + bj * HALF) = w; } }
    }
};
struct EpiProj {
    static constexpr bool PERM = true, BSEL = true;
    bf16_t* O; int ldc; const float* rc; const float* rsn;
    __device__ __forceinline__ void operator()(const f32x4 (&acc)[2][2][4][2], const Unit& u, int wr, int wc, int, int) const {
        const int lane_ = lane_id(), fr = lane_ & 15, fq = lane_ >> 4;
        const int row0 = u.pm * BM + wr * 64 + fr;
        if (u.pn >= 8) {
            const int col0 = wc * 32 + 8 * fq;
            const int act = (u.pn >= 12 && u.pn < 16) ? 1 : (u.pn >= 20 ? 2 : 0);
#pragma unroll
            for (int ai = 0; ai < 2; ++ai)
#pragma unroll
                for (int m = 0; m < 4; ++m) { bf16_t* rowp = O + ((size_t)(2 * u.pn) * T + (row0 + ai * HALF + m * 16)) * HD + col0;
#pragma unroll
                    for (int bj = 0; bj < 2; ++bj) { f32x4 v0 = acc[ai][bj][m][0], v1 = acc[ai][bj][m][1];
                        if (act) {
#pragma unroll
                            for (int j = 0; j < 4; ++j) { const float a = v0[j], b = v1[j];
                                const float ya = act == 1 ? a : 1.5957691216057308f * (a + 0.044715f * a * a * a), yb = act == 1 ? b : 1.5957691216057308f * (b + 0.044715f * b * b * b);
                                v0[j] = a * __builtin_amdgcn_rcpf(1.0f + __expf(-ya)); v1[j] = b * __builtin_amdgcn_rcpf(1.0f + __expf(-yb)); } }
                        u32x4 w; w.x = cvt_pk_bf16(v0[0], v0[1]); w.y = cvt_pk_bf16(v0[2], v0[3]); w.z = cvt_pk_bf16(v1[0], v1[1]); w.w = cvt_pk_bf16(v1[2], v1[3]);
                        *(u32x4*)(rowp + (size_t)bj * T * HD) = w; } }
        } else {
            const bool isq = u.pn < 4; const int f0 = 16 * wc + 4 * fq;
            constexpr float L2G[8] = {-4.580368961312479e-2f, -2.272007650008353e-2f, -1.1315313227834146e-2f, -5.646563141142063e-3f, -2.8205190623786626e-3f, -1.4095702546713536e-3f, -7.046129765893727e-4f, -3.522634716290214e-4f};
            float l2g[2];
#pragma unroll
            for (int bj = 0; bj < 2; ++bj) { const int hh = 2 * (u.pn & 3) + bj; float v = L2G[0];
#pragma unroll
                for (int q = 1; q < 8; ++q) v = (hh == q) ? L2G[q] : v;
                l2g[bj] = v; }
            f32x4 csv[2][4], snv[2][4];
#pragma unroll
            for (int ai = 0; ai < 2; ++ai)
#pragma unroll
                for (int m = 0; m < 4; ++m) { const int pos = (row0 + ai * HALF + m * 16) & (SEQ - 1); csv[ai][m] = *(const f32x4*)(rc + pos * 64 + f0); snv[ai][m] = *(const f32x4*)(rsn + pos * 64 + f0); }
#pragma unroll
            for (int ai = 0; ai < 2; ++ai)
#pragma unroll
                for (int m = 0; m < 4; ++m) { const int row = row0 + ai * HALF + m * 16, pos = row & (SEQ - 1), il = pos & 127;
                    const f32x4 cs = csv[ai][m], sn = snv[ai][m];
                    bf16_t* rowp = O + ((size_t)(2 * u.pn) * T + row) * HD + f0;
#pragma unroll
                    for (int bj = 0; bj < 2; ++bj) { const float sc = isq ? __builtin_amdgcn_exp2f((float)(il - 127) * l2g[bj]) * 0.08838834764831845f : __builtin_amdgcn_exp2f((float)(127 - il) * l2g[bj]);
                        const f32x4 x1 = acc[ai][bj][m][0], x2 = acc[ai][bj][m][1]; const f32x4 y1 = (x1 * cs - x2 * sn) * sc, y2 = (x1 * sn + x2 * cs) * sc;
                        u32x2 w1, w2; w1.x = cvt_pk_bf16(y1[0], y1[1]); w1.y = cvt_pk_bf16(y1[2], y1[3]); w2.x = cvt_pk_bf16(y2[0], y2[1]); w2.y = cvt_pk_bf16(y2[2], y2[3]);
                        *(u32x2*)(rowp + (size_t)bj * T * HD) = w1; *(u32x2*)(rowp + (size_t)bj * T * HD + 64) = w2; } }
        }
    }
};
struct EpiF32Res {
    static constexpr bool PERM = false, BSEL = false;
    const float* base; float* C; int ldc;
    __device__ __forceinline__ void operator()(const f32x4 (&acc)[2][2][4][2], const Unit& u, int wr, int wc, int, int) const {
        const int lane_ = lane_id(), fr = lane_ & 15, fq = lane_ >> 4;
        const int row0 = u.pm * BM + wr * 64 + fr, col0 = u.pn * BM + wc * 32 + 4 * fq;
#pragma unroll
        for (int ai = 0; ai < 2; ++ai)
#pragma unroll
            for (int m = 0; m < 4; ++m) { const size_t off = (size_t)(row0 + ai * HALF + m * 16) * ldc + col0;
#pragma unroll
                for (int bj = 0; bj < 2; ++bj)
#pragma unroll
                    for (int n = 0; n < 2; ++n) { const f32x4 b = *(const f32x4*)(base + off + bj * HALF + n * 16); *(f32x4*)(C + off + bj * HALF + n * 16) = acc[ai][bj][m][n] + b; }
                if (m == 3) asm volatile("" ::: "memory"); }
    }
};
struct EpiSwiGLU {
    static constexpr bool PERM = true, BSEL = false;
    unsigned char* O; const float* rss; const LAS int* cn;
    __device__ __forceinline__ void operator()(const f32x4 (&acc)[2][2][4][2], const Unit& u, int wr, int wc, int, int) const {
        const int lane_ = lane_id(), fr = lane_ & 15, fq = lane_ >> 4;
        const int cnt = __builtin_amdgcn_readfirstlane(cn[u.e]);
        const int col0 = u.pn * HALF + wc * 32 + 8 * fq;
        float rsv[2][4];
#pragma unroll
        for (int ai = 0; ai < 2; ++ai)
#pragma unroll
            for (int m = 0; m < 4; ++m) { const int rank = u.ti * 256 + ai * HALF + wr * 64 + m * 16 + fr; const float v = rss[(size_t)u.e * CAP + (rank < cnt ? rank : 0)]; rsv[ai][m] = rank < cnt ? v * (1.0f / SC_WGU) : 0.f; }
#pragma unroll
        for (int ai = 0; ai < 2; ++ai)
#pragma unroll
            for (int m = 0; m < 4; ++m) { const int r = ai * HALF + wr * 64 + m * 16 + fr;
                const float rs = rsv[ai][m];
                float o[8];
#pragma unroll
                for (int n = 0; n < 2; ++n)
#pragma unroll
                    for (int j = 0; j < 4; ++j) { const float g = acc[ai][0][m][n][j] * rs, uu = acc[ai][1][m][n][j] * rs; o[n * 4 + j] = SC_HB * g * uu * __builtin_amdgcn_rcpf(1.0f + __expf(-g)); }
                u32x2 w; w.x = pk4_fp8(o[0], o[1], o[2], o[3]); w.y = pk4_fp8(o[4], o[5], o[6], o[7]);
                *(u32x2*)(O + (size_t)(u.pm * BM + r) * DE + col0) = w; }
    }
};

template <class Epi, class Sched, int K, bool GATHER, bool ALIGN_EPI, bool SP2, bool FP8 = false>
__device__ __forceinline__ void gemm_phase(LAS unsigned char* lds, const Sched& S, const Epi& E, int wid) {
    const int lane = lane_id(), tid = wid * 64 + lane, wr = wid >> 2, wc = wid & 3, fr = lane & 15, fq = lane >> 4;
    constexpr int nt = K / BK;
    unsigned voffA[2], voffB[2];
#pragma unroll
    for (int i = 0; i < 2; ++i) { int R, C; stage_rc(tid * 16 + i * 8192, R, C); const int Rb = Epi::PERM ? ((R & ~31) + perm32(R & 31)) : R;
        voffA[i] = (unsigned)(R * K + C) * 2u; voffB[i] = (unsigned)(Rb * K + C) * 2u; }
    unsigned voffB2[2]; bool selC = false, selN = false;
    if constexpr (Epi::BSEL) {
#pragma unroll
        for (int i = 0; i < 2; ++i) { int R, C; stage_rc(tid * 16 + i * 8192, R, C); const int Rb = 64 * ((R >> 4) & 1) + 16 * (R >> 5) + (R & 15); voffB2[i] = (unsigned)(Rb * K + C) * 2u; }
    }
    constexpr size_t kstep = (size_t)(BK * 2);
    constexpr size_t hstep = (size_t)HALF * K * 2;
    const unsigned ldsw = (unsigned)wid * 1024u;
    const int aoff = lds_byte(wr * 64 + fr, fq * 8), boff = lds_byte(wc * 32 + fr, fq * 8);
    unsigned vC[2][2];
    LAS int* gtab = (LAS int*)(lds + (GT_OFF));
#define PG8_SA(b, h) (((b) * 2 + (h)) * HTB)
#define PG8_SB(b, h) ((4 + (b) * 2 + (h)) * HTB)
#define PG8_STAGE(bufoff, gbase, voff) do { _Pragma("unroll") for (int _i = 0; _i < 2; ++_i) \
        __builtin_amdgcn_global_load_lds((const unsigned*)((const char*)(gbase) + (voff)[_i]), (LAS unsigned*)(lds + (bufoff) + ldsw + _i * 8192), 16, 0, 0); } while (0)
#define PG8_STAGE_A(bufoff, gp, h, nx) do { if constexpr (GATHER) PG8_STAGE(bufoff, gp, vC[h]); else PG8_STAGE(bufoff, (gp) + (h) * hstep, voffA); } while (0)
#define PG8_SWITCH() do { if constexpr (GATHER) { if (last && has_next) { const int _cnt = S.count(nxt); _Pragma("unroll") for (int _i = 0; _i < 2; ++_i) { int _R, _C; stage_rc(tid * 16 + _i * 8192, _R, _C); \
        _Pragma("unroll") for (int _h = 0; _h < 2; ++_h) { const int _r = _h * 128 + _R; int _t; if constexpr (Sched::ident) _t = nxt.pm * 256 + _r; else { _t = gtab[_r]; _t = (nxt.ti * 256 + _r < _cnt) ? _t : 0; } vC[_h][_i] = ((unsigned)_t * (unsigned)K + (unsigned)_C) * 2u; } } } } } while (0)
#define PG8_STAGE_B(bufoff, gp, nx) do { if constexpr (Epi::BSEL) { const bool _s = (nx) ? selN : selC; if (_s) PG8_STAGE(bufoff, gp, voffB2); else PG8_STAGE(bufoff, gp, voffB); } else PG8_STAGE(bufoff, gp, voffB); } while (0)
#define PG8_LD8(p) __builtin_shufflevector(*(const LAS i32x4*)(p), *(const LAS i32x4*)((p) + 1024), 0, 1, 2, 3, 4, 5, 6, 7)
#define PG8_LDA(dst, b, h) do { _Pragma("unroll") for (int m = 0; m < 4; ++m) { if constexpr (FP8) dst##8[m] = PG8_LD8(lds + PG8_SA(b, h) + aoff + m * 2048); else { _Pragma("unroll") for (int k = 0; k < 2; ++k) dst[m][k] = *(const LAS bf16x8*)(lds + PG8_SA(b, h) + aoff + m * 2048 + k * 1024); } } } while (0)
#define PG8_LDB(dst, b, h) do { _Pragma("unroll") for (int n = 0; n < 2; ++n) { if constexpr (FP8) dst##8[n] = PG8_LD8(lds + PG8_SB(b, h) + boff + n * 2048); else { _Pragma("unroll") for (int k = 0; k < 2; ++k) dst[n][k] = *(const LAS bf16x8*)(lds + PG8_SB(b, h) + boff + n * 2048 + k * 1024); } } } while (0)
#define PG8_MMA(ai, bj, At, Bt) do { __builtin_amdgcn_s_setprio(1); _Pragma("unroll") for (int m = 0; m < 4; ++m) _Pragma("unroll") for (int n = 0; n < 2; ++n) { \
        if constexpr (FP8) acc[ai][bj][m][n] = __builtin_amdgcn_mfma_scale_f32_16x16x128_f8f6f4(Bt##8[n], At##8[m], acc[ai][bj][m][n], 0, 0, 0, 0x7f7f7f7f, 0, 0x7f7f7f7f); \
        else { _Pragma("unroll") for (int k = 0; k < 2; ++k) acc[ai][bj][m][n] = __builtin_amdgcn_mfma_f32_16x16x32_bf16(Bt[n][k], At[m][k], acc[ai][bj][m][n], 0, 0, 0); } } \
        __builtin_amdgcn_s_setprio(0); } while (0)
#define PG8_WAIT_V(n) asm volatile("s_waitcnt vmcnt(" #n ")" ::: "memory")
#define PG8_WAIT_L(n) asm volatile("s_waitcnt lgkmcnt(" #n ")" ::: "memory")
#define PG8_BAR __builtin_amdgcn_s_barrier()
#define PG8_SCHED __builtin_amdgcn_sched_barrier(0)
    Unit cur, nxt; int ui = 0;
    if (!S.next(0, cur)) return;
    f32x4 acc[2][2][4][2];
#pragma unroll
    for (int a = 0; a < 2; ++a)
#pragma unroll
        for (int b = 0; b < 2; ++b)
#pragma unroll
            for (int m = 0; m < 4; ++m)
#pragma unroll
                for (int n = 0; n < 2; ++n) acc[a][b][m][n] = (f32x4){0.f, 0.f, 0.f, 0.f};
    bf16x8 At[4][2], B0[2][2], B1[2][2]; i32x8 At8[4], B08[2], B18[2];
    const char* cA = S.a_ptr(cur); const char* cB = S.b_ptr(cur);
    if constexpr (GATHER) { S.gather(cur, tid, vC); }
    if constexpr (Epi::BSEL) selC = S.bsel(cur);
    if constexpr (SP2) {
        PG8_STAGE_B(PG8_SB(0, 0), cB, false); PG8_STAGE_B(PG8_SB(0, 1), cB + hstep, false); PG8_STAGE_A(PG8_SA(0, 0), cA, 0, false); PG8_STAGE_A(PG8_SA(0, 1), cA, 1, false);
        if (wr == 1) PG8_BAR;
        PG8_WAIT_V(2); PG8_BAR;
        PG8_STAGE_B(PG8_SB(1, 0), cB + kstep, false); PG8_STAGE_A(PG8_SA(1, 0), cA + kstep, 0, false); PG8_STAGE_B(PG8_SB(1, 1), cB + hstep + kstep, false);
        PG8_WAIT_V(6); PG8_BAR;
    } else {
        PG8_STAGE_B(PG8_SB(0, 0), cB, false); PG8_STAGE_A(PG8_SA(0, 0), cA, 0, false); PG8_STAGE_B(PG8_SB(0, 1), cB + hstep, false); PG8_STAGE_A(PG8_SA(0, 1), cA, 1, false);
        if (wr == 1) PG8_BAR;
        PG8_WAIT_V(4); PG8_BAR;
        PG8_STAGE_B(PG8_SB(1, 0), cB + kstep, false); PG8_STAGE_A(PG8_SA(1, 0), cA + kstep, 0, false); PG8_STAGE_B(PG8_SB(1, 1), cB + hstep + kstep, false);
        PG8_WAIT_V(6); PG8_BAR;
    }
    for (;;) {
        const bool has_next = S.next(ui + 1, nxt);
        const char* nA = has_next ? S.a_ptr(nxt) : cA; const char* nB = has_next ? S.b_ptr(nxt) : cB;
        if constexpr (Epi::BSEL) selN = has_next ? S.bsel(nxt) : selC;
        if constexpr (GATHER && !Sched::ident) { if (has_next && wid < 4) __builtin_amdgcn_global_load_lds((const unsigned*)(S.tok_ptr(nxt) + wid * 64 + lane), (LAS unsigned*)(gtab + wid * 64), 4, 0, 0); }
#pragma unroll 1
        for (int t = 0; t < nt; t += 2) {
            const bool last = (t == nt - 2);
            const char* a1 = cA + (size_t)(t + 1) * kstep;
            const char* a2 = last ? nA : cA + (size_t)(t + 2) * kstep; const char* b2 = last ? nB : cB + (size_t)(t + 2) * kstep;
            const char* a3 = a2 + kstep; const char* b3 = b2 + kstep;
            if constexpr (SP2) {
            PG8_LDB(B0, 0, 0); PG8_LDB(B1, 0, 1); PG8_SCHED; PG8_LDA(At, 0, 0); PG8_STAGE_A(PG8_SA(1, 1), a1, 1, false); PG8_SWITCH();
            PG8_WAIT_V(8); PG8_WAIT_L(0); PG8_BAR; PG8_MMA(0, 0, At, B0); PG8_MMA(0, 1, At, B1); PG8_BAR; PG8_SCHED;
            PG8_LDA(At, 0, 1); PG8_STAGE_B(PG8_SB(0, 0), b2, last); PG8_STAGE_B(PG8_SB(0, 1), b2 + hstep, last); PG8_STAGE_A(PG8_SA(0, 0), a2, 0, last);
            PG8_WAIT_V(8); PG8_WAIT_L(0); PG8_BAR; PG8_MMA(1, 0, At, B0); PG8_MMA(1, 1, At, B1); PG8_BAR; PG8_SCHED;
            PG8_LDB(B0, 1, 0); PG8_LDB(B1, 1, 1); PG8_SCHED; PG8_LDA(At, 1, 0); PG8_STAGE_A(PG8_SA(0, 1), a2, 1, last);
            PG8_WAIT_V(8); PG8_WAIT_L(0); PG8_BAR; PG8_MMA(0, 0, At, B0); PG8_MMA(0, 1, At, B1); PG8_BAR; PG8_SCHED;
            PG8_LDA(At, 1, 1); PG8_STAGE_B(PG8_SB(1, 0), b3, last); PG8_STAGE_B(PG8_SB(1, 1), b3 + hstep, last); PG8_STAGE_A(PG8_SA(1, 0), a3, 0, last);
            PG8_WAIT_V(8); PG8_WAIT_L(0); PG8_BAR; PG8_MMA(1, 0, At, B0); PG8_MMA(1, 1, At, B1); PG8_BAR; PG8_SCHED;
            } else {
            PG8_LDB(B0, 0, 0); PG8_SCHED; PG8_LDA(At, 0, 0); PG8_STAGE_A(PG8_SA(1, 1), a1, 1, false); PG8_SWITCH();
            PG8_WAIT_L(8); PG8_BAR; PG8_WAIT_L(0); PG8_MMA(0, 0, At, B0); PG8_BAR; PG8_SCHED;
            PG8_LDB(B1, 0, 1); PG8_STAGE_B(PG8_SB(0, 0), b2, last);
            PG8_BAR; PG8_WAIT_L(0); PG8_MMA(0, 1, At, B1); PG8_BAR;
            PG8_LDA(At, 0, 1); PG8_STAGE_A(PG8_SA(0, 0), a2, 0, last);
            PG8_BAR; PG8_WAIT_L(0); PG8_MMA(1, 0, At, B0); PG8_BAR; PG8_SCHED;
            PG8_STAGE_B(PG8_SB(0, 1), b2 + hstep, last);
            PG8_WAIT_V(6); PG8_BAR; PG8_MMA(1, 1, At, B1); PG8_BAR;
            PG8_LDB(B0, 1, 0); PG8_SCHED; PG8_LDA(At, 1, 0); PG8_STAGE_A(PG8_SA(0, 1), a2, 1, last);
            PG8_WAIT_L(8); PG8_BAR; PG8_WAIT_L(0); PG8_MMA(0, 0, At, B0); PG8_BAR; PG8_SCHED;
            PG8_LDB(B1, 1, 1); PG8_STAGE_B(PG8_SB(1, 0), b3, last);
            PG8_BAR; PG8_WAIT_L(0); PG8_MMA(0, 1, At, B1); PG8_BAR;
            PG8_LDA(At, 1, 1); PG8_STAGE_A(PG8_SA(1, 0), a3, 0, last);
            PG8_BAR; PG8_WAIT_L(0); PG8_MMA(1, 0, At, B0); PG8_BAR; PG8_SCHED;
            PG8_STAGE_B(PG8_SB(1, 1), b3 + hstep, last);
            PG8_WAIT_V(6); PG8_BAR; PG8_MMA(1, 1, At, B1); PG8_BAR;
            }
        }
        if constexpr (ALIGN_EPI) { if (wr == 0) PG8_BAR; }
        E(acc, cur, wr, wc, fr, fq);
        if (!has_next) break;
#pragma unroll
        for (int a = 0; a < 2; ++a)
#pragma unroll
            for (int b = 0; b < 2; ++b)
#pragma unroll
                for (int m = 0; m < 4; ++m)
#pragma unroll
                    for (int n = 0; n < 2; ++n) acc[a][b][m][n] = (f32x4){0.f, 0.f, 0.f, 0.f};
        cur = nxt; cA = nA; cB = nB; ++ui; selC = selN;
        if constexpr (ALIGN_EPI) { if (wr == 1) PG8_BAR; }
    }
    PG8_WAIT_V(0);
    if constexpr (!ALIGN_EPI) { if (wr == 0) PG8_BAR; }
    PG8_BAR;
#undef PG8_SA
#undef PG8_SB
#undef PG8_STAGE
#undef PG8_STAGE_A
#undef PG8_SWITCH
#undef PG8_STAGE_B
#undef PG8_LDA
#undef PG8_LDB
#undef PG8_MMA
#undef PG8_LD8
#undef PG8_WAIT_V
#undef PG8_WAIT_L
#undef PG8_BAR
#undef PG8_SCHED
}
}

#ifndef PG8_SP2
#define PG8_SP2 true
#endif
#ifndef PG8_ALIGN
#define PG8_ALIGN true
#endif

#define XB_TMO      128
#define XB_XCNT(j)  (256  + 64 * (j))
#define XB_XSUB(j)  (1280 + 64 * (j))
#define XB_XGEN(j)  (2304 + 64 * (j))
#define XB_TOP      3328
#define XB_TOPGEN   3392
#define XCD_BAR_WORDS 3456
#define XB_SPIN_CAP (1u << 18)
__device__ __forceinline__ unsigned xb_ld(unsigned* p)              { return __hip_atomic_load(p, __ATOMIC_RELAXED, __HIP_MEMORY_SCOPE_AGENT); }
__device__ __forceinline__ unsigned xb_add(unsigned* p, unsigned v) { return __hip_atomic_fetch_add(p, v, __ATOMIC_RELAXED, __HIP_MEMORY_SCOPE_AGENT); }
__device__ __forceinline__ unsigned xb_xcc_id() { return (unsigned)__builtin_amdgcn_s_getreg((3 << 11) | 20) & 0xFu; }
#define XB_SPIN(cond, bar) do { unsigned _sp = 0; while (cond) { __builtin_amdgcn_s_sleep(1); \
    if ((++_sp & 255u) == 0u) { if (xb_ld(&(bar)[XB_TMO])) break; if (_sp > XB_SPIN_CAP) { atomicAdd(&(bar)[XB_TMO], 1u); break; } } } } while (0)
struct XcdBarrier { unsigned* bar; unsigned x; volatile LAS unsigned* st; };
__device__ __forceinline__ XcdBarrier xcd_barrier_post(unsigned* bar, volatile LAS unsigned* st) {
    XcdBarrier b; b.bar = bar; b.x = xb_xcc_id(); b.st = st;
    if (threadIdx.x == 0) (void)xb_add(&bar[XB_XCNT(b.x)], 1u);
    return b;
}
__device__ __forceinline__ void xcd_barrier_complete(unsigned* bar, unsigned x, unsigned& nloc, unsigned& nx) {
    const unsigned G = gridDim.x * gridDim.y * gridDim.z;
    unsigned sum, cnt, mine, sp = 0u;
    for (;;) {
        sum = 0u; cnt = 0u; mine = 0u;
#pragma unroll
        for (unsigned j = 0; j < 16; ++j) { const unsigned c = xb_ld(&bar[XB_XCNT(j)]); sum += c; cnt += (c > 0u) ? 1u : 0u; mine = (j == x) ? c : mine; }
        if (sum == G) break;
        __builtin_amdgcn_s_sleep(1);
        if ((++sp & 255u) == 0u) { if (xb_ld(&bar[XB_TMO])) break; if (sp > XB_SPIN_CAP) { atomicAdd(&bar[XB_TMO], 1u); break; } }
    }
    nloc = mine > 0u ? mine : 1u; nx = cnt > 0u ? cnt : 1u;
}
__device__ __forceinline__ void xcd_barrier(const XcdBarrier& b) {
    asm volatile("s_waitcnt vmcnt(0)" ::: "memory");
    __syncthreads();
    if (threadIdx.x == 0) {
        unsigned* bar = b.bar;
        __builtin_amdgcn_s_waitcnt(0);
        unsigned nloc = b.st[0], nx = b.st[1];
        if (nloc == 0u) { xcd_barrier_complete(bar, b.x, nloc, nx); b.st[0] = nloc; b.st[1] = nx; }
        const unsigned old = xb_add(&bar[XB_XSUB(b.x)], 1u);
        const unsigned gen = old / nloc;
        if (old + 1u == (gen + 1u) * nloc) {
            __builtin_amdgcn_fence(__ATOMIC_RELEASE, "agent");
            asm volatile("s_waitcnt vmcnt(0)" ::: "memory");
            const unsigned og = xb_add(&bar[XB_TOP], 1u);
            const unsigned tg = og / nx;
            if (og + 1u == (tg + 1u) * nx) xb_add(&bar[XB_TOPGEN], 1u);
            else XB_SPIN(xb_ld(&bar[XB_TOPGEN]) == tg, bar);
            __builtin_amdgcn_fence(__ATOMIC_ACQUIRE, "agent");
            xb_add(&bar[XB_XGEN(b.x)], 1u);
            asm volatile("s_waitcnt vmcnt(0)" ::: "memory");
        } else {
            XB_SPIN(xb_ld(&bar[XB_XGEN(b.x)]) == gen, bar);
            __builtin_amdgcn_fence(__ATOMIC_ACQUIRE, "agent");
            asm volatile("s_waitcnt vmcnt(0)" ::: "memory");
        }
    }
    __syncthreads();
}

struct Frame {
    LAS unsigned char* lds;
    volatile LAS unsigned* MISC;
    unsigned* ctl;
    int wave, vcu, G;
    const float *x, *norm_mix_g, *w_in, *ret_norm_g, *conv_w, *conv_b, *w_rg, *b_rg, *w_ig, *b_ig, *lam, *lru_norm_g, *w_out, *norm_ffn_g,
                *w_group, *b_group, *w_router, *b_router, *w_gate, *w_up, *w_down, *norm_final_g;
    float* out;
    unsigned char* ws;
};

__device__ __forceinline__ unsigned offb(unsigned row, unsigned ch);
__device__ __forceinline__ bf16x8 tr_frag(LAS unsigned char* img, int lane, int c, int ks);
__device__ __forceinline__ bf16x8 tr_rows(LAS unsigned char* img, int lane, int c, int row0) {
    const unsigned q = (lane & 15) >> 2, p = lane & 3;
    const s16x4 a = __builtin_amdgcn_ds_read_tr16_b64_v4i16((LAS s16x4*)(img + offb(row0 + q, 2 * c + (p >> 1)) + 8 * (p & 1)));
    const s16x4 b = __builtin_amdgcn_ds_read_tr16_b64_v4i16((LAS s16x4*)(img + offb(row0 + 4 + q, 2 * c + (p >> 1)) + 8 * (p & 1)));
    bf16x8 r; r[0] = a[0]; r[1] = a[1]; r[2] = a[2]; r[3] = a[3]; r[4] = b[0]; r[5] = b[1]; r[6] = b[2]; r[7] = b[3]; return r;
}
template <bool F8, bool GK>
__device__ __forceinline__ void p0_transpose_item(const float* W, int N, int k0, int n0, void* WTrow0, int KoutB, const float* gk, float scale, LAS unsigned char* img, int lane) {
    const int l31 = lane & 31, lh = lane >> 5, l15 = lane & 15, g = lane >> 4;
    const float* src = W + (size_t)(k0 + lh) * N + n0 + 4 * l31;
#define P0_OUT(pass) do { LDS_WAIT(); asm volatile("" ::: "memory"); const int kk0 = k0 + 64 * (pass); \
        if constexpr (F8) { _Pragma("unroll") for (int c = 0; c < 8; ++c) { const u32x4 q0 = __builtin_bit_cast(u32x4, tr_rows(img, lane, c, 16 * g)), q1 = __builtin_bit_cast(u32x4, tr_rows(img, lane, c, 16 * g + 8)); \
            u32x4 o; o.x = pk4_fp8(bflo(q0.x), bfhi(q0.x), bflo(q0.y), bfhi(q0.y)); o.y = pk4_fp8(bflo(q0.z), bfhi(q0.z), bflo(q0.w), bfhi(q0.w)); \
            o.z = pk4_fp8(bflo(q1.x), bfhi(q1.x), bflo(q1.y), bfhi(q1.y)); o.w = pk4_fp8(bflo(q1.z), bfhi(q1.z), bflo(q1.w), bfhi(q1.w)); \
            *(u32x4*)((unsigned char*)WTrow0 + (size_t)(16 * c + l15) * KoutB + kk0 + 16 * g) = o; } } \
        else { _Pragma("unroll") for (int c = 0; c < 8; ++c) _Pragma("unroll") for (int ks = 0; ks < 2; ++ks) { const bf16x8 f = tr_frag(img, lane, c, ks); \
            *(bf16x8*)((unsigned char*)WTrow0 + (size_t)(16 * c + l15) * KoutB + 2 * (kk0 + 32 * ks + 8 * g)) = f; } } \
        LDS_WAIT(); asm volatile("" ::: "memory"); } while (0)
#pragma unroll 1
    for (int pass = 0; pass < 2; ++pass) {
#pragma unroll
        for (int half = 0; half < 2; ++half) {
            const int st = 2 * pass + half;
            f32x4 v[16]; float gs[16];
#pragma unroll
            for (int i = 0; i < 16; ++i) v[i] = __builtin_nontemporal_load((const f32x4*)(src + (size_t)(32 * st + 2 * i) * N));
#pragma unroll
            for (int i = 0; i < 16; ++i) gs[i] = GK ? gk[k0 + 32 * st + 2 * i + lh] * scale : scale;
#pragma unroll
            for (int i = 0; i < 16; ++i) { const int kl = 32 * half + 2 * i + lh; const f32x4 x = v[i] * gs[i];
                u32x2 w; w.x = pk2(x.x, x.y); w.y = pk2(x.z, x.w); *(LAS u32x2*)(img + offb(kl, l31 >> 1) + 8 * (l31 & 1)) = w; }
        }
        P0_OUT(pass);
    }
#undef P0_OUT
}
constexpr int I_G = (D / 128) * (DE / 128), I_DN = (DE / 128) * (D / 128), NQ_ITEMS = NE * (2 * I_G + I_DN);
__device__ __forceinline__ void convert_queue(Frame& F) {
    LAS unsigned char* scr = F.lds + F.wave * 16384;
    const int lane = lane_id();
    unsigned char* Wd8 = F.ws + WS_WD; unsigned char* Wgu8 = F.ws + WS_WGU;
    for (;;) {
        unsigned it = 0; if (lane == 0) it = atomicAdd(F.ctl + CW_Q, 1u);
        int r = __builtin_amdgcn_readfirstlane((int)it); if (r >= NQ_ITEMS) break;
        const int e = r / (2 * I_G + I_DN); r -= e * (2 * I_G + I_DN);
        if (r < 2 * I_G) { const int up = r >= I_G; if (up) r -= I_G; const int nblk = DE / 128, kb = r / nblk, nb = r % nblk;
            const float* W = (up ? F.w_up : F.w_gate) + (size_t)e * D * DE;
            unsigned char* row0 = Wgu8 + (size_t)e * D * D + (size_t)(256 * nb + 128 * up) * D;
            p0_transpose_item<true, true>(W, DE, 128 * kb, 128 * nb, row0, D, F.norm_ffn_g, SC_WGU, scr, lane); continue; }
        r -= 2 * I_G;
        { const int nblk = D / 128, kb = r / nblk, nb = r % nblk; p0_transpose_item<true, false>(F.w_down + (size_t)e * DE * D, D, 128 * kb, 128 * nb, Wd8 + (size_t)e * D * DE + (size_t)(128 * nb) * DE, DE, nullptr, SC_WD, scr, lane); }
    }
}
__device__ __forceinline__ void p0_prologue(Frame& F) {
    LAS unsigned char* scr = F.lds + F.wave * 16384;
    const int lane = lane_id(), tid = F.wave * 64 + lane;
    const int gw = F.wave * F.G + F.vcu, NGW = F.G * NWAVES;
    bf16_t* Win_t = (bf16_t*)(F.ws + WS_WIN); bf16_t* Wout_t = (bf16_t*)(F.ws + WS_WOUT);
    constexpr int I_IN = (D / 128) * (PROJ / 128), I_OUT = (D / 128) * (D / 128);
    constexpr int NITEMS = I_IN + I_OUT;
    for (int it = gw; it < NITEMS; it += NGW) {
        int r = it;
        if (r < I_IN) { const int nblk = PROJ / 128, kb = r / nblk, nb = r % nblk; p0_transpose_item<false, false>(F.w_in, PROJ, 128 * kb, 128 * nb, Win_t + (size_t)(128 * nb) * D, D * 2, nullptr, 1.0f, scr, lane); continue; } r -= I_IN;
        { const int nblk = D / 128, kb = r / nblk, nb = r % nblk; p0_transpose_item<false, false>(F.w_out, D, 128 * kb, 128 * nb, Wout_t + (size_t)(128 * nb) * D, D * 2, nullptr, 1.0f, scr, lane); }
    }
    bf16_t* Hb = (bf16_t*)(F.ws + WS_R1);
    for (int m = gw; m < T; m += 2 * NGW) {
        const int m2 = m + NGW < T ? m + NGW : m;
        const f32x4* xr = (const f32x4*)(F.x + (size_t)m * D) + lane; const f32x4* xr2 = (const f32x4*)(F.x + (size_t)m2 * D) + lane; const f32x4* gr = (const f32x4*)F.norm_mix_g + lane;
        f32x4 v[8], v2[8]; float s = 0.f, s2 = 0.f;
#pragma unroll
        for (int j = 0; j < 8; ++j) { v[j] = __builtin_nontemporal_load(xr + 64 * j); v2[j] = __builtin_nontemporal_load(xr2 + 64 * j); }
#pragma unroll
        for (int j = 0; j < 8; ++j) { s += (v[j].x * v[j].x + v[j].y * v[j].y) + (v[j].z * v[j].z + v[j].w * v[j].w); s2 += (v2[j].x * v2[j].x + v2[j].y * v2[j].y) + (v2[j].z * v2[j].z + v2[j].w * v2[j].w); }
        const float rs = 1.0f / sqrtf(wave_sum(s) * (1.0f / D) + EPS), rs2 = 1.0f / sqrtf(wave_sum(s2) * (1.0f / D) + EPS);
        u32x2* o = (u32x2*)(Hb + (size_t)m * D) + lane; u32x2* o2 = (u32x2*)(Hb + (size_t)m2 * D) + lane;
#pragma unroll
        for (int j = 0; j < 8; ++j) { const f32x4 g = gr[64 * j]; u32x2 w; w.x = pk2(v[j].x * rs * g.x, v[j].y * rs * g.y); w.y = pk2(v[j].z * rs * g.z, v[j].w * rs * g.w); o[64 * j] = w;
            u32x2 w2; w2.x = pk2(v2[j].x * rs2 * g.x, v2[j].y * rs2 * g.y); w2.y = pk2(v2[j].z * rs2 * g.z, v2[j].w * rs2 * g.w); o2[64 * j] = w2; }
    }
    const int gt = F.vcu * NTHREADS + tid, NGT = F.G * NTHREADS;
    float* rc = (float*)(F.ws + WS_ROPE); float* rsn = rc + SEQ * 64;
    for (int i = gt; i < SEQ * 64; i += NGT) { const int pos = i >> 6, f = i & 63; const float inv = powf(10000.0f, -(float)f / 64.0f); const float ang = (float)pos * inv; float sv, cv; sincosf(ang, &sv, &cv); rc[i] = cv; rsn[i] = sv; }
    bf16_t* whi = (bf16_t*)(F.ws + WS_WGT); bf16_t* wlo = whi + 48 * D;
    for (int i = gt; i < 48 * D; i += NGT) { const int n = i / D, k = i % D; float v = 0.f;
        if (n < 4) v = F.w_group[k * 4 + n]; else if (n < 36) v = F.w_router[k * 32 + (n - 4)];
        v *= F.norm_ffn_g[k]; const unsigned h = f2bf(v); const float hf = __builtin_bit_cast(float, h << 16); whi[i] = (bf16_t)h; wlo[i] = (bf16_t)f2bf(v - hf); }
}

__device__ __forceinline__ unsigned offb(unsigned row, unsigned ch) { return 256u * row + 16u * (ch ^ (((row & 3u) << 2) | ((row >> 2) & 3u))); }
__device__ __forceinline__ bf16x8 row_frag(LAS unsigned char* img, int lane, int rb, int s) { return *(const LAS bf16x8*)(img + offb((lane & 15) + 16 * rb, 4 * s + (lane >> 4))); }
__device__ __forceinline__ bf16x8 tr_frag(LAS unsigned char* img, int lane, int c, int ks) {
    const unsigned g = lane >> 4, q = (lane & 15) >> 2, p = lane & 3;
    const s16x4 a = __builtin_amdgcn_ds_read_tr16_b64_v4i16((LAS s16x4*)(img + offb(32 * ks + 8 * g + q, 2 * c + (p >> 1)) + 8 * (p & 1)));
    const s16x4 b = __builtin_amdgcn_ds_read_tr16_b64_v4i16((LAS s16x4*)(img + offb(32 * ks + 8 * g + 4 + q, 2 * c + (p >> 1)) + 8 * (p & 1)));
    bf16x8 r; r[0] = a[0]; r[1] = a[1]; r[2] = a[2]; r[3] = a[3]; r[4] = b[0]; r[5] = b[1]; r[6] = b[2]; r[7] = b[3]; return r;
}
#define MFMA16(a, b, c) __builtin_amdgcn_mfma_f32_16x16x32_bf16(a, b, c, 0, 0, 0)
__device__ __forceinline__ bf16x8 tr_frag2(LAS unsigned char* img, int lane, int c, int ks) {
    const unsigned g = lane >> 4, q = (lane & 15) >> 2, p = lane & 3;
    const s16x4 a = __builtin_amdgcn_ds_read_tr16_b64_v4i16((LAS s16x4*)(img + offb(32 * ks + 4 * g + q, 2 * c + (p >> 1)) + 8 * (p & 1)));
    const s16x4 b = __builtin_amdgcn_ds_read_tr16_b64_v4i16((LAS s16x4*)(img + offb(32 * ks + 16 + 4 * g + q, 2 * c + (p >> 1)) + 8 * (p & 1)));
    bf16x8 r; r[0] = a[0]; r[1] = a[1]; r[2] = a[2]; r[3] = a[3]; r[4] = b[0]; r[5] = b[1]; r[6] = b[2]; r[7] = b[3]; return r;
}
__device__ __forceinline__ void glds16_asm(const void* gsrc, unsigned lds_dst) { unsigned keep;
    asm volatile("s_mov_b32 %0, m0\n\ts_mov_b32 m0, %2\n\ts_nop 0\n\tglobal_load_lds_dwordx4 %1, off\n\ts_mov_b32 m0, %0" : "=&s"(keep) : "v"(gsrc), "s"(lds_dst) : "memory"); }
#define GLDS16(gsrc, ldst) glds16_asm((const void*)(gsrc), (unsigned)(unsigned long)(LAS unsigned char*)(ldst))
#define RAW_BAR() do { asm volatile("s_waitcnt lgkmcnt(0)" ::: "memory"); __builtin_amdgcn_s_barrier(); asm volatile("" ::: "memory"); } while (0)
__device__ __forceinline__ void retention_unit(Frame& F, int b, int h) {
    LAS unsigned char* KI = F.lds; LAS unsigned char* VI0 = F.lds + 32768; LAS unsigned char* SI = F.lds + 98304;
    const int lane = lane_id(), w = F.wave, l15 = lane & 15, lg = lane >> 4;
    const int rtw = (w < 4) ? w : 11 - w;
    const float gC = expf(128.0f * log1pf(-exp2f(-5.0f - (float)h)));
    LAS float* GN = (LAS float*)(F.lds + 131072);
    if (w < 2) GN[w * 64 + lane] = F.ret_norm_g[h * HD + w * 64 + lane];
    const bf16_t* proj = (const bf16_t*)(F.ws + WS_R2);
    bf16_t* mix = (bf16_t*)(F.ws + WS_R1);
    f32x4 accS[8];
#pragma unroll
    for (int c = 0; c < 8; ++c) accS[c] = (f32x4){0.f, 0.f, 0.f, 0.f};
    const int il = 16 * rtw + l15;
    unsigned dsrc[4];
#pragma unroll
    for (int i = 0; i < 4; ++i) { const unsigned row = 16 * w + 4 * i + lg; dsrc[i] = row * (HD * 2) + 16u * ((unsigned)l15 ^ (((row & 3u) << 2) | ((row >> 2) & 3u))); }
    const char* kbase = (const char*)(proj + ((size_t)(8 + h) * T + b * SEQ) * HD);
    const size_t vofs = (size_t)8 * T * HD * 2;
    const bf16_t* qbase = proj + ((size_t)h * T + b * SEQ + il) * HD + 8 * lg;
#define RET_DMA(img, base) do { _Pragma("unroll") for (int _i = 0; _i < 4; ++_i) GLDS16((base) + dsrc[_i], (img) + 4096 * w + 1024 * _i); } while (0)
    RET_DMA(KI, kbase); RET_DMA(VI0, kbase + vofs);
    u32x4 qn[4]; u32x2 ov[8];
#pragma unroll
    for (int s = 0; s < 4; ++s) qn[s] = *(const u32x4*)(qbase + 32 * s);
#pragma unroll
    for (int c = 0; c < 8; ++c) *(LAS u32x2*)(SI + offb(16 * c + l15, 2 * w + (lane >> 5)) + 8 * (lg & 1)) = (u32x2){0u, 0u};
#pragma unroll 1
    for (int n = 0; n < NCHUNK; ++n) {
        const int tok0 = b * SEQ + n * CHK;
        LAS unsigned char* VI = VI0 + (n & 1) * 32768;
        asm volatile("s_waitcnt vmcnt(0)" ::: "memory"); RAW_BAR();
        bf16x8 qf[4];
#pragma unroll
        for (int s = 0; s < 4; ++s) qf[s] = __builtin_bit_cast(bf16x8, qn[s]);
        const char* nk = kbase + (size_t)(n + 1) * (CHK * HD * 2);
        if (n + 1 < NCHUNK) {
            RET_DMA(VI0 + ((n + 1) & 1) * 32768, nk + vofs);
#pragma unroll
            for (int s = 0; s < 4; ++s) qn[s] = *(const u32x4*)(qbase + (size_t)(n + 1) * (CHK * HD) + 32 * s);
        }
        if (n > 0) { bf16_t* prow = mix + (size_t)(tok0 - CHK + il) * D + h * HD + 4 * lg;
#pragma unroll
            for (int c = 0; c < 8; ++c) *(u32x2*)(prow + 16 * c) = ov[c]; }
        u32x2 gv[8];
        { const bf16_t* grow = proj + ((size_t)(24 + h) * T + tok0 + il) * HD + 4 * lg;
#pragma unroll
          for (int c = 0; c < 8; ++c) gv[c] = *(const u32x2*)(grow + 16 * c); }
        bf16x8 pf[4];
#pragma unroll
        for (int s = 0; s < 4; ++s) {
            f32x4 sc[2];
#pragma unroll
            for (int t = 0; t < 2; ++t) { const int jt = 2 * s + t; sc[t] = (f32x4){0.f, 0.f, 0.f, 0.f};
#pragma unroll
                for (int k = 0; k < 4; ++k) sc[t] = MFMA16(row_frag(KI, lane, jt, k), qf[k], sc[t]);
                const int j0 = 16 * jt + 4 * lg;
#pragma unroll
                for (int r = 0; r < 4; ++r) sc[t][r] = (j0 + r > il) ? 0.f : sc[t][r]; }
            const u32x4 pw = (u32x4){pk2(sc[0][0], sc[0][1]), pk2(sc[0][2], sc[0][3]), pk2(sc[1][0], sc[1][1]), pk2(sc[1][2], sc[1][3])};
            pf[s] = __builtin_bit_cast(bf16x8, pw);
        }
        bf16x8 ktf[4];
#pragma unroll
        for (int s = 0; s < 4; ++s) ktf[s] = tr_frag2(KI, lane, w, s);
        RAW_BAR();
        if (n + 1 < NCHUNK) RET_DMA(KI, nk);
        f32x4 accO[8];
        bf16x8 vfr[2][4], sfr[2][4];
#pragma unroll
        for (int s = 0; s < 4; ++s) { vfr[0][s] = tr_frag2(VI, lane, 0, s); sfr[0][s] = row_frag(SI, lane, 0, s); }
#pragma unroll
        for (int c = 0; c < 8; ++c) {
            if (c < 7) {
#pragma unroll
                for (int s = 0; s < 4; ++s) { vfr[(c + 1) & 1][s] = tr_frag2(VI, lane, c + 1, s); sfr[(c + 1) & 1][s] = row_frag(SI, lane, c + 1, s); } }
            f32x4 o = (f32x4){0.f, 0.f, 0.f, 0.f};
#pragma unroll
            for (int s = 0; s < 4; ++s) o = MFMA16(vfr[c & 1][s], pf[s], o);
#pragma unroll
            for (int s = 0; s < 4; ++s) o = MFMA16(sfr[c & 1][s], qf[s], o);
            accO[c] = o;
#pragma unroll
            for (int s = 0; s < 4; ++s) accS[c] = MFMA16(ktf[s], vfr[c & 1][s], accS[c]);
            __builtin_amdgcn_sched_barrier(0);
        }
        {
            float s1 = 0.f;
#pragma unroll
            for (int c = 0; c < 8; ++c) s1 += (accO[c][0] + accO[c][1]) + (accO[c][2] + accO[c][3]);
            s1 += __shfl_xor(s1, 16); s1 += __shfl_xor(s1, 32);
            const float mu = s1 * (1.0f / 128.0f); float s2 = 0.f;
#pragma unroll
            for (int c = 0; c < 8; ++c) { const f32x4 d = accO[c] - mu; s2 += (d[0] * d[0] + d[1] * d[1]) + (d[2] * d[2] + d[3] * d[3]); }
            s2 += __shfl_xor(s2, 16); s2 += __shfl_xor(s2, 32);
            const float rstd = 1.0f / sqrtf(s2 * (1.0f / 128.0f) + EPS);
#pragma unroll
            for (int c = 0; c < 8; ++c) {
                const f32x4 gain = *(const LAS f32x4*)(GN + 16 * c + 4 * lg);
                const float g[4] = {bflo(gv[c].x), bfhi(gv[c].x), bflo(gv[c].y), bfhi(gv[c].y)}; float o[4];
#pragma unroll
                for (int r = 0; r < 4; ++r) o[r] = (accO[c][r] - mu) * rstd * gain[r] * g[r];
                ov[c].x = pk2(o[0], o[1]); ov[c].y = pk2(o[2], o[3]);
            }
        }
        RAW_BAR();
#pragma unroll
        for (int c = 0; c < 8; ++c) { accS[c] = accS[c] * gC; u32x2 wv; wv.x = pk2(accS[c][0], accS[c][1]); wv.y = pk2(accS[c][2], accS[c][3]);
            *(LAS u32x2*)(SI + offb(16 * c + l15, 2 * w + (lane >> 5)) + 8 * (lg & 1)) = wv; }
    }
    { bf16_t* prow = mix + (size_t)(b * SEQ + (NCHUNK - 1) * CHK + il) * D + h * HD + 4 * lg;
#pragma unroll
      for (int c = 0; c < 8; ++c) *(u32x2*)(prow + 16 * c) = ov[c]; }
    asm volatile("s_waitcnt vmcnt(0)" ::: "memory"); RAW_BAR();
#undef RET_DMA
}
template <int N> __device__ __forceinline__ float dpp_shr(float old, float src) {
    return __builtin_bit_cast(float, __builtin_amdgcn_update_dpp(__builtin_bit_cast(int, old), __builtin_bit_cast(int, src), 0x110 + N, 0xf, 0xf, false));
}
__device__ __forceinline__ float sigmoidf_(float x) { return __builtin_amdgcn_rcpf(1.0f + __expf(-x)); }
__device__ __forceinline__ float gelu_tanh(float z) { const float y2 = 1.5957691216057308f * (z + 0.044715f * z * z * z); return z * __builtin_amdgcn_rcpf(1.0f + __expf(-y2)); }
template <int N> __device__ __forceinline__ float dpp_shr0(float src) {
    return __builtin_bit_cast(float, __builtin_amdgcn_update_dpp(0, __builtin_bit_cast(int, src), 0x110 + N, 0xf, 0xf, true));
}
__device__ __forceinline__ float row_prefix_sum(float v) { v += dpp_shr0<1>(v); v += dpp_shr0<2>(v); v += dpp_shr0<4>(v); v += dpp_shr0<8>(v); return v; }
__device__ __forceinline__ void lru_unit(Frame& F, int b, int nb) {
    constexpr int RAWB = 132 * 256;
    LAS unsigned char* UI0 = F.lds; LAS unsigned char* RAW0 = F.lds + 65536; LAS float* PART = (LAS float*)(F.lds + 65536 + 2 * RAWB); LAS float* CW = PART + 1024;
    static_assert(65536 + 2 * RAWB + 4096 + 2560 <= LDSCTL_OFF, "LRU scratch below the LDS control words");
    const int lane = lane_id(), w = F.wave, tid = w * 64 + lane, l15 = lane & 15, lg = lane >> 4, cb = 128 * nb;
    const bf16_t* proj = (const bf16_t*)(F.ws + WS_R2);
    bf16_t* mix = (bf16_t*)(F.ws + WS_R1);
    const char* zline = (const char*)(F.ws + WS_CTL + 61440);
    const char* ubase = (const char*)(proj + ((size_t)(32 + nb) * T + b * SEQ) * HD);
#define LRU_DMA(n_, buf) do { _Pragma("unroll") for (int _i = 0; _i < 5; ++_i) { if (_i < 4 || w == 0) { const int _r = (_i < 4 ? 16 * w + 4 * _i : 128) + lg; int _pos = 128 * (n_) - 3 + _r; _pos = _pos > SEQ - 1 ? SEQ - 1 : _pos; \
        const char* _src = _pos < 0 ? zline + 16 * l15 : ubase + (size_t)_pos * (HD * 2) + 16 * (l15 ^ (_r & 15)); GLDS16(_src, (buf) + 256 * (_i < 4 ? 16 * w + 4 * _i : 128)); } } } while (0)
    const int sj = tid >> 2, sc0 = tid & 3;
#define LRU_CONV(RAW, UI) do { _Pragma("unroll") for (int q = 0; q < 4; ++q) { const int ch = sc0 + 4 * q; float a8[8]; \
            { const f32x4 b0 = *(const LAS f32x4*)(CW + 512 + 8 * ch), b1 = *(const LAS f32x4*)(CW + 512 + 8 * ch + 4); a8[0] = b0.x; a8[1] = b0.y; a8[2] = b0.z; a8[3] = b0.w; a8[4] = b1.x; a8[5] = b1.y; a8[6] = b1.z; a8[7] = b1.w; } \
            _Pragma("unroll") for (int k = 0; k < 4; ++k) { const int rr = sj + k; const u32x4 uv = *(const LAS u32x4*)((RAW) + 256 * rr + 16 * (ch ^ (rr & 15))); \
                const f32x4 w0 = *(const LAS f32x4*)(CW + k * 128 + 8 * ch), w1 = *(const LAS f32x4*)(CW + k * 128 + 8 * ch + 4); \
                a8[0] += w0.x * bflo(uv.x); a8[1] += w0.y * bfhi(uv.x); a8[2] += w0.z * bflo(uv.y); a8[3] += w0.w * bfhi(uv.y); \
                a8[4] += w1.x * bflo(uv.z); a8[5] += w1.y * bfhi(uv.z); a8[6] += w1.z * bflo(uv.w); a8[7] += w1.w * bfhi(uv.w); } \
            u32x4 o; o.x = pk2(a8[0], a8[1]); o.y = pk2(a8[2], a8[3]); o.z = pk2(a8[4], a8[5]); o.w = pk2(a8[6], a8[7]); \
            *(LAS u32x4*)((UI) + offb(sj, ch)) = o; } } while (0)
    LRU_DMA(0, RAW0);
    for (int i = tid; i < 640; i += NTHREADS) CW[i] = (i < 512) ? F.conv_w[(i >> 7) * 1024 + cb + (i & 127)] : F.conv_b[cb + i - 512];
    bf16x8 wrf[4], wif[4];
#pragma unroll
    for (int s = 0; s < 4; ++s)
#pragma unroll
        for (int jj = 0; jj < 8; ++jj) { const int c = 32 * s + 8 * lg + jj; const size_t o = ((size_t)(nb * 128 + c)) * 128 + 16 * w + l15;
            wrf[s][jj] = (short)f2bf(F.w_rg[o]); wif[s][jj] = (short)f2bf(F.w_ig[o]); }
    const int d0 = cb + 16 * w + 4 * lg;
    const f32x4 brg = *(const f32x4*)(F.b_rg + d0), big = *(const f32x4*)(F.b_ig + d0), lam = *(const f32x4*)(F.lam + d0), ng = *(const f32x4*)(F.lru_norm_g + d0);
    f32x4 spl;
#pragma unroll
    for (int r = 0; r < 4; ++r) spl[r] = -8.0f * log1pf(expf(-lam[r])) * 1.4426950408889634f;
    f32x4 Hc = (f32x4){0.f, 0.f, 0.f, 0.f};
    const bf16_t* zbase = proj + ((size_t)(40 + nb) * T + b * SEQ + l15) * HD + 16 * w + 4 * lg;
    bf16_t* obase = mix + (size_t)(b * SEQ + l15) * D + 1024 + d0;
    asm volatile("s_waitcnt vmcnt(0)" ::: "memory"); RAW_BAR();
    LRU_DMA(1, RAW0 + RAWB);
    LRU_CONV(RAW0, UI0);
    u32x2 zv[8];
#pragma unroll
    for (int tt = 0; tt < 8; ++tt) zv[tt] = *(const u32x2*)(zbase + (size_t)(16 * tt) * HD);
    RAW_BAR();
#pragma unroll 1
    for (int n = 0; n < NCHUNK; ++n) {
        LAS unsigned char* UI = UI0 + (n & 1) * 32768;
        f32x4 hv[8]; float ssq[8];
        f32x4 aR = (f32x4){0.f, 0.f, 0.f, 0.f}, aI = (f32x4){0.f, 0.f, 0.f, 0.f};
#pragma unroll
        for (int s = 0; s < 4; ++s) { const bf16x8 uf = row_frag(UI, lane, 0, s); aR = MFMA16(wrf[s], uf, aR); aI = MFMA16(wif[s], uf, aI); }
#pragma unroll
        for (int tt = 0; tt < 8; ++tt) {
            f32x4 aRn = (f32x4){0.f, 0.f, 0.f, 0.f}, aIn = (f32x4){0.f, 0.f, 0.f, 0.f};
            if (tt < 7) {
#pragma unroll
                for (int s = 0; s < 4; ++s) { const bf16x8 uf = row_frag(UI, lane, tt + 1, s); aRn = MFMA16(wrf[s], uf, aRn); aIn = MFMA16(wif[s], uf, aIn); } }
            const int dl = 16 * w + 4 * lg;
            const u32x2 ucv = *(const LAS u32x2*)(UI + offb(16 * tt + l15, dl >> 3) + (dl & 7) * 2);
            const f32x4 uc = (f32x4){bflo(ucv.x), bfhi(ucv.x), bflo(ucv.y), bfhi(ucv.y)};
            const f32x4 xr = (aR + brg) * -1.4426950408889634f, xi = (aI + big) * -1.4426950408889634f;
            f32x4 er, ei;
#pragma unroll
            for (int r = 0; r < 4; ++r) { er[r] = __builtin_amdgcn_exp2f(xr[r]); ei[r] = __builtin_amdgcn_exp2f(xi[r]); }
            er = er + 1.0f; ei = ei + 1.0f;
            f32x4 rg, ig;
#pragma unroll
            for (int r = 0; r < 4; ++r) { rg[r] = __builtin_amdgcn_rcpf(er[r]); ig[r] = __builtin_amdgcn_rcpf(ei[r]); }
            const f32x4 la = spl * rg;
            f32x4 A, B;
#pragma unroll
            for (int r = 0; r < 4; ++r) A[r] = __builtin_amdgcn_exp2f(la[r]);
            { f32x4 om = 1.0f - A * A;
#pragma unroll
              for (int r = 0; r < 4; ++r) om[r] = __builtin_amdgcn_sqrtf(fmaxf(om[r], 0.f));
              B = om * ig * uc; }
#define LRU_STEP(N) do { _Pragma("unroll") for (int r = 0; r < 4; ++r) { const float Ap = dpp_shr<N>(1.0f, A[r]), Bp = dpp_shr0<N>(B[r]); B[r] = A[r] * Bp + B[r]; A[r] = A[r] * Ap; } } while (0)
            LRU_STEP(1); LRU_STEP(2); LRU_STEP(4); LRU_STEP(8);
#undef LRU_STEP
            const f32x4 hh = A * Hc + B;
            float q = 0.f;
#pragma unroll
            for (int r = 0; r < 4; ++r) { Hc[r] = __shfl(hh[r], (lane & 48) | 15); q += hh[r] * hh[r]; }
            hv[tt] = hh;
            q += __shfl_xor(q, 16); q += __shfl_xor(q, 32);
            ssq[tt] = q; aR = aRn; aI = aIn;
            __builtin_amdgcn_sched_barrier(0);
        }
        if (lg == 0) {
#pragma unroll
            for (int tt = 0; tt < 8; ++tt) PART[w * 128 + 16 * tt + l15] = ssq[tt];
        }
        asm volatile("s_waitcnt vmcnt(0)" ::: "memory"); RAW_BAR();
#pragma unroll
        for (int tt = 0; tt < 8; ++tt) {
            const int tk = 16 * tt + l15; float tot = 0.f;
#pragma unroll
            for (int ww = 0; ww < 8; ++ww) tot += PART[ww * 128 + tk];
            const float rs = __builtin_amdgcn_rsqf(tot * (1.0f / 128.0f) + EPS);
            const float z[4] = {bflo(zv[tt].x), bfhi(zv[tt].x), bflo(zv[tt].y), bfhi(zv[tt].y)}; float o[4];
#pragma unroll
            for (int r = 0; r < 4; ++r) o[r] = hv[tt][r] * rs * ng[r] * z[r];
            u32x2 wv; wv.x = pk2(o[0], o[1]); wv.y = pk2(o[2], o[3]);
            *(u32x2*)(obase + (size_t)(n * CHK + 16 * tt) * D) = wv;
        }
        if (n + 1 < NCHUNK) {
            LRU_CONV(RAW0 + ((n + 1) & 1) * RAWB, UI0 + ((n + 1) & 1) * 32768);
#pragma unroll
            for (int tt = 0; tt < 8; ++tt) zv[tt] = *(const u32x2*)(zbase + (size_t)((n + 1) * CHK + 16 * tt) * HD);
        }
        RAW_BAR();
        if (n + 2 < NCHUNK) LRU_DMA(n + 2, RAW0 + (n & 1) * RAWB);
    }
    asm volatile("s_waitcnt vmcnt(0)" ::: "memory"); RAW_BAR();
#undef LRU_DMA
#undef LRU_CONV
}
__device__ __forceinline__ void router_phase(Frame& F) {
    const bf16_t* dl = (const bf16_t*)(F.ws + WS_X1); bf16_t* x1b = (bf16_t*)(F.ws + WS_X1 + 128 * MiB);
    unsigned char* h2 = F.ws + WS_H2;
    const bf16_t* whi = (const bf16_t*)(F.ws + WS_WGT);
    int* tokl = (int*)(F.ws + WS_TOK); float* rss = (float*)(F.ws + WS_RSS); u32x2* apk = (u32x2*)(F.ws + WS_APK); f32x2* aw = (f32x2*)(F.ws + WS_AW);
    const int w = F.wave, lane = lane_id(), l15 = lane & 15, lg = lane >> 4;
    LAS float* LG = (LAS float*)(F.lds + 65536 + w * 4096);
    LAS unsigned char* WB0 = F.lds;
    unsigned wsrc[3];
#pragma unroll
    for (int i = 0; i < 3; ++i) { const unsigned row = 4 * (3 * w + i) + lg; wsrc[i] = row * (D * 2) + 16u * ((unsigned)l15 ^ (row & 15u)); }
#define RT_DMA(kc, buf) do { _Pragma("unroll") for (int _i = 0; _i < 3; ++_i) GLDS16((const char*)whi + wsrc[_i] + (kc) * 256, (buf) + 1024 * (3 * w + _i)); } while (0)
    for (int base = F.vcu * NWAVES; base < T / 16; base += F.G * NWAVES) {
        const int item = base + w; const int r0 = item * 16;
        const float* xr = F.x + (size_t)(r0 + l15) * D + 8 * lg; unsigned char* hr = h2 + (size_t)(r0 + l15) * D + 8 * lg;
        const bf16_t* dr = dl + (size_t)(r0 + l15) * D + 8 * lg; bf16_t* xo = x1b + (size_t)(r0 + l15) * D + 8 * lg;
        f32x4 acc[3]; float ss = 0.f;
#pragma unroll
        for (int ct = 0; ct < 3; ++ct) acc[ct] = (f32x4){0.f, 0.f, 0.f, 0.f};
        f32x4 xa[8]; u32x4 da[4];
        RT_DMA(0, WB0);
#pragma unroll 1
        for (int kc = 0; kc < 16; ++kc) {
            LAS unsigned char* WB = WB0 + (kc & 1) * 24576;
            asm volatile("s_waitcnt vmcnt(0)" ::: "memory"); RAW_BAR();
            if (kc + 1 < 16) { RT_DMA(kc + 1, WB0 + ((kc + 1) & 1) * 24576); }
#pragma unroll
            for (int j = 0; j < 4; ++j) { xa[2 * j] = *(const f32x4*)(xr + 128 * kc + 32 * j); xa[2 * j + 1] = *(const f32x4*)(xr + 128 * kc + 32 * j + 4); da[j] = *(const u32x4*)(dr + 128 * kc + 32 * j); }
#pragma unroll
            for (int j = 0; j < 4; ++j) {
                const f32x4 a0 = xa[2 * j] + (f32x4){bflo(da[j].x), bfhi(da[j].x), bflo(da[j].y), bfhi(da[j].y)}, a1 = xa[2 * j + 1] + (f32x4){bflo(da[j].z), bfhi(da[j].z), bflo(da[j].w), bfhi(da[j].w)};
                ss += (a0.x * a0.x + a0.y * a0.y) + (a0.z * a0.z + a0.w * a0.w) + (a1.x * a1.x + a1.y * a1.y) + (a1.z * a1.z + a1.w * a1.w);
                const float av[8] = {a0.x, a0.y, a0.z, a0.w, a1.x, a1.y, a1.z, a1.w};
                unsigned hw[4], lw[4];
#pragma unroll
                for (int i = 0; i < 4; ++i) { hw[i] = pk2(av[2 * i], av[2 * i + 1]); lw[i] = pk2(av[2 * i] - bflo(hw[i]), av[2 * i + 1] - bfhi(hw[i])); }
                const u32x4 xh4 = (u32x4){hw[0], hw[1], hw[2], hw[3]}, xl4 = (u32x4){lw[0], lw[1], lw[2], lw[3]};
                *(u32x2*)(hr + 128 * kc + 32 * j) = (u32x2){pk4_fp8(av[0], av[1], av[2], av[3]), pk4_fp8(av[4], av[5], av[6], av[7])};
                *(u32x4*)(xo + 128 * kc + 32 * j) = xh4;
                const bf16x8 xh = __builtin_bit_cast(bf16x8, xh4), xl = __builtin_bit_cast(bf16x8, xl4);
#pragma unroll
                for (int ct = 0; ct < 3; ++ct) { const unsigned rh = 16 * ct + l15, rl = 48 + 16 * ct + l15;
                    const bf16x8 bh = *(const LAS bf16x8*)(WB + 256 * rh + 16 * ((4 * j + lg) ^ (rh & 15))), bl = *(const LAS bf16x8*)(WB + 256 * rl + 16 * ((4 * j + lg) ^ (rl & 15)));
                    acc[ct] = MFMA16(xh, bh, acc[ct]); acc[ct] = MFMA16(xh, bl, acc[ct]); acc[ct] = MFMA16(xl, bh, acc[ct]); }
            }
        }
        ss += __shfl_xor(ss, 16); ss += __shfl_xor(ss, 32);
#pragma unroll
        for (int ct = 0; ct < 3; ++ct)
#pragma unroll
            for (int r = 0; r < 4; ++r) LG[(4 * lg + r) * 48 + 16 * ct + l15] = acc[ct][r];
        LDS_WAIT();
        if (lane < 16) {
            const int t = r0 + lane; const float rs = 1.0f / sqrtf(ss * (1.0f / D) + EPS);
            const LAS float* L = LG + lane * 48;
            float gl[4];
#pragma unroll
            for (int j = 0; j < 4; ++j) gl[j] = L[j] * rs + F.b_group[j];
            int g = 0; float gm = gl[0];
#pragma unroll
            for (int j = 1; j < 4; ++j) if (gl[j] > gm) { gm = gl[j]; g = j; }
            float den = 0.f;
#pragma unroll
            for (int j = 0; j < 4; ++j) den += expf(gl[j] - gm);
            const float gp = 1.0f / den;
            float v[8];
#pragma unroll
            for (int q = 0; q < 8; ++q) v[q] = L[4 + 8 * g + q] * rs + F.b_router[8 * g + q];
            int ia = 0; float va = v[0];
#pragma unroll
            for (int q = 1; q < 8; ++q) if (v[q] > va) { va = v[q]; ia = q; }
            int ib = -1; float vb = -3.0e38f;
#pragma unroll
            for (int q = 0; q < 8; ++q) if (q != ia && v[q] > vb) { vb = v[q]; ib = q; }
            const float wa = 1.0f / (1.0f + expf(vb - va)), wb = 1.0f - wa;
            const int ea = 8 * g + ia, eb = 8 * g + ib;
            const unsigned ra = atomicAdd(F.ctl + CW_CNT + 64 * ea, 1u), rb = atomicAdd(F.ctl + CW_CNT + 64 * eb, 1u);
            tokl[(size_t)ea * CAP + ra] = t; tokl[(size_t)eb * CAP + rb] = t; rss[(size_t)ea * CAP + ra] = rs; rss[(size_t)eb * CAP + rb] = rs;
            apk[t] = (u32x2){((unsigned)ea << 16) | ra, ((unsigned)eb << 16) | rb}; aw[t] = (f32x2){wa * gp, wb * gp};
        }
        LDS_WAIT();
    }
#undef RT_DMA
}
__device__ __forceinline__ void compute_tile_start(Frame& F) {
    LAS int* ts = (LAS int*)(F.lds + TS_OFF); LAS int* cn = (LAS int*)(F.lds + CN_OFF);
    const int tid = F.wave * 64 + lane_id();
    if (tid < NE) { int c = (int)__hip_atomic_load(F.ctl + CW_CNT + 64 * tid, __ATOMIC_RELAXED, __HIP_MEMORY_SCOPE_AGENT); cn[tid] = c < 0 ? 0 : (c > CAP ? CAP : c); }
    __syncthreads();
    if (tid == 0) { int a = 0; for (int e = 0; e < NE; ++e) { ts[e] = a; a += (cn[e] + 255) >> 8; } ts[NE] = a > MAXRT ? MAXRT : a; }
    __syncthreads();
    if (tid < MAXRT) { int e = 0; for (int j = 1; j < NE; ++j) e = (ts[j] <= tid) ? j : e; ((LAS unsigned char*)(F.lds + RE_OFF))[tid] = (unsigned char)e; }
    __syncthreads();
}
__device__ __forceinline__ void combine_phase(Frame& F) {
    const bf16_t* x1 = (const bf16_t*)(F.ws + WS_X1 + 128 * MiB); const unsigned char* Y = F.ws + WS_Y;
    const u32x2* apk = (const u32x2*)(F.ws + WS_APK); const f32x2* aw = (const f32x2*)(F.ws + WS_AW);
    const LAS int* ts = (const LAS int*)(F.lds + TS_OFF);
    const int gw = F.vcu * NWAVES + F.wave, NGW = F.G * NWAVES, lane = lane_id();
    int m = gw; if (m >= T) return;
    u32x2 pk[2]; f32x2 ww[2];
#pragma unroll
    for (int r = 0; r < 2; ++r) { const int mr = m + r * NGW < T ? m + r * NGW : m; pk[r] = apk[mr]; ww[r] = aw[mr]; }
    for (; m < T; m += 2 * NGW) {
        u32x4 xa[2][4]; u32x2 p[2][4], q[2][4]; float w0[2], w1[2]; int mr[2];
#pragma unroll
        for (int r = 0; r < 2; ++r) {
            mr[r] = m + r * NGW < T ? m + r * NGW : m;
            const int e0 = (pk[r].x >> 16) & 31, e1 = (pk[r].y >> 16) & 31;
            const size_t row0 = (size_t)256 * ts[e0] + (pk[r].x & 0xffffu), row1 = (size_t)256 * ts[e1] + (pk[r].y & 0xffffu);
            w0[r] = ww[r].x * (1.0f / SC_Y); w1[r] = ww[r].y * (1.0f / SC_Y);
            const bf16_t* xr = x1 + (size_t)mr[r] * D + 8 * lane; const unsigned char* y0 = Y + row0 * D + 8 * lane; const unsigned char* y1 = Y + row1 * D + 8 * lane;
#pragma unroll
            for (int j = 0; j < 4; ++j) { xa[r][j] = *(const u32x4*)(xr + 512 * j); p[r][j] = *(const u32x2*)(y0 + 512 * j); q[r][j] = *(const u32x2*)(y1 + 512 * j); }
        }
#pragma unroll
        for (int r = 0; r < 2; ++r) { const int mn = m + (2 + r) * NGW < T ? m + (2 + r) * NGW : mr[r]; pk[r] = apk[mn]; ww[r] = aw[mn]; }
#pragma unroll
        for (int r = 0; r < 2; ++r) {
            float v[4][8]; float ss = 0.f;
#pragma unroll
            for (int j = 0; j < 4; ++j) {
                const f32x2 p0 = __builtin_amdgcn_cvt_pk_f32_fp8((int)p[r][j].x, false), p1 = __builtin_amdgcn_cvt_pk_f32_fp8((int)p[r][j].x, true), p2 = __builtin_amdgcn_cvt_pk_f32_fp8((int)p[r][j].y, false), p3 = __builtin_amdgcn_cvt_pk_f32_fp8((int)p[r][j].y, true);
                const f32x2 q0 = __builtin_amdgcn_cvt_pk_f32_fp8((int)q[r][j].x, false), q1 = __builtin_amdgcn_cvt_pk_f32_fp8((int)q[r][j].x, true), q2 = __builtin_amdgcn_cvt_pk_f32_fp8((int)q[r][j].y, false), q3 = __builtin_amdgcn_cvt_pk_f32_fp8((int)q[r][j].y, true);
                const u32x4 xw = xa[r][j];
                v[j][0] = bflo(xw.x) + w0[r] * p0.x + w1[r] * q0.x; v[j][1] = bfhi(xw.x) + w0[r] * p0.y + w1[r] * q0.y;
                v[j][2] = bflo(xw.y) + w0[r] * p1.x + w1[r] * q1.x; v[j][3] = bfhi(xw.y) + w0[r] * p1.y + w1[r] * q1.y;
                v[j][4] = bflo(xw.z) + w0[r] * p2.x + w1[r] * q2.x; v[j][5] = bfhi(xw.z) + w0[r] * p2.y + w1[r] * q2.y;
                v[j][6] = bflo(xw.w) + w0[r] * p3.x + w1[r] * q3.x; v[j][7] = bfhi(xw.w) + w0[r] * p3.y + w1[r] * q3.y;
#pragma unroll
                for (int i = 0; i < 8; ++i) ss += v[j][i] * v[j][i];
            }
            const float rs = 1.0f / sqrtf(wave_sum(ss) * (1.0f / D) + EPS);
            if (r == 0 || m + NGW < T) {
                float* orow = F.out + (size_t)mr[r] * D + 8 * lane; const float* gf = F.norm_final_g + 8 * lane;
#pragma unroll
                for (int j = 0; j < 4; ++j) { const f32x4 g0 = *(const f32x4*)(gf + 512 * j), g1 = *(const f32x4*)(gf + 512 * j + 4);
                    *(f32x4*)(orow + 512 * j) = (f32x4){v[j][0] * rs * g0.x, v[j][1] * rs * g0.y, v[j][2] * rs * g0.z, v[j][3] * rs * g0.w};
                    *(f32x4*)(orow + 512 * j + 4) = (f32x4){v[j][4] * rs * g1.x, v[j][5] * rs * g1.y, v[j][6] * rs * g1.z, v[j][7] * rs * g1.w}; }
            }
        }
    }
}
__device__ __forceinline__ void final_norm_only(Frame& F, const float* src) {
    const int gw = F.vcu * NWAVES + F.wave, NGW = F.G * NWAVES, lane = lane_id();
    for (int m = gw; m < T; m += NGW) {
        const f32x4* xr = (const f32x4*)(src + (size_t)m * D) + lane; const f32x4* gr = (const f32x4*)F.norm_final_g + lane;
        f32x4 v[8]; float s = 0.f;
#pragma unroll
        for (int j = 0; j < 8; ++j) { v[j] = xr[64 * j]; s += (v[j].x * v[j].x + v[j].y * v[j].y) + (v[j].z * v[j].z + v[j].w * v[j].w); }
        const float rs = 1.0f / sqrtf(wave_sum(s) * (1.0f / D) + EPS);
        f32x4* o = (f32x4*)(F.out + (size_t)m * D) + lane;
#pragma unroll
        for (int j = 0; j < 8; ++j) { const f32x4 g = gr[64 * j]; o[64 * j] = (f32x4){v[j].x * rs * g.x, v[j].y * rs * g.y, v[j].z * rs * g.z, v[j].w * rs * g.w}; }
    }
}

struct Args { const float* in[22]; float* out; unsigned char* ws; int ph_lo, ph_hi, li, pad; };
__global__ void __launch_bounds__(NTHREADS, 2) hymba_fwd(Args args) {
    extern __shared__ __attribute__((aligned(16))) unsigned char lds[];
    Frame F;
    F.lds = (LAS unsigned char*)lds;
    F.MISC = (volatile LAS unsigned*)(F.lds + MISC_OFF);
    F.wave = __builtin_amdgcn_readfirstlane(threadIdx.x >> 6);
    F.G = gridDim.x; { const int bx = blockIdx.x; F.vcu = (F.G % 8 == 0) ? (bx % 8) * (F.G / 8) + bx / 8 : bx; }
    unsigned char* ws = args.ws; F.ws = ws; F.ctl = (unsigned*)(ws + WS_CTL); F.out = args.out;
    F.x = args.in[0]; F.norm_mix_g = args.in[1]; F.w_in = args.in[2]; F.ret_norm_g = args.in[3]; F.conv_w = args.in[4]; F.conv_b = args.in[5]; F.w_rg = args.in[6]; F.b_rg = args.in[7];
    F.w_ig = args.in[8]; F.b_ig = args.in[9]; F.lam = args.in[10]; F.lru_norm_g = args.in[11]; F.w_out = args.in[12]; F.norm_ffn_g = args.in[13]; F.w_group = args.in[14]; F.b_group = args.in[15];
    F.w_router = args.in[16]; F.b_router = args.in[17]; F.w_gate = args.in[18]; F.w_up = args.in[19]; F.w_down = args.in[20]; F.norm_final_g = args.in[21];
    for (int u = threadIdx.x; u < (LDS_BYTES - LDSCTL_OFF) / 4; u += NTHREADS) ((LAS unsigned*)(F.lds + LDSCTL_OFF))[u] = 0u;
    __syncthreads();
    const int lo = args.ph_lo, hi = args.ph_hi;
    XcdBarrier bar; bar.bar = F.ctl + CW_BAR; bar.x = 0; bar.st = nullptr;
    if (hi - lo > 1) bar = xcd_barrier_post(F.ctl + CW_BAR, F.MISC + 8);
#define IN(k) (lo <= (k) && (k) < hi)
#define BOTH(k) (IN(k) && IN((k) + 1))
#define GRID_BAR() xcd_barrier(bar)

    if (IN(0)) { p0_prologue(F); if (BOTH(0)) GRID_BAR(); }
    if (IN(1)) {
        const int G1 = (F.G > 2 * NCONV) ? F.G - NCONV : F.G;
        if ((int)blockIdx.x < G1) {
        pg8::DenseSched<D, T / 256, PROJ / 256, true, true> S; S.so.init(T, PROJ, G1, (int)blockIdx.x); S.A = (const char*)(ws + WS_R1); S.B = (const char*)(ws + WS_WIN);
        pg8::EpiProj E{(bf16_t*)(ws + WS_R2), PROJ, (const float*)(ws + WS_ROPE), (const float*)(ws + WS_ROPE) + SEQ * 64};
        pg8::gemm_phase<pg8::EpiProj, pg8::DenseSched<D, T / 256, PROJ / 256, true, true>, D, true, PG8_ALIGN, PG8_SP2>(F.lds, S, E, F.wave);
        }
        convert_queue(F);
        if (BOTH(1)) GRID_BAR();
    }
    if (IN(2)) {
        for (int u = (int)blockIdx.x; u < 128; u += F.G) retention_unit(F, u >> 3, u & 7);
        for (int u = (int)((blockIdx.x + (unsigned)F.G - (128u % (unsigned)F.G)) % (unsigned)F.G); u < 128; u += F.G) lru_unit(F, u >> 3, u & 7);
        if (BOTH(2)) GRID_BAR();
    }
    if (IN(3)) {
        pg8::DenseSched<D, T / 256, D / 256, false, true> S; S.so.init(T, D, F.G, (int)blockIdx.x); S.A = (const char*)(ws + WS_R1); S.B = (const char*)(ws + WS_WOUT);
        pg8::EpiBf16 E{(bf16_t*)(ws + WS_X1), D, 1.0f};
        pg8::gemm_phase<pg8::EpiBf16, pg8::DenseSched<D, T / 256, D / 256, false, true>, D, true, PG8_ALIGN, PG8_SP2>(F.lds, S, E, F.wave);
        if (BOTH(3)) GRID_BAR();
    }
#if MK_LAST_PHASE <= 4
    if (IN(4)) { final_norm_only(F, (const float*)(ws + WS_X1)); }
#else
    if (IN(4)) { router_phase(F); if (BOTH(4)) GRID_BAR(); }
    if (IN(5)) {
        compute_tile_start(F);
        const LAS int* ts = (const LAS int*)(F.lds + TS_OFF); const LAS int* cn = (const LAS int*)(F.lds + CN_OFF);
        pg8::MoeSched<D / 2, true> S; S.G = F.G; S.c = (int)blockIdx.x; S.nrt = __builtin_amdgcn_readfirstlane(ts[NE]); S.ts = ts; S.cn = cn;
        S.A = (const char*)(ws + WS_H2); S.B = (const char*)(ws + WS_WGU); S.bstride = (size_t)D * D; S.tok = (const int*)(ws + WS_TOK);
        pg8::EpiSwiGLU E{ws + WS_R1, (const float*)(ws + WS_RSS), cn};
        pg8::gemm_phase<pg8::EpiSwiGLU, pg8::MoeSched<D / 2, true>, D / 2, true, PG8_ALIGN, PG8_SP2, true>(F.lds, S, E, F.wave);
        if (BOTH(5)) GRID_BAR();
    }
    if (IN(6)) {
        compute_tile_start(F);
        const LAS int* ts = (const LAS int*)(F.lds + TS_OFF); const LAS int* cn = (const LAS int*)(F.lds + CN_OFF);
        pg8::MoeSched<DE / 2, true, true> S; S.G = F.G; S.c = (int)blockIdx.x; S.nrt = __builtin_amdgcn_readfirstlane(ts[NE]); S.ts = ts; S.cn = cn;
        S.A = (const char*)(ws + WS_R1); S.B = (const char*)(ws + WS_WD); S.bstride = (size_t)D * DE; S.tok = nullptr;
        pg8::EpiFp8 E{ws + WS_Y, D, SC_Y / (SC_HB * SC_WD)};
        pg8::gemm_phase<pg8::EpiFp8, pg8::MoeSched<DE / 2, true, true>, DE / 2, true, PG8_ALIGN, PG8_SP2, true>(F.lds, S, E, F.wave);
        if (BOTH(6)) GRID_BAR();
    }
    if (IN(7)) { compute_tile_start(F); combine_phase(F); }
#endif
#undef IN
#undef BOTH
#undef GRID_BAR
}

extern "C" void kernel_launch(void* const* d_in, const int* in_sizes, int n_in, void* d_out, int out_size, void* d_ws, size_t ws_size, hipStream_t stream) {
    static int grid = 0;
    if (grid == 0) {
        if (n_in != 22 || in_sizes[0] != T * D || out_size != T * D || ws_size < WS_END) { fprintf(stderr, "kernel_launch: unexpected shapes (n_in %d, in0 %d, out %d, ws %zu < %zu); nothing launched\n", n_in, n_in > 0 ? in_sizes[0] : -1, out_size, ws_size, (size_t)WS_END); grid = -1; return; }
        int dev = 0, cus = 0, per_cu = 0;
        if (hipGetDevice(&dev) != hipSuccess || hipDeviceGetAttribute(&cus, hipDeviceAttributeMultiprocessorCount, dev) != hipSuccess) { grid = -1; return; }
        if (hipFuncSetAttribute((const void*)hymba_fwd, hipFuncAttributeMaxDynamicSharedMemorySize, LDS_BYTES) != hipSuccess) { fprintf(stderr, "kernel_launch: hipFuncSetAttribute failed\n"); grid = -1; return; }
        if (hipOccupancyMaxActiveBlocksPerMultiprocessor(&per_cu, (const void*)hymba_fwd, NTHREADS, LDS_BYTES) != hipSuccess || per_cu < 1) { fprintf(stderr, "kernel_launch: occupancy query reports %d blocks per CU\n", per_cu); }
        (void)hipGetLastError();
        grid = cus;
    }
    if (grid < 0) return;
    if (hipMemsetAsync((char*)d_ws + WS_CTL, 0, CTL_ZERO_BYTES, stream) != hipSuccess) return;
    Args a{};
    for (int i = 0; i < 22; ++i) a.in[i] = (const float*)d_in[i];
    a.out = (float*)d_out; a.ws = (unsigned char*)d_ws;
    constexpr int NL = MK_N_LAUNCHES;
    constexpr int LASTP = (MK_LAST_PHASE <= 4) ? 5 : NPHASES;
    if (NL == 1) { a.ph_lo = 0; a.ph_hi = LASTP; a.li = 0; hipLaunchKernelGGL(hymba_fwd, dim3(grid), dim3(NTHREADS), LDS_BYTES, stream, a); }
    else for (int li = 0; li < LASTP; ++li) { a.ph_lo = li; a.ph_hi = li + 1; a.li = li; hipLaunchKernelGGL(hymba_fwd, dim3(grid), dim3(NTHREADS), LDS_BYTES, stream, a);
        if (li == MK_REPEAT_PHASE) hipLaunchKernelGGL(hymba_fwd, dim3(grid), dim3(NTHREADS), LDS_BYTES, stream, a); }
}
```

```cpp
#include <hip/hip_runtime.h>
#include <cstdio>
#include <cstdint>

#ifndef MK_N_LAUNCHES
#define MK_N_LAUNCHES 1
#endif
#ifndef MK_REPEAT_PHASE
#define MK_REPEAT_PHASE -1
#endif
#ifndef MK_LAST_PHASE
#define MK_LAST_PHASE 8
#endif

#define GAS __attribute__((address_space(1)))
#define LAS __attribute__((address_space(3)))
typedef unsigned short bf16_t;
typedef short bf16x8 __attribute__((ext_vector_type(8)));
typedef short s16x4 __attribute__((ext_vector_type(4)));
typedef float f32x4 __attribute__((ext_vector_type(4)));
typedef float f32x2 __attribute__((ext_vector_type(2)));
typedef unsigned u32x4 __attribute__((ext_vector_type(4)));
typedef unsigned u32x2 __attribute__((ext_vector_type(2)));
typedef GAS unsigned gu32;
typedef int i32x4 __attribute__((ext_vector_type(4)));
typedef int i32x8 __attribute__((ext_vector_type(8)));
constexpr float SC_WGU = 64.0f, SC_WD = 32.0f, SC_HB = 4.0f, SC_Y = 16.0f;

constexpr int T = 32768, D = 2048, SEQ = 2048, NBATCH = 16, PROJ = 6144;
constexpr int NH = 8, HD = 128, CHK = 128, NCHUNK = SEQ / CHK;
constexpr int NLB = 8;
constexpr int NE = 32, DE = 1024;
constexpr int CAP = 32768;
constexpr int MAXRT = 288;
constexpr float EPS = 1e-6f;
constexpr int NWAVES = 8, NTHREADS = 512;
constexpr int NPHASES = 8;

constexpr size_t MiB = 1u << 20;
constexpr size_t WS_CTL = 0, CTL_ZERO_BYTES = 65536;
constexpr size_t WS_TOK = 1 * MiB;
constexpr size_t WS_RSS = 5 * MiB;
constexpr size_t WS_APK = 9 * MiB;
constexpr size_t WS_AW  = 9 * MiB + 512 * 1024;
constexpr size_t WS_ROPE = 10 * MiB;
constexpr size_t WS_WGT = 11 * MiB;
constexpr size_t WS_WIN = 12 * MiB;
constexpr size_t WS_WOUT = 36 * MiB;
constexpr size_t WS_WD = 44 * MiB;
constexpr size_t WS_WGU = 172 * MiB;
constexpr size_t WS_R2 = 428 * MiB;
constexpr size_t WS_H2 = WS_R2, WS_X1 = WS_R2 + 128 * MiB;
constexpr size_t WS_R1 = 812 * MiB;
constexpr size_t WS_Y = WS_WGU;
constexpr size_t WS_END = 956 * MiB;
static_assert(WS_Y + (size_t)MAXRT * 256 * 2048 * 2 <= WS_X1, "y overlays Wgu + h2 only");
static_assert(WS_R1 + (size_t)MAXRT * 256 * 1024 * 2 <= WS_END, "hb fits");
constexpr int CW_BAR = 1024;
constexpr int CW_CNT = 8192;
constexpr int CW_Q = 6144;
constexpr int NCONV = 40;

constexpr int RING_BYTES = 131072;
constexpr int LDSCTL_OFF = 143360, MISC_OFF = LDSCTL_OFF + 320;
constexpr int TS_OFF = LDSCTL_OFF + 1024;
constexpr int CN_OFF = LDSCTL_OFF + 1280;
constexpr int RE_OFF = LDSCTL_OFF + 1536;
constexpr int GT_OFF = LDSCTL_OFF + 2048;
constexpr int LDS_BYTES = 147456;

#define LDS_WAIT() asm volatile("s_waitcnt lgkmcnt(0)" ::: "memory")
#define VM_WAIT() asm volatile("s_waitcnt vmcnt(0)" ::: "memory")
__device__ __forceinline__ unsigned f2bf(float f) { unsigned u = __builtin_bit_cast(unsigned, f); return (u + 0x7fffu + ((u >> 16) & 1u)) >> 16; }
typedef __bf16 hwbf16x2 __attribute__((ext_vector_type(2)));
__device__ __forceinline__ unsigned pk2(float lo, float hi) { const f32x2 v = {lo, hi}; return __builtin_bit_cast(unsigned, __builtin_convertvector(v, hwbf16x2)); }
__device__ __forceinline__ float bflo(unsigned w) { return __builtin_bit_cast(float, w << 16); }
__device__ __forceinline__ float bfhi(unsigned w) { return __builtin_bit_cast(float, w & 0xffff0000u); }
__device__ __forceinline__ float sat8(float x) { return __builtin_amdgcn_fmed3f(x, -448.0f, 448.0f); }
__device__ __forceinline__ unsigned pk4_fp8(float a, float b, float c, float d) { int p = 0; a = sat8(a); b = sat8(b); c = sat8(c); d = sat8(d); p = __builtin_amdgcn_cvt_pk_fp8_f32(a, b, p, false); p = __builtin_amdgcn_cvt_pk_fp8_f32(c, d, p, true); return (unsigned)p; }
__device__ __forceinline__ unsigned cvt_pk_bf16(float lo, float hi) { unsigned r; asm volatile("v_cvt_pk_bf16_f32 %0, %1, %2" : "=v"(r) : "v"(lo), "v"(hi)); return r; }
__device__ __forceinline__ int lane_id() { int l; asm volatile("v_mbcnt_lo_u32_b32 %0, -1, 0\n\tv_mbcnt_hi_u32_b32 %0, -1, %0" : "=v"(l)); return l; }
__device__ __forceinline__ float wave_sum(float v) {
#pragma unroll
    for (int o = 1; o < 64; o <<= 1) v += __shfl_xor(v, o);
    return v;
}

namespace pg8 {
constexpr int BM = 256, BK = 64, HALF = 128, HTB = HALF * BK * 2, STAGE_BYTES = 8 * HTB, NXCD = 8, WGM = 2;
__host__ __device__ __forceinline__ int lds_byte(int r, int c) { const int st = (r >> 4) * 2 + (c >> 5), rr = r & 15, cc = c & 31, ob = rr * 64 + cc * 2; return st * 1024 + (ob ^ (((ob >> 9) & 1) << 5)); }
__host__ __device__ __forceinline__ void stage_rc(int b, int& R, int& C) { const int st = b / 1024, sb = b % 1024, swz = sb ^ (((sb >> 9) & 1) << 5); R = (st >> 1) * 16 + swz / 64; C = (st & 1) * 32 + (swz % 64) / 2; }
__host__ __device__ __forceinline__ int perm32(int rho) { const int n = rho >> 4, i = rho & 15; return 8 * (i >> 2) + 4 * n + (i & 3); }

struct Unit { int pm, pn, e, ti; };

template <int NM, int NN> struct StaticOrder {
    static_assert(NM % WGM == 0 && (NM * NN) % NXCD == 0, "whole 8-row groups, whole XCD shares");
    int G, c;
    __device__ void init(int, int, int G_, int c_) { G = G_; c = c_; }
    __device__ bool next(int i, Unit& u) const {
        constexpr int nwg = NM * NN, q = nwg / NXCD, nig = WGM * NN;
        const int L = i * G + c; if (L >= nwg) return false;
        const int wgid = (L % NXCD) * q + L / NXCD;
        const int gid = wgid / nig, w = wgid % nig;
        u.pm = gid * WGM + (w % WGM); u.pn = w / WGM; u.e = 0; u.ti = 0; return true;
    }
};
template <int K, int NM, int NN, bool ROPE = false, bool IDENT = false> struct DenseSched {
    static constexpr bool ident = IDENT;
    StaticOrder<NM, NN> so; const char* A; const char* B;
    __device__ __forceinline__ bool bsel(const Unit& u) const { return ROPE && u.pn < 8; }
    __device__ __forceinline__ bool next(int i, Unit& u) const { return so.next(i, u); }
    __device__ __forceinline__ const char* a_ptr(const Unit& u) const { return IDENT ? A : A + (size_t)u.pm * (256 * K * 2); }
    __device__ __forceinline__ const char* b_ptr(const Unit& u) const { return B + (size_t)u.pn * (256 * K * 2); }
    __device__ __forceinline__ void gather(const Unit& u, int tid, unsigned (&v)[2][2]) const {
#pragma unroll
        for (int i = 0; i < 2; ++i) { int R, C; stage_rc(tid * 16 + i * 8192, R, C);
#pragma unroll
            for (int h = 0; h < 2; ++h) v[h][i] = ((unsigned)(u.pm * 256 + h * 128 + R) * (unsigned)K + (unsigned)C) * 2u; }
    }
    __device__ __forceinline__ const int* tok_ptr(const Unit&) const { return nullptr; }
    __device__ __forceinline__ int count(const Unit&) const { return 0; }
};
template <int K, bool GATHER, bool IDENT = false> struct MoeSched {
    static constexpr bool ident = IDENT;
    int G, c, nrt; const LAS int* ts; const LAS int* cn;
    const char* A; const char* B; size_t bstride; const int* tok;
    __device__ __forceinline__ bool bsel(const Unit&) const { return false; }
    __device__ __forceinline__ bool next(int i, Unit& u) const {
        int L;
        int rt, pnv;
        if (G == 256) { const int b = i * 8 + (c & 7), s_ = c >> 3; rt = (b >> 1) * 8 + (s_ >> 2); pnv = (b & 1) * 4 + (s_ & 3); L = rt * 8 + pnv; }
        else { L = i * G + c; rt = L >> 3; }
        if (rt >= nrt) return false;
        const int e = __builtin_amdgcn_readfirstlane((int)((const LAS unsigned char*)ts + (RE_OFF - TS_OFF))[rt]);
        u.pm = rt; u.pn = L & 7; u.e = e; u.ti = rt - __builtin_amdgcn_readfirstlane(ts[e]); return true;
    }
    __device__ __forceinline__ const char* a_ptr(const Unit& u) const { return GATHER ? A : A + (size_t)u.pm * (256 * K * 2); }
    __device__ __forceinline__ const char* b_ptr(const Unit& u) const { return B + (size_t)u.e * bstride + (size_t)u.pn * (256 * K * 2); }
    __device__ __forceinline__ const int* tok_ptr(const Unit& u) const { return tok + (size_t)u.e * CAP + u.ti * 256; }
    __device__ __forceinline__ int count(const Unit& u) const { return __builtin_amdgcn_readfirstlane(cn[u.e]); }
    __device__ __forceinline__ void gather(const Unit& u, int tid, unsigned (&v)[2][2]) const {
        const int cnt = __builtin_amdgcn_readfirstlane(cn[u.e]);
#pragma unroll
        for (int i = 0; i < 2; ++i) { int R, C; stage_rc(tid * 16 + i * 8192, R, C);
#pragma unroll
            for (int h = 0; h < 2; ++h) { const int rank = u.ti * 256 + h * 128 + R; int t = 0; if (IDENT) t = u.pm * 256 + h * 128 + R; else if (rank < cnt) t = tok[(size_t)u.e * CAP + rank];
                v[h][i] = ((unsigned)t * (unsigned)K + (unsigned)C) * 2u; } }
    }
};

struct EpiBf16 {
    static constexpr bool PERM = true, BSEL = false;
    bf16_t* O; int ldc; float sc;
    __device__ __forceinline__ void operator()(const f32x4 (&acc)[2][2][4][2], const Unit& u, int wr, int wc, int, int) const {
        const int lane_ = lane_id(), fr = lane_ & 15, fq = lane_ >> 4;
        const int row0 = u.pm * BM + wr * 64 + fr, col0 = u.pn * BM + wc * 32 + 8 * fq;
#pragma unroll
        for (int ai = 0; ai < 2; ++ai)
#pragma unroll
            for (int m = 0; m < 4; ++m) { bf16_t* rowp = O + (size_t)(row0 + ai * HALF + m * 16) * ldc + col0;
#pragma unroll
                for (int bj = 0; bj < 2; ++bj) { const f32x4 v0 = acc[ai][bj][m][0] * sc, v1 = acc[ai][bj][m][1] * sc;
                    u32x4 w; w.x = cvt_pk_bf16(v0[0], v0[1]); w.y = cvt_pk_bf16(v0[2], v0[3]); w.z = cvt_pk_bf16(v1[0], v1[1]); w.w = cvt_pk_bf16(v1[2], v1[3]);
                    *(u32x4*)(rowp + bj * HALF) = w; } }
    }
};
struct EpiFp8 {
    static constexpr bool PERM = true, BSEL = false;
    unsigned char* O; int ldc; float sc;
    __device__ __forceinline__ void operator()(const f32x4 (&acc)[2][2][4][2], const Unit& u, int wr, int wc, int, int) const {
        const int lane_ = lane_id(), fr = lane_ & 15, fq = lane_ >> 4;
        const int row0 = u.pm * BM + wr * 64 + fr, col0 = u.pn * BM + wc * 32 + 8 * fq;
#pragma unroll
        for (int ai = 0; ai < 2; ++ai)
#pragma unroll
            for (int m = 0; m < 4; ++m) { unsigned char* rowp = O + (size_t)(row0 + ai * HALF + m * 16) * ldc + col0;
#pragma unroll
                for (int bj = 0; bj < 2; ++bj) { const f32x4 v0 = acc[ai][bj][m][0] * sc, v1 = acc[ai][bj][m][1] * sc;
                    u32x2 w; w.x = pk4_fp8(v0[0], v0[1], v0[2], v0[3]); w.y = pk4_fp8(v1[0], v1[1], v1[2], v1[3]);
                    *(u32x2*)(rowp + bj * HALF) = w; } }
    }
};
struct EpiProj {
    static constexpr bool PERM = true, BSEL = true;
    bf16_t* O; int ldc; const float* rc; const float* rsn;
    __device__ __forceinline__ void operator()(const f32x4 (&acc)[2][2][4][2], const Unit& u, int wr, int wc, int, int) const {
        const int lane_ = lane_id(), fr = lane_ & 15, fq = lane_ >> 4;
        const int row0 = u.pm * BM + wr * 64 + fr;
        if (u.pn >= 8) {
            const int col0 = wc * 32 + 8 * fq;
            const int act = (u.pn >= 12 && u.pn < 16) ? 1 : (u.pn >= 20 ? 2 : 0);
#pragma unroll
            for (int ai = 0; ai < 2; ++ai)
#pragma unroll
                for (int m = 0; m < 4; ++m) { bf16_t* rowp = O + ((size_t)(2 * u.pn) * T + (row0 + ai * HALF + m * 16)) * HD + col0;
#pragma unroll
                    for (int bj = 0; bj < 2; ++bj) { f32x4 v0 = acc[ai][bj][m][0], v1 = acc[ai][bj][m][1];
                        if (act) {
#pragma unroll
                            for (int j = 0; j < 4; ++j) { const float a = v0[j], b = v1[j];
                                const float ya = act == 1 ? a : 1.5957691216057308f * (a + 0.044715f * a * a * a), yb = act == 1 ? b : 1.5957691216057308f * (b + 0.044715f * b * b * b);
                                v0[j] = a * __builtin_amdgcn_rcpf(1.0f + __expf(-ya)); v1[j] = b * __builtin_amdgcn_rcpf(1.0f + __expf(-yb)); } }
                        u32x4 w; w.x = cvt_pk_bf16(v0[0], v0[1]); w.y = cvt_pk_bf16(v0[2], v0[3]); w.z = cvt_pk_bf16(v1[0], v1[1]); w.w = cvt_pk_bf16(v1[2], v1[3]);
                        *(u32x4*)(rowp + (size_t)bj * T * HD) = w; } }
        } else {
            const bool isq = u.pn < 4; const int f0 = 16 * wc + 4 * fq;
            constexpr float L2G[8] = {-4.580368961312479e-2f, -2.272007650008353e-2f, -1.1315313227834146e-2f, -5.646563141142063e-3f, -2.8205190623786626e-3f, -1.4095702546713536e-3f, -7.046129765893727e-4f, -3.522634716290214e-4f};
            float l2g[2];
#pragma unroll
            for (int bj = 0; bj < 2; ++bj) { const int hh = 2 * (u.pn & 3) + bj; float v = L2G[0];
#pragma unroll
                for (int q = 1; q < 8; ++q) v = (hh == q) ? L2G[q] : v;
                l2g[bj] = v; }
            f32x4 csv[2][4], snv[2][4];
#pragma unroll
            for (int ai = 0; ai < 2; ++ai)
#pragma unroll
                for (int m = 0; m < 4; ++m) { const int pos = (row0 + ai * HALF + m * 16) & (SEQ - 1); csv[ai][m] = *(const f32x4*)(rc + pos * 64 + f0); snv[ai][m] = *(const f32x4*)(rsn + pos * 64 + f0); }
#pragma unroll
            for (int ai = 0; ai < 2; ++ai)
#pragma unroll
                for (int m = 0; m < 4; ++m) { const int row = row0 + ai * HALF + m * 16, pos = row & (SEQ - 1), il = pos & 127;
                    const f32x4 cs = csv[ai][m], sn = snv[ai][m];
                    bf16_t* rowp = O + ((size_t)(2 * u.pn) * T + row) * HD + f0;
#pragma unroll
                    for (int bj = 0; bj < 2; ++bj) { const float sc = isq ? __builtin_amdgcn_exp2f((float)(il - 127) * l2g[bj]) * 0.08838834764831845f : __builtin_amdgcn_exp2f((float)(127 - il) * l2g[bj]);
                        const f32x4 x1 = acc[ai][bj][m][0], x2 = acc[ai][bj][m][1]; const f32x4 y1 = (x1 * cs - x2 * sn) * sc, y2 = (x1 * sn + x2 * cs) * sc;
                        u32x2 w1, w2; w1.x = cvt_pk_bf16(y1[0], y1[1]); w1.y = cvt_pk_bf16(y1[2], y1[3]); w2.x = cvt_pk_bf16(y2[0], y2[1]); w2.y = cvt_pk_bf16(y2[2], y2[3]);
                        *(u32x2*)(rowp + (size_t)bj * T * HD) = w1; *(u32x2*)(rowp + (size_t)bj * T * HD + 64) = w2; } }
        }
    }
};
struct EpiF32Res {
    static constexpr bool PERM = false, BSEL = false;
    const float* base; float* C; int ldc;
    __device__ __forceinline__ void operator()(const f32x4 (&acc)[2][2][4][2], const Unit& u, int wr, int wc, int, int) const {
        const int lane_ = lane_id(), fr = lane_ & 15, fq = lane_ >> 4;
        const int row0 = u.pm * BM + wr * 64 + fr, col0 = u.pn * BM + wc * 32 + 4 * fq;
#pragma unroll
        for (int ai = 0; ai < 2; ++ai)
#pragma unroll
            for (int m = 0; m < 4; ++m) { const size_t off = (size_t)(row0 + ai * HALF + m * 16) * ldc + col0;
#pragma unroll
                for (int bj = 0; bj < 2; ++bj)
#pragma unroll
                    for (int n = 0; n < 2; ++n) { const f32x4 b = *(const f32x4*)(base + off + bj * HALF + n * 16); *(f32x4*)(C + off + bj * HALF + n * 16) = acc[ai][bj][m][n] + b; }
                if (m == 3) asm volatile("" ::: "memory"); }
    }
};
struct EpiSwiGLU {
    static constexpr bool PERM = true, BSEL = false;
    unsigned char* O; const float* rss; const LAS int* cn;
    __device__ __forceinline__ void operator()(const f32x4 (&acc)[2][2][4][2], const Unit& u, int wr, int wc, int, int) const {
        const int lane_ = lane_id(), fr = lane_ & 15, fq = lane_ >> 4;
        const int cnt = __builtin_amdgcn_readfirstlane(cn[u.e]);
        const int col0 = u.pn * HALF + wc * 32 + 8 * fq;
        float rsv[2][4];
#pragma unroll
        for (int ai = 0; ai < 2; ++ai)
#pragma unroll
            for (int m = 0; m < 4; ++m) { const int rank = u.ti * 256 + ai * HALF + wr * 64 + m * 16 + fr; const float v = rss[(size_t)u.e * CAP + (rank < cnt ? rank : 0)]; rsv[ai][m] = rank < cnt ? v * (1.0f / SC_WGU) : 0.f; }
#pragma unroll
        for (int ai = 0; ai < 2; ++ai)
#pragma unroll
            for (int m = 0; m < 4; ++m) { const int r = ai * HALF + wr * 64 + m * 16 + fr;
                const float rs = rsv[ai][m];
                float o[8];
#pragma unroll
                for (int n = 0; n < 2; ++n)
#pragma unroll
                    for (int j = 0; j < 4; ++j) { const float g = acc[ai][0][m][n][j] * rs, uu = acc[ai][1][m][n][j] * rs; o[n * 4 + j] = SC_HB * g * uu * __builtin_amdgcn_rcpf(1.0f + __expf(-g)); }
                u32x2 w; w.x = pk4_fp8(o[0], o[1], o[2], o[3]); w.y = pk4_fp8(o[4], o[5], o[6], o[7]);
                *(u32x2*)(O + (size_t)(u.pm * BM + r) * DE + col0) = w; }
    }
};

template <class Epi, class Sched, int K, bool GATHER, bool ALIGN_EPI, bool SP2, bool FP8 = false>
__device__ __forceinline__ void gemm_phase(LAS unsigned char* lds, const Sched& S, const Epi& E, int wid) {
    const int lane = lane_id(), tid = wid * 64 + lane, wr = wid >> 2, wc = wid & 3, fr = lane & 15, fq = lane >> 4;
    constexpr int nt = K / BK;
    unsigned voffA[2], voffB[2];
#pragma unroll
    for (int i = 0; i < 2; ++i) { int R, C; stage_rc(tid * 16 + i * 8192, R, C); const int Rb = Epi::PERM ? ((R & ~31) + perm32(R & 31)) : R;
        voffA[i] = (unsigned)(R * K + C) * 2u; voffB[i] = (unsigned)(Rb * K + C) * 2u; }
    unsigned voffB2[2]; bool selC = false, selN = false;
    if constexpr (Epi::BSEL) {
#pragma unroll
        for (int i = 0; i < 2; ++i) { int R, C; stage_rc(tid * 16 + i * 8192, R, C); const int Rb = 64 * ((R >> 4) & 1) + 16 * (R >> 5) + (R & 15); voffB2[i] = (unsigned)(Rb * K + C) * 2u; }
    }
    constexpr size_t kstep = (size_t)(BK * 2);
    constexpr size_t hstep = (size_t)HALF * K * 2;
    const unsigned ldsw = (unsigned)wid * 1024u;
    const int aoff = lds_byte(wr * 64 + fr, fq * 8), boff = lds_byte(wc * 32 + fr, fq * 8);
    unsigned vC[2][2];
    LAS int* gtab = (LAS int*)(lds + (GT_OFF));
#define PG8_SA(b, h) (((b) * 2 + (h)) * HTB)
#define PG8_SB(b, h) ((4 + (b) * 2 + (h)) * HTB)
#define PG8_STAGE(bufoff, gbase, voff) do { _Pragma("unroll") for (int _i = 0; _i < 2; ++_i) \
        __builtin_amdgcn_global_load_lds((const unsigned*)((const char*)(gbase) + (voff)[_i]), (LAS unsigned*)(lds + (bufoff) + ldsw + _i * 8192), 16, 0, 0); } while (0)
#define PG8_STAGE_A(bufoff, gp, h, nx) do { if constexpr (GATHER) PG8_STAGE(bufoff, gp, vC[h]); else PG8_STAGE(bufoff, (gp) + (h) * hstep, voffA); } while (0)
#define PG8_SWITCH() do { if constexpr (GATHER) { if (last && has_next) { const int _cnt = S.count(nxt); _Pragma("unroll") for (int _i = 0; _i < 2; ++_i) { int _R, _C; stage_rc(tid * 16 + _i * 8192, _R, _C); \
        _Pragma("unroll") for (int _h = 0; _h < 2; ++_h) { const int _r = _h * 128 + _R; int _t; if constexpr (Sched::ident) _t = nxt.pm * 256 + _r; else { _t = gtab[_r]; _t = (nxt.ti * 256 + _r < _cnt) ? _t : 0; } vC[_h][_i] = ((unsigned)_t * (unsigned)K + (unsigned)_C) * 2u; } } } } } while (0)
#define PG8_STAGE_B(bufoff, gp, nx) do { if constexpr (Epi::BSEL) { const bool _s = (nx) ? selN : selC; if (_s) PG8_STAGE(bufoff, gp, voffB2); else PG8_STAGE(bufoff, gp, voffB); } else PG8_STAGE(bufoff, gp, voffB); } while (0)
#define PG8_LD8(p) __builtin_shufflevector(*(const LAS i32x4*)(p), *(const LAS i32x4*)((p) + 1024), 0, 1, 2, 3, 4, 5, 6, 7)
#define PG8_LDA(dst, b, h) do { _Pragma("unroll") for (int m = 0; m < 4; ++m) { if constexpr (FP8) dst##8[m] = PG8_LD8(lds + PG8_SA(b, h) + aoff + m * 2048); else { _Pragma("unroll") for (int k = 0; k < 2; ++k) dst[m][k] = *(const LAS bf16x8*)(lds + PG8_SA(b, h) + aoff + m * 2048 + k * 1024); } } } while (0)
#define PG8_LDB(dst, b, h) do { _Pragma("unroll") for (int n = 0; n < 2; ++n) { if constexpr (FP8) dst##8[n] = PG8_LD8(lds + PG8_SB(b, h) + boff + n * 2048); else { _Pragma("unroll") for (int k = 0; k < 2; ++k) dst[n][k] = *(const LAS bf16x8*)(lds + PG8_SB(b, h) + boff + n * 2048 + k * 1024); } } } while (0)
#define PG8_MMA(ai, bj, At, Bt) do { __builtin_amdgcn_s_setprio(1); _Pragma("unroll") for (int m = 0; m < 4; ++m) _Pragma("unroll") for (int n = 0; n < 2; ++n) { \
        if constexpr (FP8) acc[ai][bj][m][n] = __builtin_amdgcn_mfma_scale_f32_16x16x128_f8f6f4(Bt##8[n], At##8[m], acc[ai][bj][m][n], 0, 0, 0, 0x7f7f7f7f, 0, 0x7f7f7f7f); \
        else { _Pragma("unroll") for (int k = 0; k < 2; ++k) acc[ai][bj][m][n] = __builtin_amdgcn_mfma_f32_16x16x32_bf16(Bt[n][k], At[m][k], acc[ai][bj][m][n], 0, 0, 0); } } \
        __builtin_amdgcn_s_setprio(0); } while (0)
#define PG8_WAIT_V(n) asm volatile("s_waitcnt vmcnt(" #n ")" ::: "memory")
#define PG8_WAIT_L(n) asm volatile("s_waitcnt lgkmcnt(" #n ")" ::: "memory")
#define PG8_BAR __builtin_amdgcn_s_barrier()
#define PG8_SCHED __builtin_amdgcn_sched_barrier(0)
    Unit cur, nxt; int ui = 0;
    if (!S.next(0, cur)) return;
    f32x4 acc[2][2][4][2];
#pragma unroll
    for (int a = 0; a < 2; ++a)
#pragma unroll
        for (int b = 0; b < 2; ++b)
#pragma unroll
            for (int m = 0; m < 4; ++m)
#pragma unroll
                for (int n = 0; n < 2; ++n) acc[a][b][m][n] = (f32x4){0.f, 0.f, 0.f, 0.f};
    bf16x8 At[4][2], B0[2][2], B1[2][2]; i32x8 At8[4], B08[2], B18[2];
    const char* cA = S.a_ptr(cur); const char* cB = S.b_ptr(cur);
    if constexpr (GATHER) { S.gather(cur, tid, vC); }
    if constexpr (Epi::BSEL) selC = S.bsel(cur);
    if constexpr (SP2) {
        PG8_STAGE_B(PG8_SB(0, 0), cB, false); PG8_STAGE_B(PG8_SB(0, 1), cB + hstep, false); PG8_STAGE_A(PG8_SA(0, 0), cA, 0, false); PG8_STAGE_A(PG8_SA(0, 1), cA, 1, false);
        if (wr == 1) PG8_BAR;
        PG8_WAIT_V(2); PG8_BAR;
        PG8_STAGE_B(PG8_SB(1, 0), cB + kstep, false); PG8_STAGE_A(PG8_SA(1, 0), cA + kstep, 0, false); PG8_STAGE_B(PG8_SB(1, 1), cB + hstep + kstep, false);
        PG8_WAIT_V(6); PG8_BAR;
    } else {
        PG8_STAGE_B(PG8_SB(0, 0), cB, false); PG8_STAGE_A(PG8_SA(0, 0), cA, 0, false); PG8_STAGE_B(PG8_SB(0, 1), cB + hstep, false); PG8_STAGE_A(PG8_SA(0, 1), cA, 1, false);
        if (wr == 1) PG8_BAR;
        PG8_WAIT_V(4); PG8_BAR;
        PG8_STAGE_B(PG8_SB(1, 0), cB + kstep, false); PG8_STAGE_A(PG8_SA(1, 0), cA + kstep, 0, false); PG8_STAGE_B(PG8_SB(1, 1), cB + hstep + kstep, false);
        PG8_WAIT_V(6); PG8_BAR;
    }
    for (;;) {
        const bool has_next = S.next(ui + 1, nxt);
        const char* nA = has_next ? S.a_ptr(nxt) : cA; const char* nB = has_next ? S.b_ptr(nxt) : cB;
        if constexpr (Epi::BSEL) selN = has_next ? S.bsel(nxt) : selC;
        if constexpr (GATHER && !Sched::ident) { if (has_next && wid < 4) __builtin_amdgcn_global_load_lds((const unsigned*)(S.tok_ptr(nxt) + wid * 64 + lane), (LAS unsigned*)(gtab + wid * 64), 4, 0, 0); }
#pragma unroll 1
        for (int t = 0; t < nt; t += 2) {
            const bool last = (t == nt - 2);
            const char* a1 = cA + (size_t)(t + 1) * kstep;
            const char* a2 = last ? nA : cA + (size_t)(t + 2) * kstep; const char* b2 = last ? nB : cB + (size_t)(t + 2) * kstep;
            const char* a3 = a2 + kstep; const char* b3 = b2 + kstep;
            if constexpr (SP2) {
            PG8_LDB(B0, 0, 0); PG8_LDB(B1, 0, 1); PG8_SCHED; PG8_LDA(At, 0, 0); PG8_STAGE_A(PG8_SA(1, 1), a1, 1, false); PG8_SWITCH();
            PG8_WAIT_V(8); PG8_WAIT_L(0); PG8_BAR; PG8_MMA(0, 0, At, B0); PG8_MMA(0, 1, At, B1); PG8_BAR; PG8_SCHED;
            PG8_LDA(At, 0, 1); PG8_STAGE_B(PG8_SB(0, 0), b2, last); PG8_STAGE_B(PG8_SB(0, 1), b2 + hstep, last); PG8_STAGE_A(PG8_SA(0, 0), a2, 0, last);
            PG8_WAIT_V(8); PG8_WAIT_L(0); PG8_BAR; PG8_MMA(1, 0, At, B0); PG8_MMA(1, 1, At, B1); PG8_BAR; PG8_SCHED;
            PG8_LDB(B0, 1, 0); PG8_LDB(B1, 1, 1); PG8_SCHED; PG8_LDA(At, 1, 0); PG8_STAGE_A(PG8_SA(0, 1), a2, 1, last);
            PG8_WAIT_V(8); PG8_WAIT_L(0); PG8_BAR; PG8_MMA(0, 0, At, B0); PG8_MMA(0, 1, At, B1); PG8_BAR; PG8_SCHED;
            PG8_LDA(At, 1, 1); PG8_STAGE_B(PG8_SB(1, 0), b3, last); PG8_STAGE_B(PG8_SB(1, 1), b3 + hstep, last); PG8_STAGE_A(PG8_SA(1, 0), a3, 0, last);
            PG8_WAIT_V(8); PG8_WAIT_L(0); PG8_BAR; PG8_MMA(1, 0, At, B0); PG8_MMA(1, 1, At, B1); PG8_BAR; PG8_SCHED;
            } else {
            PG8_LDB(B0, 0, 0); PG8_SCHED; PG8_LDA(At, 0, 0); PG8_STAGE_A(PG8_SA(1, 1), a1, 1, false); PG8_SWITCH();
            PG8_WAIT_L(8); PG8_BAR; PG8_WAIT_L(0); PG8_MMA(0, 0, At, B0); PG8_BAR; PG8_SCHED;
            PG8_LDB(B1, 0, 1); PG8_STAGE_B(PG8_SB(0, 0), b2, last);
            PG8_BAR; PG8_WAIT_L(0); PG8_MMA(0, 1, At, B1); PG8_BAR;
            PG8_LDA(At, 0, 1); PG8_STAGE_A(PG8_SA(0, 0), a2, 0, last);
            PG8_BAR; PG8_WAIT_L(0); PG8_MMA(1, 0, At, B0); PG8_BAR; PG8_SCHED;
            PG8_STAGE_B(PG8_SB(0, 1), b2 + hstep, last);
            PG8_WAIT_V(6); PG8_BAR; PG8_MMA(1, 1, At, B1); PG8_BAR;
            PG8_LDB(B0, 1, 0); PG8_SCHED; PG8_LDA(At, 1, 0); PG8_STAGE_A(PG8_SA(0, 1), a2, 1, last);
            PG8_WAIT_L(8); PG8_BAR; PG8_WAIT_L(0); PG8_MMA(0, 0, At, B0); PG8_BAR; PG8_SCHED;
            PG8_LDB(B1, 1, 1); PG8_STAGE_B(PG8_SB(1, 0), b3, last);
            PG8_BAR; PG8_WAIT_L(0); PG8_MMA(0, 1, At, B1); PG8_BAR;
            PG8_LDA(At, 1, 1); PG8_STAGE_A(PG8_SA(1, 0), a3, 0, last);
            PG8_BAR; PG8_WAIT_L(0); PG8_MMA(1, 0, At, B0); PG8_BAR; PG8_SCHED;
            PG8_STAGE_B(PG8_SB(1, 1), b3 + hstep, last);
            PG8_WAIT_V(6); PG8_BAR; PG8_MMA(1, 1, At, B1); PG8_BAR;
            }
        }
        if constexpr (ALIGN_EPI) { if (wr == 0) PG8_BAR; }
        E(acc, cur, wr, wc, fr, fq);
        if (!has_next) break;
#pragma unroll
        for (int a = 0; a < 2; ++a)
#pragma unroll
            for (int b = 0; b < 2; ++b)
#pragma unroll
                for (int m = 0; m < 4; ++m)
#pragma unroll
                    for (int n = 0; n < 2; ++n) acc[a][b][m][n] = (f32x4){0.f, 0.f, 0.f, 0.f};
        cur = nxt; cA = nA; cB = nB; ++ui; selC = selN;
        if constexpr (ALIGN_EPI) { if (wr == 1) PG8_BAR; }
    }
    PG8_WAIT_V(0);
    if constexpr (!ALIGN_EPI) { if (wr == 0) PG8_BAR; }
    PG8_BAR;
#undef PG8_SA
#undef PG8_SB
#undef PG8_STAGE
#undef PG8_STAGE_A
#undef PG8_SWITCH
#undef PG8_STAGE_B
#undef PG8_LDA
#undef PG8_LDB
#undef PG8_MMA
#undef PG8_LD8
#undef PG8_WAIT_V
#undef PG8_WAIT_L
#undef PG8_BAR
#undef PG8_SCHED
}
}

#ifndef PG8_SP2
#define PG8_SP2 true
#endif
#ifndef PG8_ALIGN
#define PG8_ALIGN true
#endif

#define XB_TMO      128
#define XB_XCNT(j)  (256  + 64 * (j))
#define XB_XSUB(j)  (1280 + 64 * (j))
#define XB_XGEN(j)  (2304 + 64 * (j))
#define XB_TOP      3328
#define XB_TOPGEN   3392
#define XCD_BAR_WORDS 3456
#define XB_SPIN_CAP (1u << 18)
__device__ __forceinline__ unsigned xb_ld(unsigned* p)              { return __hip_atomic_load(p, __ATOMIC_RELAXED, __HIP_MEMORY_SCOPE_AGENT); }
__device__ __forceinline__ unsigned xb_add(unsigned* p, unsigned v) { return __hip_atomic_fetch_add(p, v, __ATOMIC_RELAXED, __HIP_MEMORY_SCOPE_AGENT); }
__device__ __forceinline__ unsigned xb_xcc_id() { return (unsigned)__builtin_amdgcn_s_getreg((3 << 11) | 20) & 0xFu; }
#define XB_SPIN(cond, bar) do { unsigned _sp = 0; while (cond) { __builtin_amdgcn_s_sleep(1); \
    if ((++_sp & 255u) == 0u) { if (xb_ld(&(bar)[XB_TMO])) break; if (_sp > XB_SPIN_CAP) { atomicAdd(&(bar)[XB_TMO], 1u); break; } } } } while (0)
struct XcdBarrier { unsigned* bar; unsigned x; volatile LAS unsigned* st; };
__device__ __forceinline__ XcdBarrier xcd_barrier_post(unsigned* bar, volatile LAS unsigned* st) {
    XcdBarrier b; b.bar = bar; b.x = xb_xcc_id(); b.st = st;
    if (threadIdx.x == 0) (void)xb_add(&bar[XB_XCNT(b.x)], 1u);
    return b;
}
__device__ __forceinline__ void xcd_barrier_complete(unsigned* bar, unsigned x, unsigned& nloc, unsigned& nx) {
    const unsigned G = gridDim.x * gridDim.y * gridDim.z;
    unsigned sum, cnt, mine, sp = 0u;
    for (;;) {
        sum = 0u; cnt = 0u; mine = 0u;
#pragma unroll
        for (unsigned j = 0; j < 16; ++j) { const unsigned c = xb_ld(&bar[XB_XCNT(j)]); sum += c; cnt += (c > 0u) ? 1u : 0u; mine = (j == x) ? c : mine; }
        if (sum == G) break;
        __builtin_amdgcn_s_sleep(1);
        if ((++sp & 255u) == 0u) { if (xb_ld(&bar[XB_TMO])) break; if (sp > XB_SPIN_CAP) { atomicAdd(&bar[XB_TMO], 1u); break; } }
    }
    nloc = mine > 0u ? mine : 1u; nx = cnt > 0u ? cnt : 1u;
}
__device__ __forceinline__ void xcd_barrier(const XcdBarrier& b) {
    asm volatile("s_waitcnt vmcnt(0)" ::: "memory");
    __syncthreads();
    if (threadIdx.x == 0) {
        unsigned* bar = b.bar;
        __builtin_amdgcn_s_waitcnt(0);
        unsigned nloc = b.st[0], nx = b.st[1];
        if (nloc == 0u) { xcd_barrier_complete(bar, b.x, nloc, nx); b.st[0] = nloc; b.st[1] = nx; }
        const unsigned old = xb_add(&bar[XB_XSUB(b.x)], 1u);
        const unsigned gen = old / nloc;
        if (old + 1u == (gen + 1u) * nloc) {
            __builtin_amdgcn_fence(__ATOMIC_RELEASE, "agent");
            asm volatile("s_waitcnt vmcnt(0)" ::: "memory");
            const unsigned og = xb_add(&bar[XB_TOP], 1u);
            const unsigned tg = og / nx;
            if (og + 1u == (tg + 1u) * nx) xb_add(&bar[XB_TOPGEN], 1u);
            else XB_SPIN(xb_ld(&bar[XB_TOPGEN]) == tg, bar);
            __builtin_amdgcn_fence(__ATOMIC_ACQUIRE, "agent");
            xb_add(&bar[XB_XGEN(b.x)], 1u);
            asm volatile("s_waitcnt vmcnt(0)" ::: "memory");
        } else {
            XB_SPIN(xb_ld(&bar[XB_XGEN(b.x)]) == gen, bar);
            __builtin_amdgcn_fence(__ATOMIC_ACQUIRE, "agent");
            asm volatile("s_waitcnt vmcnt(0)" ::: "memory");
        }
    }
    __syncthreads();
}

struct Frame {
    LAS unsigned char* lds;
    volatile LAS unsigned* MISC;
    unsigned* ctl;
    int wave, vcu, G;
    const float *x, *norm_mix_g, *w_in, *ret_norm_g, *conv_w, *conv_b, *w_rg, *b_rg, *w_ig, *b_ig, *lam, *lru_norm_g, *w_out, *norm_ffn_g,
                *w_group, *b_group, *w_router, *b_router, *w_gate, *w_up, *w_down, *norm_final_g;
    float* out;
    unsigned char* ws;
};

__device__ __forceinline__ unsigned offb(unsigned row, unsigned ch);
__device__ __forceinline__ bf16x8 tr_frag(LAS unsigned char* img, int lane, int c, int ks);
__device__ __forceinline__ bf16x8 tr_rows(LAS unsigned char* img, int lane, int c, int row0) {
    const unsigned q = (lane & 15) >> 2, p = lane & 3;
    const s16x4 a = __builtin_amdgcn_ds_read_tr16_b64_v4i16((LAS s16x4*)(img + offb(row0 + q, 2 * c + (p >> 1)) + 8 * (p & 1)));
    const s16x4 b = __builtin_amdgcn_ds_read_tr16_b64_v4i16((LAS s16x4*)(img + offb(row0 + 4 + q, 2 * c + (p >> 1)) + 8 * (p & 1)));
    bf16x8 r; r[0] = a[0]; r[1] = a[1]; r[2] = a[2]; r[3] = a[3]; r[4] = b[0]; r[5] = b[1]; r[6] = b[2]; r[7] = b[3]; return r;
}
template <bool F8, bool GK>
__device__ __forceinline__ void p0_transpose_item(const float* W, int N, int k0, int n0, void* WTrow0, int KoutB, const LAS float* gk, float scale, LAS unsigned char* img, int lane) {
    const int l31 = lane & 31, lh = lane >> 5, l15 = lane & 15, g = lane >> 4;
    const float* src = W + (size_t)(k0 + lh) * N + n0 + 4 * l31;
#define P0_OUT(pass) do { LDS_WAIT(); asm volatile("" ::: "memory"); const int kk0 = k0 + 64 * (pass); \
        if constexpr (F8) { _Pragma("unroll") for (int c = 0; c < 8; ++c) { const u32x4 q0 = __builtin_bit_cast(u32x4, tr_rows(img, lane, c, 16 * g)), q1 = __builtin_bit_cast(u32x4, tr_rows(img, lane, c, 16 * g + 8)); \
            u32x4 o; o.x = pk4_fp8(bflo(q0.x), bfhi(q0.x), bflo(q0.y), bfhi(q0.y)); o.y = pk4_fp8(bflo(q0.z), bfhi(q0.z), bflo(q0.w), bfhi(q0.w)); \
            o.z = pk4_fp8(bflo(q1.x), bfhi(q1.x), bflo(q1.y), bfhi(q1.y)); o.w = pk4_fp8(bflo(q1.z), bfhi(q1.z), bflo(q1.w), bfhi(q1.w)); \
            *(u32x4*)((unsigned char*)WTrow0 + (size_t)(16 * c + l15) * KoutB + kk0 + 16 * g) = o; } } \
        else { _Pragma("unroll") for (int c = 0; c < 8; ++c) _Pragma("unroll") for (int ks = 0; ks < 2; ++ks) { const bf16x8 f = tr_frag(img, lane, c, ks); \
            *(bf16x8*)((unsigned char*)WTrow0 + (size_t)(16 * c + l15) * KoutB + 2 * (kk0 + 32 * ks + 8 * g)) = f; } } \
        LDS_WAIT(); asm volatile("" ::: "memory"); } while (0)
#pragma unroll 1
    for (int pass = 0; pass < 2; ++pass) {
#pragma unroll
        for (int half = 0; half < 2; ++half) {
            const int st = 2 * pass + half;
            f32x4 v[16]; float gs[16];
#pragma unroll
            for (int i = 0; i < 16; ++i) v[i] = __builtin_nontemporal_load((const f32x4*)(src + (size_t)(32 * st + 2 * i) * N));
#pragma unroll
            for (int i = 0; i < 16; ++i) gs[i] = GK ? gk[k0 + 32 * st + 2 * i + lh] : scale;
#pragma unroll
            for (int i = 0; i < 16; ++i) { const int kl = 32 * half + 2 * i + lh; const f32x4 x = v[i] * gs[i];
                u32x2 w; w.x = pk2(x.x, x.y); w.y = pk2(x.z, x.w); *(LAS u32x2*)(img + offb(kl, l31 >> 1) + 8 * (l31 & 1)) = w; }
        }
        P0_OUT(pass);
    }
#undef P0_OUT
}
constexpr int I_G = (D / 128) * (DE / 128), I_DN = (DE / 128) * (D / 128), NQ_ITEMS = NE * (2 * I_G + I_DN);
__device__ __forceinline__ void convert_queue(Frame& F) {
    LAS unsigned char* scr = F.lds + F.wave * 16384;
    const int lane = lane_id();
    unsigned char* Wd8 = F.ws + WS_WD; unsigned char* Wgu8 = F.ws + WS_WGU;
    LAS float* GKT = (LAS float*)(F.lds + 131072);
    for (int i = F.wave * 64 + lane; i < D; i += NTHREADS) GKT[i] = F.norm_ffn_g[i] * SC_WGU;
    __syncthreads();
    for (;;) {
        unsigned it = 0; if (lane == 0) it = atomicAdd(F.ctl + CW_Q, 1u);
        int r = __builtin_amdgcn_readfirstlane((int)it); if (r >= NQ_ITEMS) break;
        const int e = r / (2 * I_G + I_DN); r -= e * (2 * I_G + I_DN);
        if (r < 2 * I_G) { const int up = r >= I_G; if (up) r -= I_G; const int nblk = DE / 128, kb = r / nblk, nb = r % nblk;
            const float* W = (up ? F.w_up : F.w_gate) + (size_t)e * D * DE;
            unsigned char* row0 = Wgu8 + (size_t)e * D * D + (size_t)(256 * nb + 128 * up) * D;
            p0_transpose_item<true, true>(W, DE, 128 * kb, 128 * nb, row0, D, GKT, SC_WGU, scr, lane); continue; }
        r -= 2 * I_G;
        { const int nblk = D / 128, kb = r / nblk, nb = r % nblk; p0_transpose_item<true, false>(F.w_down + (size_t)e * DE * D, D, 128 * kb, 128 * nb, Wd8 + (size_t)e * D * DE + (size_t)(128 * nb) * DE, DE, nullptr, SC_WD, scr, lane); }
    }
}
__device__ __forceinline__ void p0_prologue(Frame& F) {
    LAS unsigned char* scr = F.lds + F.wave * 16384;
    const int lane = lane_id(), tid = F.wave * 64 + lane;
    const int gw = F.wave * F.G + F.vcu, NGW = F.G * NWAVES;
    bf16_t* Win_t = (bf16_t*)(F.ws + WS_WIN); bf16_t* Wout_t = (bf16_t*)(F.ws + WS_WOUT);
    constexpr int I_IN = (D / 128) * (PROJ / 128), I_OUT = (D / 128) * (D / 128);
    constexpr int NITEMS = I_IN + I_OUT;
    for (int it = gw; it < NITEMS; it += NGW) {
        int r = it;
        if (r < I_IN) { const int nblk = PROJ / 128, kb = r / nblk, nb = r % nblk; p0_transpose_item<false, false>(F.w_in, PROJ, 128 * kb, 128 * nb, Win_t + (size_t)(128 * nb) * D, D * 2, nullptr, 1.0f, scr, lane); continue; } r -= I_IN;
        { const int nblk = D / 128, kb = r / nblk, nb = r % nblk; p0_transpose_item<false, false>(F.w_out, D, 128 * kb, 128 * nb, Wout_t + (size_t)(128 * nb) * D, D * 2, nullptr, 1.0f, scr, lane); }
    }
    bf16_t* Hb = (bf16_t*)(F.ws + WS_R1);
    for (int m = gw; m < T; m += 2 * NGW) {
        const int m2 = m + NGW < T ? m + NGW : m;
        const f32x4* xr = (const f32x4*)(F.x + (size_t)m * D) + lane; const f32x4* xr2 = (const f32x4*)(F.x + (size_t)m2 * D) + lane; const f32x4* gr = (const f32x4*)F.norm_mix_g + lane;
        f32x4 v[8], v2[8]; float s = 0.f, s2 = 0.f;
#pragma unroll
        for (int j = 0; j < 8; ++j) { v[j] = __builtin_nontemporal_load(xr + 64 * j); v2[j] = __builtin_nontemporal_load(xr2 + 64 * j); }
#pragma unroll
        for (int j = 0; j < 8; ++j) { s += (v[j].x * v[j].x + v[j].y * v[j].y) + (v[j].z * v[j].z + v[j].w * v[j].w); s2 += (v2[j].x * v2[j].x + v2[j].y * v2[j].y) + (v2[j].z * v2[j].z + v2[j].w * v2[j].w); }
        const float rs = 1.0f / sqrtf(wave_sum(s) * (1.0f / D) + EPS), rs2 = 1.0f / sqrtf(wave_sum(s2) * (1.0f / D) + EPS);
        u32x2* o = (u32x2*)(Hb + (size_t)m * D) + lane; u32x2* o2 = (u32x2*)(Hb + (size_t)m2 * D) + lane;
#pragma unroll
        for (int j = 0; j < 8; ++j) { const f32x4 g = gr[64 * j]; u32x2 w; w.x = pk2(v[j].x * rs * g.x, v[j].y * rs * g.y); w.y = pk2(v[j].z * rs * g.z, v[j].w * rs * g.w); o[64 * j] = w;
            u32x2 w2; w2.x = pk2(v2[j].x * rs2 * g.x, v2[j].y * rs2 * g.y); w2.y = pk2(v2[j].z * rs2 * g.z, v2[j].w * rs2 * g.w); o2[64 * j] = w2; }
    }
    const int gt = F.vcu * NTHREADS + tid, NGT = F.G * NTHREADS;
    float* rc = (float*)(F.ws + WS_ROPE); float* rsn = rc + SEQ * 64;
    for (int i = gt; i < SEQ * 64; i += NGT) { const int pos = i >> 6, f = i & 63; const float inv = powf(10000.0f, -(float)f / 64.0f); const float ang = (float)pos * inv; float sv, cv; sincosf(ang, &sv, &cv); rc[i] = cv; rsn[i] = sv; }
    bf16_t* whi = (bf16_t*)(F.ws + WS_WGT); bf16_t* wlo = whi + 48 * D;
    for (int i = gt; i < 48 * D; i += NGT) { const int n = i / D, k = i % D; float v = 0.f;
        if (n < 4) v = F.w_group[k * 4 + n]; else if (n < 36) v = F.w_router[k * 32 + (n - 4)];
        v *= F.norm_ffn_g[k]; const unsigned h = f2bf(v); const float hf = __builtin_bit_cast(float, h << 16); whi[i] = (bf16_t)h; wlo[i] = (bf16_t)f2bf(v - hf); }
}

__device__ __forceinline__ unsigned offb(unsigned row, unsigned ch) { return 256u * row + 16u * (ch ^ (((row & 3u) << 2) | ((row >> 2) & 3u))); }
__device__ __forceinline__ bf16x8 row_frag(LAS unsigned char* img, int lane, int rb, int s) { return *(const LAS bf16x8*)(img + offb((lane & 15) + 16 * rb, 4 * s + (lane >> 4))); }
__device__ __forceinline__ bf16x8 tr_frag(LAS unsigned char* img, int lane, int c, int ks) {
    const unsigned g = lane >> 4, q = (lane & 15) >> 2, p = lane & 3;
    const s16x4 a = __builtin_amdgcn_ds_read_tr16_b64_v4i16((LAS s16x4*)(img + offb(32 * ks + 8 * g + q, 2 * c + (p >> 1)) + 8 * (p & 1)));
    const s16x4 b = __builtin_amdgcn_ds_read_tr16_b64_v4i16((LAS s16x4*)(img + offb(32 * ks + 8 * g + 4 + q, 2 * c + (p >> 1)) + 8 * (p & 1)));
    bf16x8 r; r[0] = a[0]; r[1] = a[1]; r[2] = a[2]; r[3] = a[3]; r[4] = b[0]; r[5] = b[1]; r[6] = b[2]; r[7] = b[3]; return r;
}
#define MFMA16(a, b, c) __builtin_amdgcn_mfma_f32_16x16x32_bf16(a, b, c, 0, 0, 0)
__device__ __forceinline__ bf16x8 tr_frag2(LAS unsigned char* img, int lane, int c, int ks) {
    const unsigned g = lane >> 4, q = (lane & 15) >> 2, p = lane & 3;
    const s16x4 a = __builtin_amdgcn_ds_read_tr16_b64_v4i16((LAS s16x4*)(img + offb(32 * ks + 4 * g + q, 2 * c + (p >> 1)) + 8 * (p & 1)));
    const s16x4 b = __builtin_amdgcn_ds_read_tr16_b64_v4i16((LAS s16x4*)(img + offb(32 * ks + 16 + 4 * g + q, 2 * c + (p >> 1)) + 8 * (p & 1)));
    bf16x8 r; r[0] = a[0]; r[1] = a[1]; r[2] = a[2]; r[3] = a[3]; r[4] = b[0]; r[5] = b[1]; r[6] = b[2]; r[7] = b[3]; return r;
}
__device__ __forceinline__ void glds16_asm(const void* gsrc, unsigned lds_dst) { unsigned keep;
    asm volatile("s_mov_b32 %0, m0\n\ts_mov_b32 m0, %2\n\ts_nop 0\n\tglobal_load_lds_dwordx4 %1, off\n\ts_mov_b32 m0, %0" : "=&s"(keep) : "v"(gsrc), "s"(lds_dst) : "memory"); }
#define GLDS16(gsrc, ldst) glds16_asm((const void*)(gsrc), (unsigned)(unsigned long)(LAS unsigned char*)(ldst))
#define RAW_BAR() do { asm volatile("s_waitcnt lgkmcnt(0)" ::: "memory"); __builtin_amdgcn_s_barrier(); asm volatile("" ::: "memory"); } while (0)
__device__ __forceinline__ void retention_unit(Frame& F, int b, int h) {
    LAS unsigned char* KI = F.lds; LAS unsigned char* VI0 = F.lds + 32768; LAS unsigned char* SI = F.lds + 98304;
    const int lane = lane_id(), w = F.wave, l15 = lane & 15, lg = lane >> 4;
    const int rtw = (w < 4) ? w : 11 - w;
    const float gC = expf(128.0f * log1pf(-exp2f(-5.0f - (float)h)));
    LAS float* GN = (LAS float*)(F.lds + 131072);
    if (w < 2) GN[w * 64 + lane] = F.ret_norm_g[h * HD + w * 64 + lane];
    const bf16_t* proj = (const bf16_t*)(F.ws + WS_R2);
    bf16_t* mix = (bf16_t*)(F.ws + WS_R1);
    f32x4 accS[8];
#pragma unroll
    for (int c = 0; c < 8; ++c) accS[c] = (f32x4){0.f, 0.f, 0.f, 0.f};
    const int il = 16 * rtw + l15;
    unsigned dsrc[4];
#pragma unroll
    for (int i = 0; i < 4; ++i) { const unsigned row = 16 * w + 4 * i + lg; dsrc[i] = row * (HD * 2) + 16u * ((unsigned)l15 ^ (((row & 3u) << 2) | ((row >> 2) & 3u))); }
    const char* kbase = (const char*)(proj + ((size_t)(8 + h) * T + b * SEQ) * HD);
    const size_t vofs = (size_t)8 * T * HD * 2;
    const bf16_t* qbase = proj + ((size_t)h * T + b * SEQ + il) * HD + 8 * lg;
#define RET_DMA(img, base) do { _Pragma("unroll") for (int _i = 0; _i < 4; ++_i) GLDS16((base) + dsrc[_i], (img) + 4096 * w + 1024 * _i); } while (0)
    RET_DMA(KI, kbase); RET_DMA(VI0, kbase + vofs);
    u32x4 qn[4]; u32x2 ov[8];
#pragma unroll
    for (int s = 0; s < 4; ++s) qn[s] = *(const u32x4*)(qbase + 32 * s);
#pragma unroll
    for (int c = 0; c < 8; ++c) *(LAS u32x2*)(SI + offb(16 * c + l15, 2 * w + (lane >> 5)) + 8 * (lg & 1)) = (u32x2){0u, 0u};
#pragma unroll 1
    for (int n = 0; n < NCHUNK; ++n) {
        const int tok0 = b * SEQ + n * CHK;
        LAS unsigned char* VI = VI0 + (n & 1) * 32768;
        asm volatile("s_waitcnt vmcnt(0)" ::: "memory"); RAW_BAR();
        bf16x8 qf[4];
#pragma unroll
        for (int s = 0; s < 4; ++s) qf[s] = __builtin_bit_cast(bf16x8, qn[s]);
        const char* nk = kbase + (size_t)(n + 1) * (CHK * HD * 2);
        if (n + 1 < NCHUNK) {
            RET_DMA(VI0 + ((n + 1) & 1) * 32768, nk + vofs);
#pragma unroll
            for (int s = 0; s < 4; ++s) qn[s] = *(const u32x4*)(qbase + (size_t)(n + 1) * (CHK * HD) + 32 * s);
        }
        if (n > 0) { bf16_t* prow = mix + (size_t)(tok0 - CHK + il) * D + h * HD + 4 * lg;
#pragma unroll
            for (int c = 0; c < 8; ++c) *(u32x2*)(prow + 16 * c) = ov[c]; }
        u32x2 gv[8];
        { const bf16_t* grow = proj + ((size_t)(24 + h) * T + tok0 + il) * HD + 4 * lg;
#pragma unroll
          for (int c = 0; c < 8; ++c) gv[c] = *(const u32x2*)(grow + 16 * c); }
        bf16x8 pf[4];
#pragma unroll
        for (int s = 0; s < 4; ++s) {
            f32x4 sc[2];
#pragma unroll
            for (int t = 0; t < 2; ++t) { const int jt = 2 * s + t; sc[t] = (f32x4){0.f, 0.f, 0.f, 0.f};
#pragma unroll
                for (int k = 0; k < 4; ++k) sc[t] = MFMA16(row_frag(KI, lane, jt, k), qf[k], sc[t]);
                const int j0 = 16 * jt + 4 * lg;
#pragma unroll
                for (int r = 0; r < 4; ++r) sc[t][r] = (j0 + r > il) ? 0.f : sc[t][r]; }
            const u32x4 pw = (u32x4){pk2(sc[0][0], sc[0][1]), pk2(sc[0][2], sc[0][3]), pk2(sc[1][0], sc[1][1]), pk2(sc[1][2], sc[1][3])};
            pf[s] = __builtin_bit_cast(bf16x8, pw);
        }
        bf16x8 ktf[4];
#pragma unroll
        for (int s = 0; s < 4; ++s) ktf[s] = tr_frag2(KI, lane, w, s);
        RAW_BAR();
        if (n + 1 < NCHUNK) RET_DMA(KI, nk);
        f32x4 accO[8];
        bf16x8 vfr[2][4], sfr[2][4];
#pragma unroll
        for (int s = 0; s < 4; ++s) { vfr[0][s] = tr_frag2(VI, lane, 0, s); sfr[0][s] = row_frag(SI, lane, 0, s); }
#pragma unroll
        for (int c = 0; c < 8; ++c) {
            if (c < 7) {
#pragma unroll
                for (int s = 0; s < 4; ++s) { vfr[(c + 1) & 1][s] = tr_frag2(VI, lane, c + 1, s); sfr[(c + 1) & 1][s] = row_frag(SI, lane, c + 1, s); } }
            f32x4 o = (f32x4){0.f, 0.f, 0.f, 0.f};
#pragma unroll
            for (int s = 0; s < 4; ++s) o = MFMA16(vfr[c & 1][s], pf[s], o);
#pragma unroll
            for (int s = 0; s < 4; ++s) o = MFMA16(sfr[c & 1][s], qf[s], o);
            accO[c] = o;
#pragma unroll
            for (int s = 0; s < 4; ++s) accS[c] = MFMA16(ktf[s], vfr[c & 1][s], accS[c]);
            __builtin_amdgcn_sched_barrier(0);
        }
        {
            float s1 = 0.f;
#pragma unroll
            for (int c = 0; c < 8; ++c) s1 += (accO[c][0] + accO[c][1]) + (accO[c][2] + accO[c][3]);
            s1 += __shfl_xor(s1, 16); s1 += __shfl_xor(s1, 32);
            const float mu = s1 * (1.0f / 128.0f); float s2 = 0.f;
#pragma unroll
            for (int c = 0; c < 8; ++c) { const f32x4 d = accO[c] - mu; s2 += (d[0] * d[0] + d[1] * d[1]) + (d[2] * d[2] + d[3] * d[3]); }
            s2 += __shfl_xor(s2, 16); s2 += __shfl_xor(s2, 32);
            const float rstd = 1.0f / sqrtf(s2 * (1.0f / 128.0f) + EPS);
#pragma unroll
            for (int c = 0; c < 8; ++c) {
                const f32x4 gain = *(const LAS f32x4*)(GN + 16 * c + 4 * lg);
                const float g[4] = {bflo(gv[c].x), bfhi(gv[c].x), bflo(gv[c].y), bfhi(gv[c].y)}; float o[4];
#pragma unroll
                for (int r = 0; r < 4; ++r) o[r] = (accO[c][r] - mu) * rstd * gain[r] * g[r];
                ov[c].x = pk2(o[0], o[1]); ov[c].y = pk2(o[2], o[3]);
            }
        }
        RAW_BAR();
#pragma unroll
        for (int c = 0; c < 8; ++c) { accS[c] = accS[c] * gC; u32x2 wv; wv.x = pk2(accS[c][0], accS[c][1]); wv.y = pk2(accS[c][2], accS[c][3]);
            *(LAS u32x2*)(SI + offb(16 * c + l15, 2 * w + (lane >> 5)) + 8 * (lg & 1)) = wv; }
    }
    { bf16_t* prow = mix + (size_t)(b * SEQ + (NCHUNK - 1) * CHK + il) * D + h * HD + 4 * lg;
#pragma unroll
      for (int c = 0; c < 8; ++c) *(u32x2*)(prow + 16 * c) = ov[c]; }
    asm volatile("s_waitcnt vmcnt(0)" ::: "memory"); RAW_BAR();
#undef RET_DMA
}
template <int N> __device__ __forceinline__ float dpp_shr(float old, float src) {
    return __builtin_bit_cast(float, __builtin_amdgcn_update_dpp(__builtin_bit_cast(int, old), __builtin_bit_cast(int, src), 0x110 + N, 0xf, 0xf, false));
}
__device__ __forceinline__ float sigmoidf_(float x) { return __builtin_amdgcn_rcpf(1.0f + __expf(-x)); }
__device__ __forceinline__ float gelu_tanh(float z) { const float y2 = 1.5957691216057308f * (z + 0.044715f * z * z * z); return z * __builtin_amdgcn_rcpf(1.0f + __expf(-y2)); }
template <int N> __device__ __forceinline__ float dpp_shr0(float src) {
    return __builtin_bit_cast(float, __builtin_amdgcn_update_dpp(0, __builtin_bit_cast(int, src), 0x110 + N, 0xf, 0xf, true));
}
__device__ __forceinline__ float row_prefix_sum(float v) { v += dpp_shr0<1>(v); v += dpp_shr0<2>(v); v += dpp_shr0<4>(v); v += dpp_shr0<8>(v); return v; }
__device__ __forceinline__ void lru_unit(Frame& F, int b, int nb) {
    constexpr int RAWB = 132 * 256;
    LAS unsigned char* UI0 = F.lds; LAS unsigned char* RAW0 = F.lds + 65536; LAS float* PART = (LAS float*)(F.lds + 65536 + 2 * RAWB); LAS float* CW = PART + 1024;
    static_assert(65536 + 2 * RAWB + 4096 + 2560 <= LDSCTL_OFF, "LRU scratch below the LDS control words");
    const int lane = lane_id(), w = F.wave, tid = w * 64 + lane, l15 = lane & 15, lg = lane >> 4, cb = 128 * nb;
    const bf16_t* proj = (const bf16_t*)(F.ws + WS_R2);
    bf16_t* mix = (bf16_t*)(F.ws + WS_R1);
    const char* zline = (const char*)(F.ws + WS_CTL + 61440);
    const char* ubase = (const char*)(proj + ((size_t)(32 + nb) * T + b * SEQ) * HD);
#define LRU_DMA(n_, buf) do { _Pragma("unroll") for (int _i = 0; _i < 5; ++_i) { if (_i < 4 || w == 0) { const int _r = (_i < 4 ? 16 * w + 4 * _i : 128) + lg; int _pos = 128 * (n_) - 3 + _r; _pos = _pos > SEQ - 1 ? SEQ - 1 : _pos; \
        const char* _src = _pos < 0 ? zline + 16 * l15 : ubase + (size_t)_pos * (HD * 2) + 16 * (l15 ^ (_r & 15)); GLDS16(_src, (buf) + 256 * (_i < 4 ? 16 * w + 4 * _i : 128)); } } } while (0)
    const int sj = tid >> 2, sc0 = tid & 3;
#define LRU_CONV(RAW, UI) do { _Pragma("unroll") for (int q = 0; q < 4; ++q) { const int ch = sc0 + 4 * q; float a8[8]; \
            { const f32x4 b0 = *(const LAS f32x4*)(CW + 512 + 8 * ch), b1 = *(const LAS f32x4*)(CW + 512 + 8 * ch + 4); a8[0] = b0.x; a8[1] = b0.y; a8[2] = b0.z; a8[3] = b0.w; a8[4] = b1.x; a8[5] = b1.y; a8[6] = b1.z; a8[7] = b1.w; } \
            _Pragma("unroll") for (int k = 0; k < 4; ++k) { const int rr = sj + k; const u32x4 uv = *(const LAS u32x4*)((RAW) + 256 * rr + 16 * (ch ^ (rr & 15))); \
                const f32x4 w0 = *(const LAS f32x4*)(CW + k * 128 + 8 * ch), w1 = *(const LAS f32x4*)(CW + k * 128 + 8 * ch + 4); \
                a8[0] += w0.x * bflo(uv.x); a8[1] += w0.y * bfhi(uv.x); a8[2] += w0.z * bflo(uv.y); a8[3] += w0.w * bfhi(uv.y); \
                a8[4] += w1.x * bflo(uv.z); a8[5] += w1.y * bfhi(uv.z); a8[6] += w1.z * bflo(uv.w); a8[7] += w1.w * bfhi(uv.w); } \
            u32x4 o; o.x = pk2(a8[0], a8[1]); o.y = pk2(a8[2], a8[3]); o.z = pk2(a8[4], a8[5]); o.w = pk2(a8[6], a8[7]); \
            *(LAS u32x4*)((UI) + offb(sj, ch)) = o; } } while (0)
    LRU_DMA(0, RAW0);
    for (int i = tid; i < 640; i += NTHREADS) CW[i] = (i < 512) ? F.conv_w[(i >> 7) * 1024 + cb + (i & 127)] : F.conv_b[cb + i - 512];
    bf16x8 wrf[4], wif[4];
#pragma unroll
    for (int s = 0; s < 4; ++s)
#pragma unroll
        for (int jj = 0; jj < 8; ++jj) { const int c = 32 * s + 8 * lg + jj; const size_t o = ((size_t)(nb * 128 + c)) * 128 + 16 * w + l15;
            wrf[s][jj] = (short)f2bf(F.w_rg[o]); wif[s][jj] = (short)f2bf(F.w_ig[o]); }
    const int d0 = cb + 16 * w + 4 * lg;
    const f32x4 brg = *(const f32x4*)(F.b_rg + d0), big = *(const f32x4*)(F.b_ig + d0), lam = *(const f32x4*)(F.lam + d0), ng = *(const f32x4*)(F.lru_norm_g + d0);
    f32x4 spl;
#pragma unroll
    for (int r = 0; r < 4; ++r) spl[r] = -8.0f * log1pf(expf(-lam[r])) * 1.4426950408889634f;
    f32x4 Hc = (f32x4){0.f, 0.f, 0.f, 0.f};
    const bf16_t* zbase = proj + ((size_t)(40 + nb) * T + b * SEQ + l15) * HD + 16 * w + 4 * lg;
    bf16_t* obase = mix + (size_t)(b * SEQ + l15) * D + 1024 + d0;
    asm volatile("s_waitcnt vmcnt(0)" ::: "memory"); RAW_BAR();
    LRU_DMA(1, RAW0 + RAWB);
    LRU_CONV(RAW0, UI0);
    u32x2 zv[8];
#pragma unroll
    for (int tt = 0; tt < 8; ++tt) zv[tt] = *(const u32x2*)(zbase + (size_t)(16 * tt) * HD);
    RAW_BAR();
#pragma unroll 1
    for (int n = 0; n < NCHUNK; ++n) {
        LAS unsigned char* UI = UI0 + (n & 1) * 32768;
        f32x4 hv[8]; float ssq[8];
        f32x4 aR = (f32x4){0.f, 0.f, 0.f, 0.f}, aI = (f32x4){0.f, 0.f, 0.f, 0.f};
#pragma unroll
        for (int s = 0; s < 4; ++s) { const bf16x8 uf = row_frag(UI, lane, 0, s); aR = MFMA16(wrf[s], uf, aR); aI = MFMA16(wif[s], uf, aI); }
#pragma unroll
        for (int tt = 0; tt < 8; ++tt) {
            f32x4 aRn = (f32x4){0.f, 0.f, 0.f, 0.f}, aIn = (f32x4){0.f, 0.f, 0.f, 0.f};
            if (tt < 7) {
#pragma unroll
                for (int s = 0; s < 4; ++s) { const bf16x8 uf = row_frag(UI, lane, tt + 1, s); aRn = MFMA16(wrf[s], uf, aRn); aIn = MFMA16(wif[s], uf, aIn); } }
            const int dl = 16 * w + 4 * lg;
            const u32x2 ucv = *(const LAS u32x2*)(UI + offb(16 * tt + l15, dl >> 3) + (dl & 7) * 2);
            const f32x4 uc = (f32x4){bflo(ucv.x), bfhi(ucv.x), bflo(ucv.y), bfhi(ucv.y)};
            const f32x4 xr = (aR + brg) * -1.4426950408889634f, xi = (aI + big) * -1.4426950408889634f;
            f32x4 er, ei;
#pragma unroll
            for (int r = 0; r < 4; ++r) { er[r] = __builtin_amdgcn_exp2f(xr[r]); ei[r] = __builtin_amdgcn_exp2f(xi[r]); }
            er = er + 1.0f; ei = ei + 1.0f;
            f32x4 rg, ig;
#pragma unroll
            for (int r = 0; r < 4; ++r) { rg[r] = __builtin_amdgcn_rcpf(er[r]); ig[r] = __builtin_amdgcn_rcpf(ei[r]); }
            const f32x4 la = spl * rg;
            f32x4 A, B;
#pragma unroll
            for (int r = 0; r < 4; ++r) A[r] = __builtin_amdgcn_exp2f(la[r]);
            { f32x4 om = 1.0f - A * A;
#pragma unroll
              for (int r = 0; r < 4; ++r) om[r] = __builtin_amdgcn_sqrtf(fmaxf(om[r], 0.f));
              B = om * ig * uc; }
#define LRU_STEP(N) do { _Pragma("unroll") for (int r = 0; r < 4; ++r) { const float Ap = dpp_shr<N>(1.0f, A[r]), Bp = dpp_shr0<N>(B[r]); B[r] = A[r] * Bp + B[r]; A[r] = A[r] * Ap; } } while (0)
            LRU_STEP(1); LRU_STEP(2); LRU_STEP(4); LRU_STEP(8);
#undef LRU_STEP
            const f32x4 hh = A * Hc + B;
            float q = 0.f;
#pragma unroll
            for (int r = 0; r < 4; ++r) { Hc[r] = __shfl(hh[r], (lane & 48) | 15); q += hh[r] * hh[r]; }
            hv[tt] = hh;
            q += __shfl_xor(q, 16); q += __shfl_xor(q, 32);
            ssq[tt] = q; aR = aRn; aI = aIn;
            __builtin_amdgcn_sched_barrier(0);
        }
        if (lg == 0) {
#pragma unroll
            for (int tt = 0; tt < 8; ++tt) PART[w * 128 + 16 * tt + l15] = ssq[tt];
        }
        asm volatile("s_waitcnt vmcnt(0)" ::: "memory"); RAW_BAR();
#pragma unroll
        for (int tt = 0; tt < 8; ++tt) {
            const int tk = 16 * tt + l15; float tot = 0.f;
#pragma unroll
            for (int ww = 0; ww < 8; ++ww) tot += PART[ww * 128 + tk];
            const float rs = __builtin_amdgcn_rsqf(tot * (1.0f / 128.0f) + EPS);
            const float z[4] = {bflo(zv[tt].x), bfhi(zv[tt].x), bflo(zv[tt].y), bfhi(zv[tt].y)}; float o[4];
#pragma unroll
            for (int r = 0; r < 4; ++r) o[r] = hv[tt][r] * rs * ng[r] * z[r];
            u32x2 wv; wv.x = pk2(o[0], o[1]); wv.y = pk2(o[2], o[3]);
            *(u32x2*)(obase + (size_t)(n * CHK + 16 * tt) * D) = wv;
        }
        if (n + 1 < NCHUNK) {
            LRU_CONV(RAW0 + ((n + 1) & 1) * RAWB, UI0 + ((n + 1) & 1) * 32768);
#pragma unroll
            for (int tt = 0; tt < 8; ++tt) zv[tt] = *(const u32x2*)(zbase + (size_t)((n + 1) * CHK + 16 * tt) * HD);
        }
        RAW_BAR();
        if (n + 2 < NCHUNK) LRU_DMA(n + 2, RAW0 + (n & 1) * RAWB);
    }
    asm volatile("s_waitcnt vmcnt(0)" ::: "memory"); RAW_BAR();
#undef LRU_DMA
#undef LRU_CONV
}
__device__ __forceinline__ void router_phase(Frame& F) {
    const bf16_t* dl = (const bf16_t*)(F.ws + WS_X1); bf16_t* x1b = (bf16_t*)(F.ws + WS_X1 + 128 * MiB);
    unsigned char* h2 = F.ws + WS_H2;
    const bf16_t* whi = (const bf16_t*)(F.ws + WS_WGT);
    int* tokl = (int*)(F.ws + WS_TOK); float* rss = (float*)(F.ws + WS_RSS); u32x2* apk = (u32x2*)(F.ws + WS_APK); f32x2* aw = (f32x2*)(F.ws + WS_AW);
    const int w = F.wave, lane = lane_id(), l15 = lane & 15, lg = lane >> 4;
    LAS float* LG = (LAS float*)(F.lds + 65536 + w * 4096);
    LAS unsigned char* WB0 = F.lds;
    unsigned wsrc[3];
#pragma unroll
    for (int i = 0; i < 3; ++i) { const unsigned row = 4 * (3 * w + i) + lg; wsrc[i] = row * (D * 2) + 16u * ((unsigned)l15 ^ (row & 15u)); }
#define RT_DMA(kc, buf) do { _Pragma("unroll") for (int _i = 0; _i < 3; ++_i) GLDS16((const char*)whi + wsrc[_i] + (kc) * 256, (buf) + 1024 * (3 * w + _i)); } while (0)
    for (int base = F.vcu * NWAVES; base < T / 16; base += F.G * NWAVES) {
        const int item = base + w; const int r0 = item * 16;
        const float* xr = F.x + (size_t)(r0 + l15) * D + 8 * lg; unsigned char* hr = h2 + (size_t)(r0 + l15) * D + 8 * lg;
        const bf16_t* dr = dl + (size_t)(r0 + l15) * D + 8 * lg; bf16_t* xo = x1b + (size_t)(r0 + l15) * D + 8 * lg;
        f32x4 acc[3]; float ss = 0.f;
#pragma unroll
        for (int ct = 0; ct < 3; ++ct) acc[ct] = (f32x4){0.f, 0.f, 0.f, 0.f};
        f32x4 xa[8]; u32x4 da[4];
        RT_DMA(0, WB0);
#pragma unroll 1
        for (int kc = 0; kc < 16; ++kc) {
            LAS unsigned char* WB = WB0 + (kc & 1) * 24576;
            asm volatile("s_waitcnt vmcnt(0)" ::: "memory"); RAW_BAR();
            if (kc + 1 < 16) { RT_DMA(kc + 1, WB0 + ((kc + 1) & 1) * 24576); }
#pragma unroll
            for (int j = 0; j < 4; ++j) { xa[2 * j] = *(const f32x4*)(xr + 128 * kc + 32 * j); xa[2 * j + 1] = *(const f32x4*)(xr + 128 * kc + 32 * j + 4); da[j] = *(const u32x4*)(dr + 128 * kc + 32 * j); }
#pragma unroll
            for (int j = 0; j < 4; ++j) {
                const f32x4 a0 = xa[2 * j] + (f32x4){bflo(da[j].x), bfhi(da[j].x), bflo(da[j].y), bfhi(da[j].y)}, a1 = xa[2 * j + 1] + (f32x4){bflo(da[j].z), bfhi(da[j].z), bflo(da[j].w), bfhi(da[j].w)};
                ss += (a0.x * a0.x + a0.y * a0.y) + (a0.z * a0.z + a0.w * a0.w) + (a1.x * a1.x + a1.y * a1.y) + (a1.z * a1.z + a1.w * a1.w);
                const float av[8] = {a0.x, a0.y, a0.z, a0.w, a1.x, a1.y, a1.z, a1.w};
                unsigned hw[4], lw[4];
#pragma unroll
                for (int i = 0; i < 4; ++i) { hw[i] = pk2(av[2 * i], av[2 * i + 1]); lw[i] = pk2(av[2 * i] - bflo(hw[i]), av[2 * i + 1] - bfhi(hw[i])); }
                const u32x4 xh4 = (u32x4){hw[0], hw[1], hw[2], hw[3]}, xl4 = (u32x4){lw[0], lw[1], lw[2], lw[3]};
                *(u32x2*)(hr + 128 * kc + 32 * j) = (u32x2){pk4_fp8(av[0], av[1], av[2], av[3]), pk4_fp8(av[4], av[5], av[6], av[7])};
                *(u32x4*)(xo + 128 * kc + 32 * j) = xh4;
                const bf16x8 xh = __builtin_bit_cast(bf16x8, xh4), xl = __builtin_bit_cast(bf16x8, xl4);
#pragma unroll
                for (int ct = 0; ct < 3; ++ct) { const unsigned rh = 16 * ct + l15, rl = 48 + 16 * ct + l15;
                    const bf16x8 bh = *(const LAS bf16x8*)(WB + 256 * rh + 16 * ((4 * j + lg) ^ (rh & 15))), bl = *(const LAS bf16x8*)(WB + 256 * rl + 16 * ((4 * j + lg) ^ (rl & 15)));
                    acc[ct] = MFMA16(xh, bh, acc[ct]); acc[ct] = MFMA16(xh, bl, acc[ct]); acc[ct] = MFMA16(xl, bh, acc[ct]); }
            }
        }
        ss += __shfl_xor(ss, 16); ss += __shfl_xor(ss, 32);
#pragma unroll
        for (int ct = 0; ct < 3; ++ct)
#pragma unroll
            for (int r = 0; r < 4; ++r) LG[(4 * lg + r) * 48 + 16 * ct + l15] = acc[ct][r];
        LDS_WAIT();
        if (lane < 16) {
            const int t = r0 + lane; const float rs = 1.0f / sqrtf(ss * (1.0f / D) + EPS);
            const LAS float* L = LG + lane * 48;
            float gl[4];
#pragma unroll
            for (int j = 0; j < 4; ++j) gl[j] = L[j] * rs + F.b_group[j];
            int g = 0; float gm = gl[0];
#pragma unroll
            for (int j = 1; j < 4; ++j) if (gl[j] > gm) { gm = gl[j]; g = j; }
            float den = 0.f;
#pragma unroll
            for (int j = 0; j < 4; ++j) den += expf(gl[j] - gm);
            const float gp = 1.0f / den;
            float v[8];
#pragma unroll
            for (int q = 0; q < 8; ++q) v[q] = L[4 + 8 * g + q] * rs + F.b_router[8 * g + q];
            int ia = 0; float va = v[0];
#pragma unroll
            for (int q = 1; q < 8; ++q) if (v[q] > va) { va = v[q]; ia = q; }
            int ib = -1; float vb = -3.0e38f;
#pragma unroll
            for (int q = 0; q < 8; ++q) if (q != ia && v[q] > vb) { vb = v[q]; ib = q; }
            const float wa = 1.0f / (1.0f + expf(vb - va)), wb = 1.0f - wa;
            const int ea = 8 * g + ia, eb = 8 * g + ib;
            const unsigned ra = atomicAdd(F.ctl + CW_CNT + 64 * ea, 1u), rb = atomicAdd(F.ctl + CW_CNT + 64 * eb, 1u);
            tokl[(size_t)ea * CAP + ra] = t; tokl[(size_t)eb * CAP + rb] = t; rss[(size_t)ea * CAP + ra] = rs; rss[(size_t)eb * CAP + rb] = rs;
            apk[t] = (u32x2){((unsigned)ea << 16) | ra, ((unsigned)eb << 16) | rb}; aw[t] = (f32x2){wa * gp, wb * gp};
        }
        LDS_WAIT();
    }
#undef RT_DMA
}
__device__ __forceinline__ void compute_tile_start(Frame& F) {
    LAS int* ts = (LAS int*)(F.lds + TS_OFF); LAS int* cn = (LAS int*)(F.lds + CN_OFF);
    const int tid = F.wave * 64 + lane_id();
    if (tid < NE) { int c = (int)__hip_atomic_load(F.ctl + CW_CNT + 64 * tid, __ATOMIC_RELAXED, __HIP_MEMORY_SCOPE_AGENT); cn[tid] = c < 0 ? 0 : (c > CAP ? CAP : c); }
    __syncthreads();
    if (tid == 0) { int a = 0; for (int e = 0; e < NE; ++e) { ts[e] = a; a += (cn[e] + 255) >> 8; } ts[NE] = a > MAXRT ? MAXRT : a; }
    __syncthreads();
    if (tid < MAXRT) { int e = 0; for (int j = 1; j < NE; ++j) e = (ts[j] <= tid) ? j : e; ((LAS unsigned char*)(F.lds + RE_OFF))[tid] = (unsigned char)e; }
    __syncthreads();
}
__device__ __forceinline__ void combine_phase(Frame& F) {
    const bf16_t* x1 = (const bf16_t*)(F.ws + WS_X1 + 128 * MiB); const unsigned char* Y = F.ws + WS_Y;
    const u32x2* apk = (const u32x2*)(F.ws + WS_APK); const f32x2* aw = (const f32x2*)(F.ws + WS_AW);
    const LAS int* ts = (const LAS int*)(F.lds + TS_OFF);
    const int gw = F.vcu * NWAVES + F.wave, NGW = F.G * NWAVES, lane = lane_id();
    int m = gw; if (m >= T) return;
    u32x2 pk[2]; f32x2 ww[2];
#pragma unroll
    for (int r = 0; r < 2; ++r) { const int mr = m + r * NGW < T ? m + r * NGW : m; pk[r] = apk[mr]; ww[r] = aw[mr]; }
    for (; m < T; m += 2 * NGW) {
        u32x4 xa[2][4]; u32x2 p[2][4], q[2][4]; float w0[2], w1[2]; int mr[2];
#pragma unroll
        for (int r = 0; r < 2; ++r) {
            mr[r] = m + r * NGW < T ? m + r * NGW : m;
            const int e0 = (pk[r].x >> 16) & 31, e1 = (pk[r].y >> 16) & 31;
            const size_t row0 = (size_t)256 * ts[e0] + (pk[r].x & 0xffffu), row1 = (size_t)256 * ts[e1] + (pk[r].y & 0xffffu);
            w0[r] = ww[r].x * (1.0f / SC_Y); w1[r] = ww[r].y * (1.0f / SC_Y);
            const bf16_t* xr = x1 + (size_t)mr[r] * D + 8 * lane; const unsigned char* y0 = Y + row0 * D + 8 * lane; const unsigned char* y1 = Y + row1 * D + 8 * lane;
#pragma unroll
            for (int j = 0; j < 4; ++j) { xa[r][j] = *(const u32x4*)(xr + 512 * j); p[r][j] = *(const u32x2*)(y0 + 512 * j); q[r][j] = *(const u32x2*)(y1 + 512 * j); }
        }
#pragma unroll
        for (int r = 0; r < 2; ++r) { const int mn = m + (2 + r) * NGW < T ? m + (2 + r) * NGW : mr[r]; pk[r] = apk[mn]; ww[r] = aw[mn]; }
#pragma unroll
        for (int r = 0; r < 2; ++r) {
            float v[4][8]; float ss = 0.f;
#pragma unroll
            for (int j = 0; j < 4; ++j) {
                const f32x2 p0 = __builtin_amdgcn_cvt_pk_f32_fp8((int)p[r][j].x, false), p1 = __builtin_amdgcn_cvt_pk_f32_fp8((int)p[r][j].x, true), p2 = __builtin_amdgcn_cvt_pk_f32_fp8((int)p[r][j].y, false), p3 = __builtin_amdgcn_cvt_pk_f32_fp8((int)p[r][j].y, true);
                const f32x2 q0 = __builtin_amdgcn_cvt_pk_f32_fp8((int)q[r][j].x, false), q1 = __builtin_amdgcn_cvt_pk_f32_fp8((int)q[r][j].x, true), q2 = __builtin_amdgcn_cvt_pk_f32_fp8((int)q[r][j].y, false), q3 = __builtin_amdgcn_cvt_pk_f32_fp8((int)q[r][j].y, true);
                const u32x4 xw = xa[r][j];
                v[j][0] = bflo(xw.x) + w0[r] * p0.x + w1[r] * q0.x; v[j][1] = bfhi(xw.x) + w0[r] * p0.y + w1[r] * q0.y;
                v[j][2] = bflo(xw.y) + w0[r] * p1.x + w1[r] * q1.x; v[j][3] = bfhi(xw.y) + w0[r] * p1.y + w1[r] * q1.y;
                v[j][4] = bflo(xw.z) + w0[r] * p2.x + w1[r] * q2.x; v[j][5] = bfhi(xw.z) + w0[r] * p2.y + w1[r] * q2.y;
                v[j][6] = bflo(xw.w) + w0[r] * p3.x + w1[r] * q3.x; v[j][7] = bfhi(xw.w) + w0[r] * p3.y + w1[r] * q3.y;
#pragma unroll
                for (int i = 0; i < 8; ++i) ss += v[j][i] * v[j][i];
            }
            const float rs = 1.0f / sqrtf(wave_sum(ss) * (1.0f / D) + EPS);
            if (r == 0 || m + NGW < T) {
                float* orow = F.out + (size_t)mr[r] * D + 8 * lane; const float* gf = F.norm_final_g + 8 * lane;
#pragma unroll
                for (int j = 0; j < 4; ++j) { const f32x4 g0 = *(const f32x4*)(gf + 512 * j), g1 = *(const f32x4*)(gf + 512 * j + 4);
                    *(f32x4*)(orow + 512 * j) = (f32x4){v[j][0] * rs * g0.x, v[j][1] * rs * g0.y, v[j][2] * rs * g0.z, v[j][3] * rs * g0.w};
                    *(f32x4*)(orow + 512 * j + 4) = (f32x4){v[j][4] * rs * g1.x, v[j][5] * rs * g1.y, v[j][6] * rs * g1.z, v[j][7] * rs * g1.w}; }
            }
        }
    }
}
__device__ __forceinline__ void final_norm_only(Frame& F, const float* src) {
    const int gw = F.vcu * NWAVES + F.wave, NGW = F.G * NWAVES, lane = lane_id();
    for (int m = gw; m < T; m += NGW) {
        const f32x4* xr = (const f32x4*)(src + (size_t)m * D) + lane; const f32x4* gr = (const f32x4*)F.norm_final_g + lane;
        f32x4 v[8]; float s = 0.f;
#pragma unroll
        for (int j = 0; j < 8; ++j) { v[j] = xr[64 * j]; s += (v[j].x * v[j].x + v[j].y * v[j].y) + (v[j].z * v[j].z + v[j].w * v[j].w); }
        const float rs = 1.0f / sqrtf(wave_sum(s) * (1.0f / D) + EPS);
        f32x4* o = (f32x4*)(F.out + (size_t)m * D) + lane;
#pragma unroll
        for (int j = 0; j < 8; ++j) { const f32x4 g = gr[64 * j]; o[64 * j] = (f32x4){v[j].x * rs * g.x, v[j].y * rs * g.y, v[j].z * rs * g.z, v[j].w * rs * g.w}; }
    }
}

struct Args { const float* in[22]; float* out; unsigned char* ws; int ph_lo, ph_hi, li, pad; };
__global__ void __launch_bounds__(NTHREADS, 2) hymba_fwd(Args args) {
    extern __shared__ __attribute__((aligned(16))) unsigned char lds[];
    Frame F;
    F.lds = (LAS unsigned char*)lds;
    F.MISC = (volatile LAS unsigned*)(F.lds + MISC_OFF);
    F.wave = __builtin_amdgcn_readfirstlane(threadIdx.x >> 6);
    F.G = gridDim.x; { const int bx = blockIdx.x; F.vcu = (F.G % 8 == 0) ? (bx % 8) * (F.G / 8) + bx / 8 : bx; }
    unsigned char* ws = args.ws; F.ws = ws; F.ctl = (unsigned*)(ws + WS_CTL); F.out = args.out;
    F.x = args.in[0]; F.norm_mix_g = args.in[1]; F.w_in = args.in[2]; F.ret_norm_g = args.in[3]; F.conv_w = args.in[4]; F.conv_b = args.in[5]; F.w_rg = args.in[6]; F.b_rg = args.in[7];
    F.w_ig = args.in[8]; F.b_ig = args.in[9]; F.lam = args.in[10]; F.lru_norm_g = args.in[11]; F.w_out = args.in[12]; F.norm_ffn_g = args.in[13]; F.w_group = args.in[14]; F.b_group = args.in[15];
    F.w_router = args.in[16]; F.b_router = args.in[17]; F.w_gate = args.in[18]; F.w_up = args.in[19]; F.w_down = args.in[20]; F.norm_final_g = args.in[21];
    for (int u = threadIdx.x; u < (LDS_BYTES - LDSCTL_OFF) / 4; u += NTHREADS) ((LAS unsigned*)(F.lds + LDSCTL_OFF))[u] = 0u;
    __syncthreads();
    const int lo = args.ph_lo, hi = args.ph_hi;
    XcdBarrier bar; bar.bar = F.ctl + CW_BAR; bar.x = 0; bar.st = nullptr;
    if (hi - lo > 1) bar = xcd_barrier_post(F.ctl + CW_BAR, F.MISC + 8);
#define IN(k) (lo <= (k) && (k) < hi)
#define BOTH(k) (IN(k) && IN((k) + 1))
#define GRID_BAR() xcd_barrier(bar)

    if (IN(0)) { p0_prologue(F); if (BOTH(0)) GRID_BAR(); }
    if (IN(1)) {
        const int G1 = (F.G > 2 * NCONV) ? F.G - NCONV : F.G;
        if ((int)blockIdx.x < G1) {
        pg8::DenseSched<D, T / 256, PROJ / 256, true, true> S; S.so.init(T, PROJ, G1, (int)blockIdx.x); S.A = (const char*)(ws + WS_R1); S.B = (const char*)(ws + WS_WIN);
        pg8::EpiProj E{(bf16_t*)(ws + WS_R2), PROJ, (const float*)(ws + WS_ROPE), (const float*)(ws + WS_ROPE) + SEQ * 64};
        pg8::gemm_phase<pg8::EpiProj, pg8::DenseSched<D, T / 256, PROJ / 256, true, true>, D, true, PG8_ALIGN, PG8_SP2>(F.lds, S, E, F.wave);
        }
        convert_queue(F);
        if (BOTH(1)) GRID_BAR();
    }
    if (IN(2)) {
        for (int u = (int)blockIdx.x; u < 128; u += F.G) retention_unit(F, u >> 3, u & 7);
        for (int u = (int)((blockIdx.x + (unsigned)F.G - (128u % (unsigned)F.G)) % (unsigned)F.G); u < 128; u += F.G) lru_unit(F, u >> 3, u & 7);
        if (BOTH(2)) GRID_BAR();
    }
    if (IN(3)) {
        pg8::DenseSched<D, T / 256, D / 256, false, true> S; S.so.init(T, D, F.G, (int)blockIdx.x); S.A = (const char*)(ws + WS_R1); S.B = (const char*)(ws + WS_WOUT);
        pg8::EpiBf16 E{(bf16_t*)(ws + WS_X1), D, 1.0f};
        pg8::gemm_phase<pg8::EpiBf16, pg8::DenseSched<D, T / 256, D / 256, false, true>, D, true, PG8_ALIGN, PG8_SP2>(F.lds, S, E, F.wave);
        if (BOTH(3)) GRID_BAR();
    }
#if MK_LAST_PHASE <= 4
    if (IN(4)) { final_norm_only(F, (const float*)(ws + WS_X1)); }
#else
    if (IN(4)) { router_phase(F); if (BOTH(4)) GRID_BAR(); }
    if (IN(5)) {
        compute_tile_start(F);
        const LAS int* ts = (const LAS int*)(F.lds + TS_OFF); const LAS int* cn = (const LAS int*)(F.lds + CN_OFF);
        pg8::MoeSched<D / 2, true> S; S.G = F.G; S.c = (int)blockIdx.x; S.nrt = __builtin_amdgcn_readfirstlane(ts[NE]); S.ts = ts; S.cn = cn;
        S.A = (const char*)(ws + WS_H2); S.B = (const char*)(ws + WS_WGU); S.bstride = (size_t)D * D; S.tok = (const int*)(ws + WS_TOK);
        pg8::EpiSwiGLU E{ws + WS_R1, (const float*)(ws + WS_RSS), cn};
        pg8::gemm_phase<pg8::EpiSwiGLU, pg8::MoeSched<D / 2, true>, D / 2, true, PG8_ALIGN, PG8_SP2, true>(F.lds, S, E, F.wave);
        if (BOTH(5)) GRID_BAR();
    }
    if (IN(6)) {
        compute_tile_start(F);
        const LAS int* ts = (const LAS int*)(F.lds + TS_OFF); const LAS int* cn = (const LAS int*)(F.lds + CN_OFF);
        pg8::MoeSched<DE / 2, true, true> S; S.G = F.G; S.c = (int)blockIdx.x; S.nrt = __builtin_amdgcn_readfirstlane(ts[NE]); S.ts = ts; S.cn = cn;
        S.A = (const char*)(ws + WS_R1); S.B = (const char*)(ws + WS_WD); S.bstride = (size_t)D * DE; S.tok = nullptr;
        pg8::EpiFp8 E{ws + WS_Y, D, SC_Y / (SC_HB * SC_WD)};
        pg8::gemm_phase<pg8::EpiFp8, pg8::MoeSched<DE / 2, true, true>, DE / 2, true, PG8_ALIGN, PG8_SP2, true>(F.lds, S, E, F.wave);
        if (BOTH(6)) GRID_BAR();
    }
    if (IN(7)) { compute_tile_start(F); combine_phase(F); }
#endif
#undef IN
#undef BOTH
#undef GRID_BAR
}

extern "C" void kernel_launch(void* const* d_in, const int* in_sizes, int n_in, void* d_out, int out_size, void* d_ws, size_t ws_size, hipStream_t stream) {
    static int grid = 0;
    if (grid == 0) {
        if (n_in != 22 || in_sizes[0] != T * D || out_size != T * D || ws_size < WS_END) { fprintf(stderr, "kernel_launch: unexpected shapes (n_in %d, in0 %d, out %d, ws %zu < %zu); nothing launched\n", n_in, n_in > 0 ? in_sizes[0] : -1, out_size, ws_size, (size_t)WS_END); grid = -1; return; }
        int dev = 0, cus = 0, per_cu = 0;
        if (hipGetDevice(&dev) != hipSuccess || hipDeviceGetAttribute(&cus, hipDeviceAttributeMultiprocessorCount, dev) != hipSuccess) { grid = -1; return; }
        if (hipFuncSetAttribute((const void*)hymba_fwd, hipFuncAttributeMaxDynamicSharedMemorySize, LDS_BYTES) != hipSuccess) { fprintf(stderr, "kernel_launch: hipFuncSetAttribute failed\n"); grid = -1; return; }
        if (hipOccupancyMaxActiveBlocksPerMultiprocessor(&per_cu, (const void*)hymba_fwd, NTHREADS, LDS_BYTES) != hipSuccess || per_cu < 1) { fprintf(stderr, "kernel_launch: occupancy query reports %d blocks per CU\n", per_cu); }
        (void)hipGetLastError();
        grid = cus;
    }
    if (grid < 0) return;
    if (hipMemsetAsync((char*)d_ws + WS_CTL, 0, CTL_ZERO_BYTES, stream) != hipSuccess) return;
    Args a{};
    for (int i = 0; i < 22; ++i) a.in[i] = (const float*)d_in[i];
    a.out = (float*)d_out; a.ws = (unsigned char*)d_ws;
    constexpr int NL = MK_N_LAUNCHES;
    constexpr int LASTP = (MK_LAST_PHASE <= 4) ? 5 : NPHASES;
    if (NL == 1) { a.ph_lo = 0; a.ph_hi = LASTP; a.li = 0; hipLaunchKernelGGL(hymba_fwd, dim3(grid), dim3(NTHREADS), LDS_BYTES, stream, a); }
    else for (int li = 0; li < LASTP; ++li) { a.ph_lo = li; a.ph_hi = li + 1; a.li = li; hipLaunchKernelGGL(hymba_fwd, dim3(grid), dim3(NTHREADS), LDS_BYTES, stream, a);
        if (li == MK_REPEAT_PHASE) hipLaunchKernelGGL(hymba_fwd, dim3(grid), dim3(NTHREADS), LDS_BYTES, stream, a); }
}
```

```cpp
#include <hip/hip_runtime.h>
#include <cstdio>
#include <cstdint>

#ifndef MK_N_LAUNCHES
#define MK_N_LAUNCHES 1
#endif
#ifndef MK_REPEAT_PHASE
#define MK_REPEAT_PHASE -1
#endif
#ifndef MK_LAST_PHASE
#define MK_LAST_PHASE 8
#endif

#define GAS __attribute__((address_space(1)))
#define LAS __attribute__((address_space(3)))
typedef unsigned short bf16_t;
typedef short bf16x8 __attribute__((ext_vector_type(8)));
typedef short s16x4 __attribute__((ext_vector_type(4)));
typedef float f32x4 __attribute__((ext_vector_type(4)));
typedef float f32x2 __attribute__((ext_vector_type(2)));
typedef unsigned u32x4 __attribute__((ext_vector_type(4)));
typedef unsigned u32x2 __attribute__((ext_vector_type(2)));
typedef GAS unsigned gu32;
typedef int i32x4 __attribute__((ext_vector_type(4)));
typedef int i32x8 __attribute__((ext_vector_type(8)));
constexpr float SC_WGU = 64.0f, SC_WD = 32.0f, SC_HB = 4.0f, SC_Y = 16.0f;

constexpr int T = 32768, D = 2048, SEQ = 2048, NBATCH = 16, PROJ = 6144;
constexpr int NH = 8, HD = 128, CHK = 128, NCHUNK = SEQ / CHK;
constexpr int NLB = 8;
constexpr int NE = 32, DE = 1024;
constexpr int CAP = 32768;
constexpr int MAXRT = 288;
constexpr float EPS = 1e-6f;
constexpr int NWAVES = 8, NTHREADS = 512;
constexpr int NPHASES = 8;

constexpr size_t MiB = 1u << 20;
constexpr size_t WS_CTL = 0, CTL_ZERO_BYTES = 65536;
constexpr size_t WS_TOK = 1 * MiB;
constexpr size_t WS_RSS = 5 * MiB;
constexpr size_t WS_APK = 9 * MiB;
constexpr size_t WS_AW  = 9 * MiB + 512 * 1024;
constexpr size_t WS_ROPE = 10 * MiB;
constexpr size_t WS_WGT = 11 * MiB;
constexpr size_t WS_WIN = 12 * MiB;
constexpr size_t WS_WOUT = 36 * MiB;
constexpr size_t WS_WD = 44 * MiB;
constexpr size_t WS_WGU = 172 * MiB;
constexpr size_t WS_R2 = 428 * MiB;
constexpr size_t WS_H2 = WS_R2, WS_X1 = WS_R2 + 128 * MiB;
constexpr size_t WS_R1 = 812 * MiB;
constexpr size_t WS_Y = WS_WGU;
constexpr size_t WS_END = 956 * MiB;
static_assert(WS_Y + (size_t)MAXRT * 256 * 2048 * 2 <= WS_X1, "y overlays Wgu + h2 only");
static_assert(WS_R1 + (size_t)MAXRT * 256 * 1024 * 2 <= WS_END, "hb fits");
constexpr int CW_BAR = 1024;
constexpr int CW_CNT = 8192;
constexpr int CW_Q = 6144;
constexpr int NCONV = 40;

constexpr int RING_BYTES = 131072;
constexpr int LDSCTL_OFF = 143360, MISC_OFF = LDSCTL_OFF + 320;
constexpr int TS_OFF = LDSCTL_OFF + 1024;
constexpr int CN_OFF = LDSCTL_OFF + 1280;
constexpr int RE_OFF = LDSCTL_OFF + 1536;
constexpr int GT_OFF = LDSCTL_OFF + 2048;
constexpr int LDS_BYTES = 147456;

#define LDS_WAIT() asm volatile("s_waitcnt lgkmcnt(0)" ::: "memory")
#define VM_WAIT() asm volatile("s_waitcnt vmcnt(0)" ::: "memory")
__device__ __forceinline__ unsigned f2bf(float f) { unsigned u = __builtin_bit_cast(unsigned, f); return (u + 0x7fffu + ((u >> 16) & 1u)) >> 16; }
typedef __bf16 hwbf16x2 __attribute__((ext_vector_type(2)));
__device__ __forceinline__ unsigned pk2(float lo, float hi) { const f32x2 v = {lo, hi}; return __builtin_bit_cast(unsigned, __builtin_convertvector(v, hwbf16x2)); }
__device__ __forceinline__ float bflo(unsigned w) { return __builtin_bit_cast(float, w << 16); }
__device__ __forceinline__ float bfhi(unsigned w) { return __builtin_bit_cast(float, w & 0xffff0000u); }
__device__ __forceinline__ float sat8(float x) { return __builtin_amdgcn_fmed3f(x, -448.0f, 448.0f); }
__device__ __forceinline__ unsigned pk4_fp8(float a, float b, float c, float d) { int p = 0; a = sat8(a); b = sat8(b); c = sat8(c); d = sat8(d); p = __builtin_amdgcn_cvt_pk_fp8_f32(a, b, p, false); p = __builtin_amdgcn_cvt_pk_fp8_f32(c, d, p, true); return (unsigned)p; }
__device__ __forceinline__ unsigned cvt_pk_bf16(float lo, float hi) { unsigned r; asm volatile("v_cvt_pk_bf16_f32 %0, %1, %2" : "=v"(r) : "v"(lo), "v"(hi)); return r; }
__device__ __forceinline__ int lane_id() { int l; asm volatile("v_mbcnt_lo_u32_b32 %0, -1, 0\n\tv_mbcnt_hi_u32_b32 %0, -1, %0" : "=v"(l)); return l; }
__device__ __forceinline__ float wave_sum(float v) {
#pragma unroll
    for (int o = 1; o < 64; o <<= 1) v += __shfl_xor(v, o);
    return v;
}

namespace pg8 {
constexpr int BM = 256, BK = 64, HALF = 128, HTB = HALF * BK * 2, STAGE_BYTES = 8 * HTB, NXCD = 8, WGM = 2;
__host__ __device__ __forceinline__ int lds_byte(int r, int c) { const int st = (r >> 4) * 2 + (c >> 5), rr = r & 15, cc = c & 31, ob = rr * 64 + cc * 2; return st * 1024 + (ob ^ (((ob >> 9) & 1) << 5)); }
__host__ __device__ __forceinline__ void stage_rc(int b, int& R, int& C) { const int st = b / 1024, sb = b % 1024, swz = sb ^ (((sb >> 9) & 1) << 5); R = (st >> 1) * 16 + swz / 64; C = (st & 1) * 32 + (swz % 64) / 2; }
__host__ __device__ __forceinline__ int perm32(int rho) { const int n = rho >> 4, i = rho & 15; return 8 * (i >> 2) + 4 * n + (i & 3); }

struct Unit { int pm, pn, e, ti; };

template <int NM, int NN> struct StaticOrder {
    static_assert(NM % WGM == 0 && (NM * NN) % NXCD == 0, "whole 8-row groups, whole XCD shares");
    int G, c;
    __device__ void init(int, int, int G_, int c_) { G = G_; c = c_; }
    __device__ bool next(int i, Unit& u) const {
        constexpr int nwg = NM * NN, q = nwg / NXCD, nig = WGM * NN;
        const int L = i * G + c; if (L >= nwg) return false;
        const int wgid = (L % NXCD) * q + L / NXCD;
        const int gid = wgid / nig, w = wgid % nig;
        u.pm = gid * WGM + (w % WGM); u.pn = w / WGM; u.e = 0; u.ti = 0; return true;
    }
};
template <int K, int NM, int NN, bool ROPE = false, bool IDENT = false> struct DenseSched {
    static constexpr bool ident = IDENT;
    StaticOrder<NM, NN> so; const char* A; const char* B;
    __device__ __forceinline__ bool bsel(const Unit& u) const { return ROPE && u.pn < 8; }
    __device__ __forceinline__ bool next(int i, Unit& u) const { return so.next(i, u); }
    __device__ __forceinline__ const char* a_ptr(const Unit& u) const { return IDENT ? A : A + (size_t)u.pm * (256 * K * 2); }
    __device__ __forceinline__ const char* b_ptr(const Unit& u) const { return B + (size_t)u.pn * (256 * K * 2); }
    __device__ __forceinline__ void gather(const Unit& u, int tid, unsigned (&v)[2][2]) const {
#pragma unroll
        for (int i = 0; i < 2; ++i) { int R, C; stage_rc(tid * 16 + i * 8192, R, C);
#pragma unroll
            for (int h = 0; h < 2; ++h) v[h][i] = ((unsigned)(u.pm * 256 + h * 128 + R) * (unsigned)K + (unsigned)C) * 2u; }
    }
    __device__ __forceinline__ const int* tok_ptr(const Unit&) const { return nullptr; }
    __device__ __forceinline__ int count(const Unit&) const { return 0; }
};
template <int K, bool GATHER, bool IDENT = false> struct MoeSched {
    static constexpr bool ident = IDENT;
    int G, c, nrt; const LAS int* ts; const LAS int* cn;
    const char* A; const char* B; size_t bstride; const int* tok;
    __device__ __forceinline__ bool bsel(const Unit&) const { return false; }
    __device__ __forceinline__ bool next(int i, Unit& u) const {
        int L;
        int rt, pnv;
        if (G == 256) { const int b = i * 8 + (c & 7), s_ = c >> 3; rt = (b >> 1) * 8 + (s_ >> 2); pnv = (b & 1) * 4 + (s_ & 3); L = rt * 8 + pnv; }
        else { L = i * G + c; rt = L >> 3; }
        if (rt >= nrt) return false;
        const int e = __builtin_amdgcn_readfirstlane((int)((const LAS unsigned char*)ts + (RE_OFF - TS_OFF))[rt]);
        u.pm = rt; u.pn = L & 7; u.e = e; u.ti = rt - __builtin_amdgcn_readfirstlane(ts[e]); return true;
    }
    __device__ __forceinline__ const char* a_ptr(const Unit& u) const { return GATHER ? A : A + (size_t)u.pm * (256 * K * 2); }
    __device__ __forceinline__ const char* b_ptr(const Unit& u) const { return B + (size_t)u.e * bstride + (size_t)u.pn * (256 * K * 2); }
    __device__ __forceinline__ const int* tok_ptr(const Unit& u) const { return tok + (size_t)u.e * CAP + u.ti * 256; }
    __device__ __forceinline__ int count(const Unit& u) const { return __builtin_amdgcn_readfirstlane(cn[u.e]); }
    __device__ __forceinline__ void gather(const Unit& u, int tid, unsigned (&v)[2][2]) const {
        const int cnt = __builtin_amdgcn_readfirstlane(cn[u.e]);
#pragma unroll
        for (int i = 0; i < 2; ++i) { int R, C; stage_rc(tid * 16 + i * 8192, R, C);
#pragma unroll
            for (int h = 0; h < 2; ++h) { const int rank = u.ti * 256 + h * 128 + R; int t = 0; if (IDENT) t = u.pm * 256 + h * 128 + R; else if (rank < cnt) t = tok[(size_t)u.e * CAP + rank];
                v[h][i] = ((unsigned)t * (unsigned)K + (unsigned)C) * 2u; } }
    }
};

struct EpiBf16 {
    static constexpr bool PERM = true, BSEL = false;
    bf16_t* O; int ldc; float sc;
    __device__ __forceinline__ void operator()(const f32x4 (&acc)[2][2][4][2], const Unit& u, int wr, int wc, int, int) const {
        const int lane_ = lane_id(), fr = lane_ & 15, fq = lane_ >> 4;
        const int row0 = u.pm * BM + wr * 64 + fr, col0 = u.pn * BM + wc * 32 + 8 * fq;
#pragma unroll
        for (int ai = 0; ai < 2; ++ai)
#pragma unroll
            for (int m = 0; m < 4; ++m) { bf16_t* rowp = O + (size_t)(row0 + ai * HALF + m * 16) * ldc + col0;
#pragma unroll
                for (int bj = 0; bj < 2; ++bj) { const f32x4 v0 = acc[ai][bj][m][0] * sc, v1 = acc[ai][bj][m][1] * sc;
                    u32x4 w; w.x = cvt_pk_bf16(v0[0], v0[1]); w.y = cvt_pk_bf16(v0[2], v0[3]); w.z = cvt_pk_bf16(v1[0], v1[1]); w.w = cvt_pk_bf16(v1[2], v1[3]);
                    *(u32x4*)(rowp + bj * HALF) = w; } }
    }
};
struct EpiFp8 {
    static constexpr bool PERM = true, BSEL = false;
    unsigned char* O; int ldc; float sc;
    __device__ __forceinline__ void operator()(const f32x4 (&acc)[2][2][4][2], const Unit& u, int wr, int wc, int, int) const {
        const int lane_ = lane_id(), fr = lane_ & 15, fq = lane_ >> 4;
        const int row0 = u.pm * BM + wr * 64 + fr, col0 = u.pn * BM + wc * 32 + 8 * fq;
#pragma unroll
        for (int ai = 0; ai < 2; ++ai)
#pragma unroll
            for (int m = 0; m < 4; ++m) { unsigned char* rowp = O + (size_t)(row0 + ai * HALF + m * 16) * ldc + col0;
#pragma unroll
                for (int bj = 0; bj < 2; ++bj) { const f32x4 v0 = acc[ai][bj][m][0] * sc, v1 = acc[ai][bj][m][1] * sc;
                    u32x2 w; w.x = pk4_fp8(v0[0], v0[1], v0[2], v0[3]); w.y = pk4_fp8(v1[0], v1[1], v1[2], v1[3]);
                    *(u32x2*)(rowp + bj * HALF) = w; } }
    }
};
struct EpiProj {
    static constexpr bool PERM = true, BSEL = true;
    bf16_t* O; int ldc; const float* rc; const float* rsn;
    __device__ __forceinline__ void operator()(const f32x4 (&acc)[2][2][4][2], const Unit& u, int wr, int wc, int, int) const {
        const int lane_ = lane_id(), fr = lane_ & 15, fq = lane_ >> 4;
        const int row0 = u.pm * BM + wr * 64 + fr;
        if (u.pn >= 8) {
            const int col0 = wc * 32 + 8 * fq;
            const int act = (u.pn >= 12 && u.pn < 16) ? 1 : (u.pn >= 20 ? 2 : 0);
#pragma unroll
            for (int ai = 0; ai < 2; ++ai)
#pragma unroll
                for (int m = 0; m < 4; ++m) { bf16_t* rowp = O + ((size_t)(2 * u.pn) * T + (row0 + ai * HALF + m * 16)) * HD + col0;
#pragma unroll
                    for (int bj = 0; bj < 2; ++bj) { f32x4 v0 = acc[ai][bj][m][0], v1 = acc[ai][bj][m][1];
                        if (act) {
#pragma unroll
                            for (int j = 0; j < 4; ++j) { const float a = v0[j], b = v1[j];
                                const float ya = act == 1 ? a : 1.5957691216057308f * (a + 0.044715f * a * a * a), yb = act == 1 ? b : 1.5957691216057308f * (b + 0.044715f * b * b * b);
                                v0[j] = a * __builtin_amdgcn_rcpf(1.0f + __expf(-ya)); v1[j] = b * __builtin_amdgcn_rcpf(1.0f + __expf(-yb)); } }
                        u32x4 w; w.x = cvt_pk_bf16(v0[0], v0[1]); w.y = cvt_pk_bf16(v0[2], v0[3]); w.z = cvt_pk_bf16(v1[0], v1[1]); w.w = cvt_pk_bf16(v1[2], v1[3]);
                        *(u32x4*)(rowp + (size_t)bj * T * HD) = w; } }
        } else {
            const bool isq = u.pn < 4; const int f0 = 16 * wc + 4 * fq;
            constexpr float L2G[8] = {-4.580368961312479e-2f, -2.272007650008353e-2f, -1.1315313227834146e-2f, -5.646563141142063e-3f, -2.8205190623786626e-3f, -1.4095702546713536e-3f, -7.046129765893727e-4f, -3.522634716290214e-4f};
            float l2g[2];
#pragma unroll
            for (int bj = 0; bj < 2; ++bj) { const int hh = 2 * (u.pn & 3) + bj; float v = L2G[0];
#pragma unroll
                for (int q = 1; q < 8; ++q) v = (hh == q) ? L2G[q] : v;
                l2g[bj] = v; }
            f32x4 csv[2][4], snv[2][4];
#pragma unroll
            for (int ai = 0; ai < 2; ++ai)
#pragma unroll
                for (int m = 0; m < 4; ++m) { const int pos = (row0 + ai * HALF + m * 16) & (SEQ - 1); csv[ai][m] = *(const f32x4*)(rc + pos * 64 + f0); snv[ai][m] = *(const f32x4*)(rsn + pos * 64 + f0); }
#pragma unroll
            for (int ai = 0; ai < 2; ++ai)
#pragma unroll
                for (int m = 0; m < 4; ++m) { const int row = row0 + ai * HALF + m * 16, pos = row & (SEQ - 1), il = pos & 127;
                    const f32x4 cs = csv[ai][m], sn = snv[ai][m];
                    bf16_t* rowp = O + ((size_t)(2 * u.pn) * T + row) * HD + f0;
#pragma unroll
                    for (int bj = 0; bj < 2; ++bj) { const float sc = isq ? __builtin_amdgcn_exp2f((float)(il - 127) * l2g[bj]) * 0.08838834764831845f : __builtin_amdgcn_exp2f((float)(127 - il) * l2g[bj]);
                        const f32x4 x1 = acc[ai][bj][m][0], x2 = acc[ai][bj][m][1]; const f32x4 y1 = (x1 * cs - x2 * sn) * sc, y2 = (x1 * sn + x2 * cs) * sc;
                        u32x2 w1, w2; w1.x = cvt_pk_bf16(y1[0], y1[1]); w1.y = cvt_pk_bf16(y1[2], y1[3]); w2.x = cvt_pk_bf16(y2[0], y2[1]); w2.y = cvt_pk_bf16(y2[2], y2[3]);
                        *(u32x2*)(rowp + (size_t)bj * T * HD) = w1; *(u32x2*)(rowp + (size_t)bj * T * HD + 64) = w2; } }
        }
    }
};
struct EpiF32Res {
    static constexpr bool PERM = false, BSEL = false;
    const float* base; float* C; int ldc;
    __device__ __forceinline__ void operator()(const f32x4 (&acc)[2][2][4][2], const Unit& u, int wr, int wc, int, int) const {
        const int lane_ = lane_id(), fr = lane_ & 15, fq = lane_ >> 4;
        const int row0 = u.pm * BM + wr * 64 + fr, col0 = u.pn * BM + wc * 32 + 4 * fq;
#pragma unroll
        for (int ai = 0; ai < 2; ++ai)
#pragma unroll
            for (int m = 0; m < 4; ++m) { const size_t off = (size_t)(row0 + ai * HALF + m * 16) * ldc + col0;
#pragma unroll
                for (int bj = 0; bj < 2; ++bj)
#pragma unroll
                    for (int n = 0; n < 2; ++n) { const f32x4 b = *(const f32x4*)(base + off + bj * HALF + n * 16); *(f32x4*)(C + off + bj * HALF + n * 16) = acc[ai][bj][m][n] + b; }
                if (m == 3) asm volatile("" ::: "memory"); }
    }
};
struct EpiSwiGLU {
    static constexpr bool PERM = true, BSEL = false;
    unsigned char* O; const float* rss; const LAS int* cn;
    __device__ __forceinline__ void operator()(const f32x4 (&acc)[2][2][4][2], const Unit& u, int wr, int wc, int, int) const {
        const int lane_ = lane_id(), fr = lane_ & 15, fq = lane_ >> 4;
        const int cnt = __builtin_amdgcn_readfirstlane(cn[u.e]);
        const int col0 = u.pn * HALF + wc * 32 + 8 * fq;
        float rsv[2][4];
#pragma unroll
        for (int ai = 0; ai < 2; ++ai)
#pragma unroll
            for (int m = 0; m < 4; ++m) { const int rank = u.ti * 256 + ai * HALF + wr * 64 + m * 16 + fr; const float v = rss[(size_t)u.e * CAP + (rank < cnt ? rank : 0)]; rsv[ai][m] = rank < cnt ? v * (1.0f / SC_WGU) : 0.f; }
#pragma unroll
        for (int ai = 0; ai < 2; ++ai)
#pragma unroll
            for (int m = 0; m < 4; ++m) { const int r = ai * HALF + wr * 64 + m * 16 + fr;
                const float rs = rsv[ai][m];
                float o[8];
#pragma unroll
                for (int n = 0; n < 2; ++n)
#pragma unroll
                    for (int j = 0; j < 4; ++j) { const float g = acc[ai][0][m][n][j] * rs, uu = acc[ai][1][m][n][j] * rs; o[n * 4 + j] = SC_HB * g * uu * __builtin_amdgcn_rcpf(1.0f + __expf(-g)); }
                u32x2 w; w.x = pk4_fp8(o[0], o[1], o[2], o[3]); w.y = pk4_fp8(o[4], o[5], o[6], o[7]);
                *(u32x2*)(O + (size_t)(u.pm * BM + r) * DE + col0) = w; }
    }
};

template <class Epi, class Sched, int K, bool GATHER, bool ALIGN_EPI, bool SP2, bool FP8 = false>
__device__ __forceinline__ void gemm_phase(LAS unsigned char* lds, const Sched& S, const Epi& E, int wid) {
    const int lane = lane_id(), tid = wid * 64 + lane, wr = wid >> 2, wc = wid & 3, fr = lane & 15, fq = lane >> 4;
    constexpr int nt = K / BK;
    unsigned voffA[2], voffB[2];
#pragma unroll
    for (int i = 0; i < 2; ++i) { int R, C; stage_rc(tid * 16 + i * 8192, R, C); const int Rb = Epi::PERM ? ((R & ~31) + perm32(R & 31)) : R;
        voffA[i] = (unsigned)(R * K + C) * 2u; voffB[i] = (unsigned)(Rb * K + C) * 2u; }
    unsigned voffB2[2]; bool selC = false, selN = false;
    if constexpr (Epi::BSEL) {
#pragma unroll
        for (int i = 0; i < 2; ++i) { int R, C; stage_rc(tid * 16 + i * 8192, R, C); const int Rb = 64 * ((R >> 4) & 1) + 16 * (R >> 5) + (R & 15); voffB2[i] = (unsigned)(Rb * K + C) * 2u; }
    }
    constexpr size_t kstep = (size_t)(BK * 2);
    constexpr size_t hstep = (size_t)HALF * K * 2;
    const unsigned ldsw = (unsigned)wid * 1024u;
    const int aoff = lds_byte(wr * 64 + fr, fq * 8), boff = lds_byte(wc * 32 + fr, fq * 8);
    unsigned vC[2][2];
    LAS int* gtab = (LAS int*)(lds + (GT_OFF));
#define PG8_SA(b, h) (((b) * 2 + (h)) * HTB)
#define PG8_SB(b, h) ((4 + (b) * 2 + (h)) * HTB)
#define PG8_STAGE(bufoff, gbase, voff) do { _Pragma("unroll") for (int _i = 0; _i < 2; ++_i) \
        __builtin_amdgcn_global_load_lds((const unsigned*)((const char*)(gbase) + (voff)[_i]), (LAS unsigned*)(lds + (bufoff) + ldsw + _i * 8192), 16, 0, 0); } while (0)
#define PG8_STAGE_A(bufoff, gp, h, nx) do { if constexpr (GATHER) PG8_STAGE(bufoff, gp, vC[h]); else PG8_STAGE(bufoff, (gp) + (h) * hstep, voffA); } while (0)
#define PG8_SWITCH() do { if constexpr (GATHER) { if (last && has_next) { const int _cnt = S.count(nxt); _Pragma("unroll") for (int _i = 0; _i < 2; ++_i) { int _R, _C; stage_rc(tid * 16 + _i * 8192, _R, _C); \
        _Pragma("unroll") for (int _h = 0; _h < 2; ++_h) { const int _r = _h * 128 + _R; int _t; if constexpr (Sched::ident) _t = nxt.pm * 256 + _r; else { _t = gtab[_r]; _t = (nxt.ti * 256 + _r < _cnt) ? _t : 0; } vC[_h][_i] = ((unsigned)_t * (unsigned)K + (unsigned)_C) * 2u; } } } } } while (0)
#define PG8_STAGE_B(bufoff, gp, nx) do { if constexpr (Epi::BSEL) { const bool _s = (nx) ? selN : selC; if (_s) PG8_STAGE(bufoff, gp, voffB2); else PG8_STAGE(bufoff, gp, voffB); } else PG8_STAGE(bufoff, gp, voffB); } while (0)
#define PG8_LD8(p) __builtin_shufflevector(*(const LAS i32x4*)(p), *(const LAS i32x4*)((p) + 1024), 0, 1, 2, 3, 4, 5, 6, 7)
#define PG8_LDA(dst, b, h) do { _Pragma("unroll") for (int m = 0; m < 4; ++m) { if constexpr (FP8) dst##8[m] = PG8_LD8(lds + PG8_SA(b, h) + aoff + m * 2048); else { _Pragma("unroll") for (int k = 0; k < 2; ++k) dst[m][k] = *(const LAS bf16x8*)(lds + PG8_SA(b, h) + aoff + m * 2048 + k * 1024); } } } while (0)
#define PG8_LDB(dst, b, h) do { _Pragma("unroll") for (int n = 0; n < 2; ++n) { if constexpr (FP8) dst##8[n] = PG8_LD8(lds + PG8_SB(b, h) + boff + n * 2048); else { _Pragma("unroll") for (int k = 0; k < 2; ++k) dst[n][k] = *(const LAS bf16x8*)(lds + PG8_SB(b, h) + boff + n * 2048 + k * 1024); } } } while (0)
#define PG8_MMA(ai, bj, At, Bt) do { __builtin_amdgcn_s_setprio(1); _Pragma("unroll") for (int m = 0; m < 4; ++m) _Pragma("unroll") for (int n = 0; n < 2; ++n) { \
        if constexpr (FP8) acc[ai][bj][m][n] = __builtin_amdgcn_mfma_scale_f32_16x16x128_f8f6f4(Bt##8[n], At##8[m], acc[ai][bj][m][n], 0, 0, 0, 0x7f7f7f7f, 0, 0x7f7f7f7f); \
        else { _Pragma("unroll") for (int k = 0; k < 2; ++k) acc[ai][bj][m][n] = __builtin_amdgcn_mfma_f32_16x16x32_bf16(Bt[n][k], At[m][k], acc[ai][bj][m][n], 0, 0, 0); } } \
        __builtin_amdgcn_s_setprio(0); } while (0)
#define PG8_WAIT_V(n) asm volatile("s_waitcnt vmcnt(" #n ")" ::: "memory")
#define PG8_WAIT_L(n) asm volatile("s_waitcnt lgkmcnt(" #n ")" ::: "memory")
#define PG8_BAR __builtin_amdgcn_s_barrier()
#define PG8_SCHED __builtin_amdgcn_sched_barrier(0)
    Unit cur, nxt; int ui = 0;
    if (!S.next(0, cur)) return;
    f32x4 acc[2][2][4][2];
#pragma unroll
    for (int a = 0; a < 2; ++a)
#pragma unroll
        for (int b = 0; b < 2; ++b)
#pragma unroll
            for (int m = 0; m < 4; ++m)
#pragma unroll
                for (int n = 0; n < 2; ++n) acc[a][b][m][n] = (f32x4){0.f, 0.f, 0.f, 0.f};
    bf16x8 At[4][2], B0[2][2], B1[2][2]; i32x8 At8[4], B08[2], B18[2];
    const char* cA = S.a_ptr(cur); const char* cB = S.b_ptr(cur);
    if constexpr (GATHER) { S.gather(cur, tid, vC); }
    if constexpr (Epi::BSEL) selC = S.bsel(cur);
    if constexpr (SP2) {
        PG8_STAGE_B(PG8_SB(0, 0), cB, false); PG8_STAGE_B(PG8_SB(0, 1), cB + hstep, false); PG8_STAGE_A(PG8_SA(0, 0), cA, 0, false); PG8_STAGE_A(PG8_SA(0, 1), cA, 1, false);
        if (wr == 1) PG8_BAR;
        PG8_WAIT_V(2); PG8_BAR;
        PG8_STAGE_B(PG8_SB(1, 0), cB + kstep, false); PG8_STAGE_A(PG8_SA(1, 0), cA + kstep, 0, false); PG8_STAGE_B(PG8_SB(1, 1), cB + hstep + kstep, false);
        PG8_WAIT_V(6); PG8_BAR;
    } else {
        PG8_STAGE_B(PG8_SB(0, 0), cB, false); PG8_STAGE_A(PG8_SA(0, 0), cA, 0, false); PG8_STAGE_B(PG8_SB(0, 1), cB + hstep, false); PG8_STAGE_A(PG8_SA(0, 1), cA, 1, false);
        if (wr == 1) PG8_BAR;
        PG8_WAIT_V(4); PG8_BAR;
        PG8_STAGE_B(PG8_SB(1, 0), cB + kstep, false); PG8_STAGE_A(PG8_SA(1, 0), cA + kstep, 0, false); PG8_STAGE_B(PG8_SB(1, 1), cB + hstep + kstep, false);
        PG8_WAIT_V(6); PG8_BAR;
    }
    for (;;) {
        const bool has_next = S.next(ui + 1, nxt);
        const char* nA = has_next ? S.a_ptr(nxt) : cA; const char* nB = has_next ? S.b_ptr(nxt) : cB;
        if constexpr (Epi::BSEL) selN = has_next ? S.bsel(nxt) : selC;
        if constexpr (GATHER && !Sched::ident) { if (has_next && wid < 4) __builtin_amdgcn_global_load_lds((const unsigned*)(S.tok_ptr(nxt) + wid * 64 + lane), (LAS unsigned*)(gtab + wid * 64), 4, 0, 0); }
#pragma unroll 1
        for (int t = 0; t < nt; t += 2) {
            const bool last = (t == nt - 2);
            const char* a1 = cA + (size_t)(t + 1) * kstep;
            const char* a2 = last ? nA : cA + (size_t)(t + 2) * kstep; const char* b2 = last ? nB : cB + (size_t)(t + 2) * kstep;
            const char* a3 = a2 + kstep; const char* b3 = b2 + kstep;
            if constexpr (SP2) {
            PG8_LDB(B0, 0, 0); PG8_LDB(B1, 0, 1); PG8_SCHED; PG8_LDA(At, 0, 0); PG8_STAGE_A(PG8_SA(1, 1), a1, 1, false); PG8_SWITCH();
            PG8_WAIT_V(8); PG8_WAIT_L(0); PG8_BAR; PG8_MMA(0, 0, At, B0); PG8_MMA(0, 1, At, B1); PG8_BAR; PG8_SCHED;
            PG8_LDA(At, 0, 1); PG8_STAGE_B(PG8_SB(0, 0), b2, last); PG8_STAGE_B(PG8_SB(0, 1), b2 + hstep, last); PG8_STAGE_A(PG8_SA(0, 0), a2, 0, last);
            PG8_WAIT_V(8); PG8_WAIT_L(0); PG8_BAR; PG8_MMA(1, 0, At, B0); PG8_MMA(1, 1, At, B1); PG8_BAR; PG8_SCHED;
            PG8_LDB(B0, 1, 0); PG8_LDB(B1, 1, 1); PG8_SCHED; PG8_LDA(At, 1, 0); PG8_STAGE_A(PG8_SA(0, 1), a2, 1, last);
            PG8_WAIT_V(8); PG8_WAIT_L(0); PG8_BAR; PG8_MMA(0, 0, At, B0); PG8_MMA(0, 1, At, B1); PG8_BAR; PG8_SCHED;
            PG8_LDA(At, 1, 1); PG8_STAGE_B(PG8_SB(1, 0), b3, last); PG8_STAGE_B(PG8_SB(1, 1), b3 + hstep, last); PG8_STAGE_A(PG8_SA(1, 0), a3, 0, last);
            PG8_WAIT_V(8); PG8_WAIT_L(0); PG8_BAR; PG8_MMA(1, 0, At, B0); PG8_MMA(1, 1, At, B1); PG8_BAR; PG8_SCHED;
            } else {
            PG8_LDB(B0, 0, 0); PG8_SCHED; PG8_LDA(At, 0, 0); PG8_STAGE_A(PG8_SA(1, 1), a1, 1, false); PG8_SWITCH();
            PG8_WAIT_L(8); PG8_BAR; PG8_WAIT_L(0); PG8_MMA(0, 0, At, B0); PG8_BAR; PG8_SCHED;
            PG8_LDB(B1, 0, 1); PG8_STAGE_B(PG8_SB(0, 0), b2, last);
            PG8_BAR; PG8_WAIT_L(0); PG8_MMA(0, 1, At, B1); PG8_BAR;
            PG8_LDA(At, 0, 1); PG8_STAGE_A(PG8_SA(0, 0), a2, 0, last);
            PG8_BAR; PG8_WAIT_L(0); PG8_MMA(1, 0, At, B0); PG8_BAR; PG8_SCHED;
            PG8_STAGE_B(PG8_SB(0, 1), b2 + hstep, last);
            PG8_WAIT_V(6); PG8_BAR; PG8_MMA(1, 1, At, B1); PG8_BAR;
            PG8_LDB(B0, 1, 0); PG8_SCHED; PG8_LDA(At, 1, 0); PG8_STAGE_A(PG8_SA(0, 1), a2, 1, last);
            PG8_WAIT_L(8); PG8_BAR; PG8_WAIT_L(0); PG8_MMA(0, 0, At, B0); PG8_BAR; PG8_SCHED;
            PG8_LDB(B1, 1, 1); PG8_STAGE_B(PG8_SB(1, 0), b3, last);
            PG8_BAR; PG8_WAIT_L(0); PG8_MMA(0, 1, At, B1); PG8_BAR;
            PG8_LDA(At, 1, 1); PG8_STAGE_A(PG8_SA(1, 0), a3, 0, last);
            PG8_BAR; PG8_WAIT_L(0); PG8_MMA(1, 0, At, B0); PG8_BAR; PG8_SCHED;
            PG8_STAGE_B(PG8_SB(1, 1), b3 + hstep, last);
            PG8_WAIT_V(6); PG8_BAR; PG8_MMA(1, 1, At, B1); PG8_BAR;
            }
        }
        if constexpr (ALIGN_EPI) { if (wr == 0) PG8_BAR; }
        E(acc, cur, wr, wc, fr, fq);
        if (!has_next) break;
#pragma unroll
        for (int a = 0; a < 2; ++a)
#pragma unroll
            for (int b = 0; b < 2; ++b)
#pragma unroll
                for (int m = 0; m < 4; ++m)
#pragma unroll
                    for (int n = 0; n < 2; ++n) acc[a][b][m][n] = (f32x4){0.f, 0.f, 0.f, 0.f};
        cur = nxt; cA = nA; cB = nB; ++ui; selC = selN;
        if constexpr (ALIGN_EPI) { if (wr == 1) PG8_BAR; }
    }
    PG8_WAIT_V(0);
    if constexpr (!ALIGN_EPI) { if (wr == 0) PG8_BAR; }
    PG8_BAR;
#undef PG8_SA
#undef PG8_SB
#undef PG8_STAGE
#undef PG8_STAGE_A
#undef PG8_SWITCH
#undef PG8_STAGE_B
#undef PG8_LDA
#undef PG8_LDB
#undef PG8_MMA
#undef PG8_LD8
#undef PG8_WAIT_V
#undef PG8_WAIT_L
#undef PG8_BAR
#undef PG8_SCHED
}
}

#ifndef PG8_SP2
#define PG8_SP2 true
#endif
#ifndef PG8_ALIGN
#define PG8_ALIGN true
#endif

#define XB_TMO      128
#define XB_XCNT(j)  (256  + 64 * (j))
#define XB_XSUB(j)  (1280 + 64 * (j))
#define XB_XGEN(j)  (2304 + 64 * (j))
#define XB_TOP      3328
#define XB_TOPGEN   3392
#define XCD_BAR_WORDS 3456
#define XB_SPIN_CAP (1u << 18)
__device__ __forceinline__ unsigned xb_ld(unsigned* p)              { return __hip_atomic_load(p, __ATOMIC_RELAXED, __HIP_MEMORY_SCOPE_AGENT); }
__device__ __forceinline__ unsigned xb_add(unsigned* p, unsigned v) { return __hip_atomic_fetch_add(p, v, __ATOMIC_RELAXED, __HIP_MEMORY_SCOPE_AGENT); }
__device__ __forceinline__ unsigned xb_xcc_id() { return (unsigned)__builtin_amdgcn_s_getreg((3 << 11) | 20) & 0xFu; }
#define XB_SPIN(cond, bar) do { unsigned _sp = 0; while (cond) { __builtin_amdgcn_s_sleep(1); \
    if ((++_sp & 255u) == 0u) { if (xb_ld(&(bar)[XB_TMO])) break; if (_sp > XB_SPIN_CAP) { atomicAdd(&(bar)[XB_TMO], 1u); break; } } } } while (0)
struct XcdBarrier { unsigned* bar; unsigned x; volatile LAS unsigned* st; };
__device__ __forceinline__ XcdBarrier xcd_barrier_post(unsigned* bar, volatile LAS unsigned* st) {
    XcdBarrier b; b.bar = bar; b.x = xb_xcc_id(); b.st = st;
    if (threadIdx.x == 0) (void)xb_add(&bar[XB_XCNT(b.x)], 1u);
    return b;
}
__device__ __forceinline__ void xcd_barrier_complete(unsigned* bar, unsigned x, unsigned& nloc, unsigned& nx) {
    const unsigned G = gridDim.x * gridDim.y * gridDim.z;
    unsigned sum, cnt, mine, sp = 0u;
    for (;;) {
        sum = 0u; cnt = 0u; mine = 0u;
#pragma unroll
        for (unsigned j = 0; j < 16; ++j) { const unsigned c = xb_ld(&bar[XB_XCNT(j)]); sum += c; cnt += (c > 0u) ? 1u : 0u; mine = (j == x) ? c : mine; }
        if (sum == G) break;
        __builtin_amdgcn_s_sleep(1);
        if ((++sp & 255u) == 0u) { if (xb_ld(&bar[XB_TMO])) break; if (sp > XB_SPIN_CAP) { atomicAdd(&bar[XB_TMO], 1u); break; } }
    }
    nloc = mine > 0u ? mine : 1u; nx = cnt > 0u ? cnt : 1u;
}
__device__ __forceinline__ void xcd_barrier(const XcdBarrier& b) {
    asm volatile("s_waitcnt vmcnt(0)" ::: "memory");
    __syncthreads();
    if (threadIdx.x == 0) {
        unsigned* bar = b.bar;
        __builtin_amdgcn_s_waitcnt(0);
        unsigned nloc = b.st[0], nx = b.st[1];
        if (nloc == 0u) { xcd_barrier_complete(bar, b.x, nloc, nx); b.st[0] = nloc; b.st[1] = nx; }
        const unsigned old = xb_add(&bar[XB_XSUB(b.x)], 1u);
        const unsigned gen = old / nloc;
        if (old + 1u == (gen + 1u) * nloc) {
            __builtin_amdgcn_fence(__ATOMIC_RELEASE, "agent");
            asm volatile("s_waitcnt vmcnt(0)" ::: "memory");
            const unsigned og = xb_add(&bar[XB_TOP], 1u);
            const unsigned tg = og / nx;
            if (og + 1u == (tg + 1u) * nx) xb_add(&bar[XB_TOPGEN], 1u);
            else XB_SPIN(xb_ld(&bar[XB_TOPGEN]) == tg, bar);
            __builtin_amdgcn_fence(__ATOMIC_ACQUIRE, "agent");
            xb_add(&bar[XB_XGEN(b.x)], 1u);
            asm volatile("s_waitcnt vmcnt(0)" ::: "memory");
        } else {
            XB_SPIN(xb_ld(&bar[XB_XGEN(b.x)]) == gen, bar);
            __builtin_amdgcn_fence(__ATOMIC_ACQUIRE, "agent");
            asm volatile("s_waitcnt vmcnt(0)" ::: "memory");
        }
    }
    __syncthreads();
}

struct Frame {
    LAS unsigned char* lds;
    volatile LAS unsigned* MISC;
    unsigned* ctl;
    int wave, vcu, G;
    const float *x, *norm_mix_g, *w_in, *ret_norm_g, *conv_w, *conv_b, *w_rg, *b_rg, *w_ig, *b_ig, *lam, *lru_norm_g, *w_out, *norm_ffn_g,
                *w_group, *b_group, *w_router, *b_router, *w_gate, *w_up, *w_down, *norm_final_g;
    float* out;
    unsigned char* ws;
};

__device__ __forceinline__ unsigned offb(unsigned row, unsigned ch);
__device__ __forceinline__ bf16x8 tr_frag(LAS unsigned char* img, int lane, int c, int ks);
__device__ __forceinline__ bf16x8 tr_rows(LAS unsigned char* img, int lane, int c, int row0) {
    const unsigned q = (lane & 15) >> 2, p = lane & 3;
    const s16x4 a = __builtin_amdgcn_ds_read_tr16_b64_v4i16((LAS s16x4*)(img + offb(row0 + q, 2 * c + (p >> 1)) + 8 * (p & 1)));
    const s16x4 b = __builtin_amdgcn_ds_read_tr16_b64_v4i16((LAS s16x4*)(img + offb(row0 + 4 + q, 2 * c + (p >> 1)) + 8 * (p & 1)));
    bf16x8 r; r[0] = a[0]; r[1] = a[1]; r[2] = a[2]; r[3] = a[3]; r[4] = b[0]; r[5] = b[1]; r[6] = b[2]; r[7] = b[3]; return r;
}
template <bool F8, bool GK>
__device__ __forceinline__ void p0_transpose_item(const float* W, int N, int k0, int n0, void* WTrow0, int KoutB, const LAS float* gk, float scale, LAS unsigned char* img, int lane) {
    const int l31 = lane & 31, lh = lane >> 5, l15 = lane & 15, g = lane >> 4;
    const float* src = W + (size_t)(k0 + lh) * N + n0 + 4 * l31;
#define P0_OUT(pass) do { LDS_WAIT(); asm volatile("" ::: "memory"); const int kk0 = k0 + 64 * (pass); \
        if constexpr (F8) { _Pragma("unroll") for (int c = 0; c < 8; ++c) { const u32x4 q0 = __builtin_bit_cast(u32x4, tr_rows(img, lane, c, 16 * g)), q1 = __builtin_bit_cast(u32x4, tr_rows(img, lane, c, 16 * g + 8)); \
            u32x4 o; o.x = pk4_fp8(bflo(q0.x), bfhi(q0.x), bflo(q0.y), bfhi(q0.y)); o.y = pk4_fp8(bflo(q0.z), bfhi(q0.z), bflo(q0.w), bfhi(q0.w)); \
            o.z = pk4_fp8(bflo(q1.x), bfhi(q1.x), bflo(q1.y), bfhi(q1.y)); o.w = pk4_fp8(bflo(q1.z), bfhi(q1.z), bflo(q1.w), bfhi(q1.w)); \
            *(u32x4*)((unsigned char*)WTrow0 + (size_t)(16 * c + l15) * KoutB + kk0 + 16 * g) = o; } } \
        else { _Pragma("unroll") for (int c = 0; c < 8; ++c) _Pragma("unroll") for (int ks = 0; ks < 2; ++ks) { const bf16x8 f = tr_frag(img, lane, c, ks); \
            *(bf16x8*)((unsigned char*)WTrow0 + (size_t)(16 * c + l15) * KoutB + 2 * (kk0 + 32 * ks + 8 * g)) = f; } } \
        LDS_WAIT(); asm volatile("" ::: "memory"); } while (0)
#pragma unroll 1
    for (int pass = 0; pass < 2; ++pass) {
#pragma unroll
        for (int half = 0; half < 2; ++half) {
            const int st = 2 * pass + half;
            f32x4 v[16]; float gs[16];
#pragma unroll
            for (int i = 0; i < 16; ++i) v[i] = __builtin_nontemporal_load((const f32x4*)(src + (size_t)(32 * st + 2 * i) * N));
#pragma unroll
            for (int i = 0; i < 16; ++i) gs[i] = GK ? gk[k0 + 32 * st + 2 * i + lh] : scale;
#pragma unroll
            for (int i = 0; i < 16; ++i) { const int kl = 32 * half + 2 * i + lh; const f32x4 x = v[i] * gs[i];
                u32x2 w; w.x = pk2(x.x, x.y); w.y = pk2(x.z, x.w); *(LAS u32x2*)(img + offb(kl, l31 >> 1) + 8 * (l31 & 1)) = w; }
        }
        P0_OUT(pass);
    }
#undef P0_OUT
}
constexpr int I_G = (D / 128) * (DE / 128), I_DN = (DE / 128) * (D / 128), NQ_ITEMS = NE * (2 * I_G + I_DN);
__device__ __forceinline__ void convert_queue(Frame& F) {
    LAS unsigned char* scr = F.lds + F.wave * 16384;
    const int lane = lane_id();
    unsigned char* Wd8 = F.ws + WS_WD; unsigned char* Wgu8 = F.ws + WS_WGU;
    LAS float* GKT = (LAS float*)(F.lds + 131072);
    for (int i = F.wave * 64 + lane; i < D; i += NTHREADS) GKT[i] = F.norm_ffn_g[i] * SC_WGU;
    __syncthreads();
    for (;;) {
        unsigned it = 0; if (lane == 0) it = atomicAdd(F.ctl + CW_Q, 1u);
        int r = __builtin_amdgcn_readfirstlane((int)it); if (r >= NQ_ITEMS) break;
        const int e = r / (2 * I_G + I_DN); r -= e * (2 * I_G + I_DN);
        if (r < 2 * I_G) { const int up = r >= I_G; if (up) r -= I_G; const int nblk = DE / 128, kb = r / nblk, nb = r % nblk;
            const float* W = (up ? F.w_up : F.w_gate) + (size_t)e * D * DE;
            unsigned char* row0 = Wgu8 + (size_t)e * D * D + (size_t)(256 * nb + 128 * up) * D;
            p0_transpose_item<true, true>(W, DE, 128 * kb, 128 * nb, row0, D, GKT, SC_WGU, scr, lane); continue; }
        r -= 2 * I_G;
        { const int nblk = D / 128, kb = r / nblk, nb = r % nblk; p0_transpose_item<true, false>(F.w_down + (size_t)e * DE * D, D, 128 * kb, 128 * nb, Wd8 + (size_t)e * D * DE + (size_t)(128 * nb) * DE, DE, nullptr, SC_WD, scr, lane); }
    }
}
__device__ __forceinline__ void p0_prologue(Frame& F) {
    LAS unsigned char* scr = F.lds + F.wave * 16384;
    const int lane = lane_id(), tid = F.wave * 64 + lane;
    const int gw = F.wave * F.G + F.vcu, NGW = F.G * NWAVES;
    bf16_t* Win_t = (bf16_t*)(F.ws + WS_WIN); bf16_t* Wout_t = (bf16_t*)(F.ws + WS_WOUT);
    constexpr int I_IN = (D / 128) * (PROJ / 128), I_OUT = (D / 128) * (D / 128);
    constexpr int NITEMS = I_IN + I_OUT;
    for (int it = gw; it < NITEMS; it += NGW) {
        int r = it;
        if (r < I_IN) { const int nblk = PROJ / 128, kb = r / nblk, nb = r % nblk; p0_transpose_item<false, false>(F.w_in, PROJ, 128 * kb, 128 * nb, Win_t + (size_t)(128 * nb) * D, D * 2, nullptr, 1.0f, scr, lane); continue; } r -= I_IN;
        { const int nblk = D / 128, kb = r / nblk, nb = r % nblk; p0_transpose_item<false, false>(F.w_out, D, 128 * kb, 128 * nb, Wout_t + (size_t)(128 * nb) * D, D * 2, nullptr, 1.0f, scr, lane); }
    }
    bf16_t* Hb = (bf16_t*)(F.ws + WS_R1);
    f32x4 gmix[8];
#pragma unroll
    for (int j = 0; j < 8; ++j) gmix[j] = ((const f32x4*)F.norm_mix_g + lane)[64 * j];
    for (int m = gw; m < T; m += 2 * NGW) {
        const int m2 = m + NGW < T ? m + NGW : m;
        const f32x4* xr = (const f32x4*)(F.x + (size_t)m * D) + lane; const f32x4* xr2 = (const f32x4*)(F.x + (size_t)m2 * D) + lane;
        f32x4 v[8], v2[8]; float s = 0.f, s2 = 0.f;
#pragma unroll
        for (int j = 0; j < 8; ++j) { v[j] = __builtin_nontemporal_load(xr + 64 * j); v2[j] = __builtin_nontemporal_load(xr2 + 64 * j); }
#pragma unroll
        for (int j = 0; j < 8; ++j) { s += (v[j].x * v[j].x + v[j].y * v[j].y) + (v[j].z * v[j].z + v[j].w * v[j].w); s2 += (v2[j].x * v2[j].x + v2[j].y * v2[j].y) + (v2[j].z * v2[j].z + v2[j].w * v2[j].w); }
        const float rs = 1.0f / sqrtf(wave_sum(s) * (1.0f / D) + EPS), rs2 = 1.0f / sqrtf(wave_sum(s2) * (1.0f / D) + EPS);
        u32x2* o = (u32x2*)(Hb + (size_t)m * D) + lane; u32x2* o2 = (u32x2*)(Hb + (size_t)m2 * D) + lane;
#pragma unroll
        for (int j = 0; j < 8; ++j) { const f32x4 g = gmix[j]; u32x2 w; w.x = pk2(v[j].x * rs * g.x, v[j].y * rs * g.y); w.y = pk2(v[j].z * rs * g.z, v[j].w * rs * g.w); o[64 * j] = w;
            u32x2 w2; w2.x = pk2(v2[j].x * rs2 * g.x, v2[j].y * rs2 * g.y); w2.y = pk2(v2[j].z * rs2 * g.z, v2[j].w * rs2 * g.w); o2[64 * j] = w2; }
    }
    const int gt = F.vcu * NTHREADS + tid, NGT = F.G * NTHREADS;
    float* rc = (float*)(F.ws + WS_ROPE); float* rsn = rc + SEQ * 64;
    for (int i = gt; i < SEQ * 64; i += NGT) { const int pos = i >> 6, f = i & 63; const float inv = powf(10000.0f, -(float)f / 64.0f); const float ang = (float)pos * inv; float sv, cv; sincosf(ang, &sv, &cv); rc[i] = cv; rsn[i] = sv; }
    bf16_t* whi = (bf16_t*)(F.ws + WS_WGT); bf16_t* wlo = whi + 48 * D;
    for (int i = gt; i < 48 * D; i += NGT) { const int n = i / D, k = i % D; float v = 0.f;
        if (n < 4) v = F.w_group[k * 4 + n]; else if (n < 36) v = F.w_router[k * 32 + (n - 4)];
        v *= F.norm_ffn_g[k]; const unsigned h = f2bf(v); const float hf = __builtin_bit_cast(float, h << 16); whi[i] = (bf16_t)h; wlo[i] = (bf16_t)f2bf(v - hf); }
}

__device__ __forceinline__ unsigned offb(unsigned row, unsigned ch) { return 256u * row + 16u * (ch ^ (((row & 3u) << 2) | ((row >> 2) & 3u))); }
__device__ __forceinline__ bf16x8 row_frag(LAS unsigned char* img, int lane, int rb, int s) { return *(const LAS bf16x8*)(img + offb((lane & 15) + 16 * rb, 4 * s + (lane >> 4))); }
__device__ __forceinline__ bf16x8 tr_frag(LAS unsigned char* img, int lane, int c, int ks) {
    const unsigned g = lane >> 4, q = (lane & 15) >> 2, p = lane & 3;
    const s16x4 a = __builtin_amdgcn_ds_read_tr16_b64_v4i16((LAS s16x4*)(img + offb(32 * ks + 8 * g + q, 2 * c + (p >> 1)) + 8 * (p & 1)));
    const s16x4 b = __builtin_amdgcn_ds_read_tr16_b64_v4i16((LAS s16x4*)(img + offb(32 * ks + 8 * g + 4 + q, 2 * c + (p >> 1)) + 8 * (p & 1)));
    bf16x8 r; r[0] = a[0]; r[1] = a[1]; r[2] = a[2]; r[3] = a[3]; r[4] = b[0]; r[5] = b[1]; r[6] = b[2]; r[7] = b[3]; return r;
}
#define MFMA16(a, b, c) __builtin_amdgcn_mfma_f32_16x16x32_bf16(a, b, c, 0, 0, 0)
__device__ __forceinline__ bf16x8 tr_frag2(LAS unsigned char* img, int lane, int c, int ks) {
    const unsigned g = lane >> 4, q = (lane & 15) >> 2, p = lane & 3;
    const s16x4 a = __builtin_amdgcn_ds_read_tr16_b64_v4i16((LAS s16x4*)(img + offb(32 * ks + 4 * g + q, 2 * c + (p >> 1)) + 8 * (p & 1)));
    const s16x4 b = __builtin_amdgcn_ds_read_tr16_b64_v4i16((LAS s16x4*)(img + offb(32 * ks + 16 + 4 * g + q, 2 * c + (p >> 1)) + 8 * (p & 1)));
    bf16x8 r; r[0] = a[0]; r[1] = a[1]; r[2] = a[2]; r[3] = a[3]; r[4] = b[0]; r[5] = b[1]; r[6] = b[2]; r[7] = b[3]; return r;
}
__device__ __forceinline__ void glds16_asm(const void* gsrc, unsigned lds_dst) { unsigned keep;
    asm volatile("s_mov_b32 %0, m0\n\ts_mov_b32 m0, %2\n\ts_nop 0\n\tglobal_load_lds_dwordx4 %1, off\n\ts_mov_b32 m0, %0" : "=&s"(keep) : "v"(gsrc), "s"(lds_dst) : "memory"); }
#define GLDS16(gsrc, ldst) glds16_asm((const void*)(gsrc), (unsigned)(unsigned long)(LAS unsigned char*)(ldst))
#define RAW_BAR() do { asm volatile("s_waitcnt lgkmcnt(0)" ::: "memory"); __builtin_amdgcn_s_barrier(); asm volatile("" ::: "memory"); } while (0)
__device__ __forceinline__ void retention_unit(Frame& F, int b, int h) {
    LAS unsigned char* KI = F.lds; LAS unsigned char* VI0 = F.lds + 32768; LAS unsigned char* SI = F.lds + 98304;
    const int lane = lane_id(), w = F.wave, l15 = lane & 15, lg = lane >> 4;
    const int rtw = (w < 4) ? w : 11 - w;
    const float gC = expf(128.0f * log1pf(-exp2f(-5.0f - (float)h)));
    LAS float* GN = (LAS float*)(F.lds + 131072);
    if (w < 2) GN[w * 64 + lane] = F.ret_norm_g[h * HD + w * 64 + lane];
    const bf16_t* proj = (const bf16_t*)(F.ws + WS_R2);
    bf16_t* mix = (bf16_t*)(F.ws + WS_R1);
    f32x4 accS[8];
#pragma unroll
    for (int c = 0; c < 8; ++c) accS[c] = (f32x4){0.f, 0.f, 0.f, 0.f};
    const int il = 16 * rtw + l15;
    unsigned dsrc[4];
#pragma unroll
    for (int i = 0; i < 4; ++i) { const unsigned row = 16 * w + 4 * i + lg; dsrc[i] = row * (HD * 2) + 16u * ((unsigned)l15 ^ (((row & 3u) << 2) | ((row >> 2) & 3u))); }
    const char* kbase = (const char*)(proj + ((size_t)(8 + h) * T + b * SEQ) * HD);
    const size_t vofs = (size_t)8 * T * HD * 2;
    const bf16_t* qbase = proj + ((size_t)h * T + b * SEQ + il) * HD + 8 * lg;
#define RET_DMA(img, base) do { _Pragma("unroll") for (int _i = 0; _i < 4; ++_i) GLDS16((base) + dsrc[_i], (img) + 4096 * w + 1024 * _i); } while (0)
    RET_DMA(KI, kbase); RET_DMA(VI0, kbase + vofs);
    u32x4 qn[4]; u32x2 ov[8];
#pragma unroll
    for (int s = 0; s < 4; ++s) qn[s] = *(const u32x4*)(qbase + 32 * s);
#pragma unroll
    for (int c = 0; c < 8; ++c) *(LAS u32x2*)(SI + offb(16 * c + l15, 2 * w + (lane >> 5)) + 8 * (lg & 1)) = (u32x2){0u, 0u};
#pragma unroll 1
    for (int n = 0; n < NCHUNK; ++n) {
        const int tok0 = b * SEQ + n * CHK;
        LAS unsigned char* VI = VI0 + (n & 1) * 32768;
        asm volatile("s_waitcnt vmcnt(0)" ::: "memory"); RAW_BAR();
        bf16x8 qf[4];
#pragma unroll
        for (int s = 0; s < 4; ++s) qf[s] = __builtin_bit_cast(bf16x8, qn[s]);
        const char* nk = kbase + (size_t)(n + 1) * (CHK * HD * 2);
        if (n + 1 < NCHUNK) {
            RET_DMA(VI0 + ((n + 1) & 1) * 32768, nk + vofs);
#pragma unroll
            for (int s = 0; s < 4; ++s) qn[s] = *(const u32x4*)(qbase + (size_t)(n + 1) * (CHK * HD) + 32 * s);
        }
        if (n > 0) { bf16_t* prow = mix + (size_t)(tok0 - CHK + il) * D + h * HD + 4 * lg;
#pragma unroll
            for (int c = 0; c < 8; ++c) *(u32x2*)(prow + 16 * c) = ov[c]; }
        u32x2 gv[8];
        { const bf16_t* grow = proj + ((size_t)(24 + h) * T + tok0 + il) * HD + 4 * lg;
#pragma unroll
          for (int c = 0; c < 8; ++c) gv[c] = *(const u32x2*)(grow + 16 * c); }
        bf16x8 pf[4];
#pragma unroll
        for (int s = 0; s < 4; ++s) {
            f32x4 sc[2];
#pragma unroll
            for (int t = 0; t < 2; ++t) { const int jt = 2 * s + t; sc[t] = (f32x4){0.f, 0.f, 0.f, 0.f};
#pragma unroll
                for (int k = 0; k < 4; ++k) sc[t] = MFMA16(row_frag(KI, lane, jt, k), qf[k], sc[t]);
                const int j0 = 16 * jt + 4 * lg;
#pragma unroll
                for (int r = 0; r < 4; ++r) sc[t][r] = (j0 + r > il) ? 0.f : sc[t][r]; }
            const u32x4 pw = (u32x4){pk2(sc[0][0], sc[0][1]), pk2(sc[0][2], sc[0][3]), pk2(sc[1][0], sc[1][1]), pk2(sc[1][2], sc[1][3])};
            pf[s] = __builtin_bit_cast(bf16x8, pw);
        }
        bf16x8 ktf[4];
#pragma unroll
        for (int s = 0; s < 4; ++s) ktf[s] = tr_frag2(KI, lane, w, s);
        RAW_BAR();
        if (n + 1 < NCHUNK) RET_DMA(KI, nk);
        f32x4 accO[8];
        bf16x8 vfr[2][4], sfr[2][4];
#pragma unroll
        for (int s = 0; s < 4; ++s) { vfr[0][s] = tr_frag2(VI, lane, 0, s); sfr[0][s] = row_frag(SI, lane, 0, s); }
#pragma unroll
        for (int c = 0; c < 8; ++c) {
            if (c < 7) {
#pragma unroll
                for (int s = 0; s < 4; ++s) { vfr[(c + 1) & 1][s] = tr_frag2(VI, lane, c + 1, s); sfr[(c + 1) & 1][s] = row_frag(SI, lane, c + 1, s); } }
            f32x4 o = (f32x4){0.f, 0.f, 0.f, 0.f};
#pragma unroll
            for (int s = 0; s < 4; ++s) o = MFMA16(vfr[c & 1][s], pf[s], o);
#pragma unroll
            for (int s = 0; s < 4; ++s) o = MFMA16(sfr[c & 1][s], qf[s], o);
            accO[c] = o;
#pragma unroll
            for (int s = 0; s < 4; ++s) accS[c] = MFMA16(ktf[s], vfr[c & 1][s], accS[c]);
            __builtin_amdgcn_sched_barrier(0);
        }
        {
            float s1 = 0.f;
#pragma unroll
            for (int c = 0; c < 8; ++c) s1 += (accO[c][0] + accO[c][1]) + (accO[c][2] + accO[c][3]);
            s1 += __shfl_xor(s1, 16); s1 += __shfl_xor(s1, 32);
            const float mu = s1 * (1.0f / 128.0f); float s2 = 0.f;
#pragma unroll
            for (int c = 0; c < 8; ++c) { const f32x4 d = accO[c] - mu; s2 += (d[0] * d[0] + d[1] * d[1]) + (d[2] * d[2] + d[3] * d[3]); }
            s2 += __shfl_xor(s2, 16); s2 += __shfl_xor(s2, 32);
            const float rstd = 1.0f / sqrtf(s2 * (1.0f / 128.0f) + EPS);
#pragma unroll
            for (int c = 0; c < 8; ++c) {
                const f32x4 gain = *(const LAS f32x4*)(GN + 16 * c + 4 * lg);
                const float g[4] = {bflo(gv[c].x), bfhi(gv[c].x), bflo(gv[c].y), bfhi(gv[c].y)}; float o[4];
#pragma unroll
                for (int r = 0; r < 4; ++r) o[r] = (accO[c][r] - mu) * rstd * gain[r] * g[r];
                ov[c].x = pk2(o[0], o[1]); ov[c].y = pk2(o[2], o[3]);
            }
        }
        RAW_BAR();
#pragma unroll
        for (int c = 0; c < 8; ++c) { accS[c] = accS[c] * gC; u32x2 wv; wv.x = pk2(accS[c][0], accS[c][1]); wv.y = pk2(accS[c][2], accS[c][3]);
            *(LAS u32x2*)(SI + offb(16 * c + l15, 2 * w + (lane >> 5)) + 8 * (lg & 1)) = wv; }
    }
    { bf16_t* prow = mix + (size_t)(b * SEQ + (NCHUNK - 1) * CHK + il) * D + h * HD + 4 * lg;
#pragma unroll
      for (int c = 0; c < 8; ++c) *(u32x2*)(prow + 16 * c) = ov[c]; }
    asm volatile("s_waitcnt vmcnt(0)" ::: "memory"); RAW_BAR();
#undef RET_DMA
}
template <int N> __device__ __forceinline__ float dpp_shr(float old, float src) {
    return __builtin_bit_cast(float, __builtin_amdgcn_update_dpp(__builtin_bit_cast(int, old), __builtin_bit_cast(int, src), 0x110 + N, 0xf, 0xf, false));
}
__device__ __forceinline__ float sigmoidf_(float x) { return __builtin_amdgcn_rcpf(1.0f + __expf(-x)); }
__device__ __forceinline__ float gelu_tanh(float z) { const float y2 = 1.5957691216057308f * (z + 0.044715f * z * z * z); return z * __builtin_amdgcn_rcpf(1.0f + __expf(-y2)); }
template <int N> __device__ __forceinline__ float dpp_shr0(float src) {
    return __builtin_bit_cast(float, __builtin_amdgcn_update_dpp(0, __builtin_bit_cast(int, src), 0x110 + N, 0xf, 0xf, true));
}
__device__ __forceinline__ float row_prefix_sum(float v) { v += dpp_shr0<1>(v); v += dpp_shr0<2>(v); v += dpp_shr0<4>(v); v += dpp_shr0<8>(v); return v; }
__device__ __forceinline__ void lru_unit(Frame& F, int b, int nb) {
    constexpr int RAWB = 132 * 256;
    LAS unsigned char* UI0 = F.lds; LAS unsigned char* RAW0 = F.lds + 65536; LAS float* PART = (LAS float*)(F.lds + 65536 + 2 * RAWB); LAS float* CW = PART + 1024;
    static_assert(65536 + 2 * RAWB + 4096 + 2560 <= LDSCTL_OFF, "LRU scratch below the LDS control words");
    const int lane = lane_id(), w = F.wave, tid = w * 64 + lane, l15 = lane & 15, lg = lane >> 4, cb = 128 * nb;
    const bf16_t* proj = (const bf16_t*)(F.ws + WS_R2);
    bf16_t* mix = (bf16_t*)(F.ws + WS_R1);
    const char* zline = (const char*)(F.ws + WS_CTL + 61440);
    const char* ubase = (const char*)(proj + ((size_t)(32 + nb) * T + b * SEQ) * HD);
#define LRU_DMA(n_, buf) do { _Pragma("unroll") for (int _i = 0; _i < 5; ++_i) { if (_i < 4 || w == 0) { const int _r = (_i < 4 ? 16 * w + 4 * _i : 128) + lg; int _pos = 128 * (n_) - 3 + _r; _pos = _pos > SEQ - 1 ? SEQ - 1 : _pos; \
        const char* _src = _pos < 0 ? zline + 16 * l15 : ubase + (size_t)_pos * (HD * 2) + 16 * (l15 ^ (_r & 15)); GLDS16(_src, (buf) + 256 * (_i < 4 ? 16 * w + 4 * _i : 128)); } } } while (0)
    const int sj = tid >> 2, sc0 = tid & 3;
#define LRU_CONV(RAW, UI) do { _Pragma("unroll") for (int q = 0; q < 4; ++q) { const int ch = sc0 + 4 * q; float a8[8]; \
            { const f32x4 b0 = *(const LAS f32x4*)(CW + 512 + 8 * ch), b1 = *(const LAS f32x4*)(CW + 512 + 8 * ch + 4); a8[0] = b0.x; a8[1] = b0.y; a8[2] = b0.z; a8[3] = b0.w; a8[4] = b1.x; a8[5] = b1.y; a8[6] = b1.z; a8[7] = b1.w; } \
            _Pragma("unroll") for (int k = 0; k < 4; ++k) { const int rr = sj + k; const u32x4 uv = *(const LAS u32x4*)((RAW) + 256 * rr + 16 * (ch ^ (rr & 15))); \
                const f32x4 w0 = *(const LAS f32x4*)(CW + k * 128 + 8 * ch), w1 = *(const LAS f32x4*)(CW + k * 128 + 8 * ch + 4); \
                a8[0] += w0.x * bflo(uv.x); a8[1] += w0.y * bfhi(uv.x); a8[2] += w0.z * bflo(uv.y); a8[3] += w0.w * bfhi(uv.y); \
                a8[4] += w1.x * bflo(uv.z); a8[5] += w1.y * bfhi(uv.z); a8[6] += w1.z * bflo(uv.w); a8[7] += w1.w * bfhi(uv.w); } \
            u32x4 o; o.x = pk2(a8[0], a8[1]); o.y = pk2(a8[2], a8[3]); o.z = pk2(a8[4], a8[5]); o.w = pk2(a8[6], a8[7]); \
            *(LAS u32x4*)((UI) + offb(sj, ch)) = o; } } while (0)
    LRU_DMA(0, RAW0);
    for (int i = tid; i < 640; i += NTHREADS) CW[i] = (i < 512) ? F.conv_w[(i >> 7) * 1024 + cb + (i & 127)] : F.conv_b[cb + i - 512];
    bf16x8 wrf[4], wif[4];
#pragma unroll
    for (int s = 0; s < 4; ++s)
#pragma unroll
        for (int jj = 0; jj < 8; ++jj) { const int c = 32 * s + 8 * lg + jj; const size_t o = ((size_t)(nb * 128 + c)) * 128 + 16 * w + l15;
            wrf[s][jj] = (short)f2bf(F.w_rg[o]); wif[s][jj] = (short)f2bf(F.w_ig[o]); }
    const int d0 = cb + 16 * w + 4 * lg;
    const f32x4 brg = *(const f32x4*)(F.b_rg + d0), big = *(const f32x4*)(F.b_ig + d0), lam = *(const f32x4*)(F.lam + d0), ng = *(const f32x4*)(F.lru_norm_g + d0);
    f32x4 spl;
#pragma unroll
    for (int r = 0; r < 4; ++r) spl[r] = -8.0f * log1pf(expf(-lam[r])) * 1.4426950408889634f;
    f32x4 Hc = (f32x4){0.f, 0.f, 0.f, 0.f};
    const bf16_t* zbase = proj + ((size_t)(40 + nb) * T + b * SEQ + l15) * HD + 16 * w + 4 * lg;
    bf16_t* obase = mix + (size_t)(b * SEQ + l15) * D + 1024 + d0;
    asm volatile("s_waitcnt vmcnt(0)" ::: "memory"); RAW_BAR();
    LRU_DMA(1, RAW0 + RAWB);
    LRU_CONV(RAW0, UI0);
    u32x2 zv[8];
#pragma unroll
    for (int tt = 0; tt < 8; ++tt) zv[tt] = *(const u32x2*)(zbase + (size_t)(16 * tt) * HD);
    RAW_BAR();
#pragma unroll 1
    for (int n = 0; n < NCHUNK; ++n) {
        LAS unsigned char* UI = UI0 + (n & 1) * 32768;
        f32x4 hv[8]; float ssq[8];
        f32x4 aR = (f32x4){0.f, 0.f, 0.f, 0.f}, aI = (f32x4){0.f, 0.f, 0.f, 0.f};
#pragma unroll
        for (int s = 0; s < 4; ++s) { const bf16x8 uf = row_frag(UI, lane, 0, s); aR = MFMA16(wrf[s], uf, aR); aI = MFMA16(wif[s], uf, aI); }
#pragma unroll
        for (int tt = 0; tt < 8; ++tt) {
            f32x4 aRn = (f32x4){0.f, 0.f, 0.f, 0.f}, aIn = (f32x4){0.f, 0.f, 0.f, 0.f};
            if (tt < 7) {
#pragma unroll
                for (int s = 0; s < 4; ++s) { const bf16x8 uf = row_frag(UI, lane, tt + 1, s); aRn = MFMA16(wrf[s], uf, aRn); aIn = MFMA16(wif[s], uf, aIn); } }
            const int dl = 16 * w + 4 * lg;
            const u32x2 ucv = *(const LAS u32x2*)(UI + offb(16 * tt + l15, dl >> 3) + (dl & 7) * 2);
            const f32x4 uc = (f32x4){bflo(ucv.x), bfhi(ucv.x), bflo(ucv.y), bfhi(ucv.y)};
            const f32x4 xr = (aR + brg) * -1.4426950408889634f, xi = (aI + big) * -1.4426950408889634f;
            f32x4 er, ei;
#pragma unroll
            for (int r = 0; r < 4; ++r) { er[r] = __builtin_amdgcn_exp2f(xr[r]); ei[r] = __builtin_amdgcn_exp2f(xi[r]); }
            er = er + 1.0f; ei = ei + 1.0f;
            f32x4 rg, ig;
#pragma unroll
            for (int r = 0; r < 4; ++r) { rg[r] = __builtin_amdgcn_rcpf(er[r]); ig[r] = __builtin_amdgcn_rcpf(ei[r]); }
            const f32x4 la = spl * rg;
            f32x4 A, B;
#pragma unroll
            for (int r = 0; r < 4; ++r) A[r] = __builtin_amdgcn_exp2f(la[r]);
            { f32x4 om = 1.0f - A * A;
#pragma unroll
              for (int r = 0; r < 4; ++r) om[r] = __builtin_amdgcn_sqrtf(fmaxf(om[r], 0.f));
              B = om * ig * uc; }
#define LRU_STEP(N) do { _Pragma("unroll") for (int r = 0; r < 4; ++r) { const float Ap = dpp_shr<N>(1.0f, A[r]), Bp = dpp_shr0<N>(B[r]); B[r] = A[r] * Bp + B[r]; A[r] = A[r] * Ap; } } while (0)
            LRU_STEP(1); LRU_STEP(2); LRU_STEP(4); LRU_STEP(8);
#undef LRU_STEP
            const f32x4 hh = A * Hc + B;
            float q = 0.f;
#pragma unroll
            for (int r = 0; r < 4; ++r) { Hc[r] = __shfl(hh[r], (lane & 48) | 15); q += hh[r] * hh[r]; }
            hv[tt] = hh;
            q += __shfl_xor(q, 16); q += __shfl_xor(q, 32);
            ssq[tt] = q; aR = aRn; aI = aIn;
            __builtin_amdgcn_sched_barrier(0);
        }
        if (lg == 0) {
#pragma unroll
            for (int tt = 0; tt < 8; ++tt) PART[w * 128 + 16 * tt + l15] = ssq[tt];
        }
        asm volatile("s_waitcnt vmcnt(0)" ::: "memory"); RAW_BAR();
#pragma unroll
        for (int tt = 0; tt < 8; ++tt) {
            const int tk = 16 * tt + l15; float tot = 0.f;
#pragma unroll
            for (int ww = 0; ww < 8; ++ww) tot += PART[ww * 128 + tk];
            const float rs = __builtin_amdgcn_rsqf(tot * (1.0f / 128.0f) + EPS);
            const float z[4] = {bflo(zv[tt].x), bfhi(zv[tt].x), bflo(zv[tt].y), bfhi(zv[tt].y)}; float o[4];
#pragma unroll
            for (int r = 0; r < 4; ++r) o[r] = hv[tt][r] * rs * ng[r] * z[r];
            u32x2 wv; wv.x = pk2(o[0], o[1]); wv.y = pk2(o[2], o[3]);
            *(u32x2*)(obase + (size_t)(n * CHK + 16 * tt) * D) = wv;
        }
        if (n + 1 < NCHUNK) {
            LRU_CONV(RAW0 + ((n + 1) & 1) * RAWB, UI0 + ((n + 1) & 1) * 32768);
#pragma unroll
            for (int tt = 0; tt < 8; ++tt) zv[tt] = *(const u32x2*)(zbase + (size_t)((n + 1) * CHK + 16 * tt) * HD);
        }
        RAW_BAR();
        if (n + 2 < NCHUNK) LRU_DMA(n + 2, RAW0 + (n & 1) * RAWB);
    }
    asm volatile("s_waitcnt vmcnt(0)" ::: "memory"); RAW_BAR();
#undef LRU_DMA
#undef LRU_CONV
}
__device__ __forceinline__ void router_phase(Frame& F) {
    const bf16_t* dl = (const bf16_t*)(F.ws + WS_X1); bf16_t* x1b = (bf16_t*)(F.ws + WS_X1 + 128 * MiB);
    unsigned char* h2 = F.ws + WS_H2;
    const bf16_t* whi = (const bf16_t*)(F.ws + WS_WGT);
    int* tokl = (int*)(F.ws + WS_TOK); float* rss = (float*)(F.ws + WS_RSS); u32x2* apk = (u32x2*)(F.ws + WS_APK); f32x2* aw = (f32x2*)(F.ws + WS_AW);
    const int w = F.wave, lane = lane_id(), l15 = lane & 15, lg = lane >> 4;
    LAS float* LG = (LAS float*)(F.lds + 65536 + w * 4096);
    LAS unsigned char* WB0 = F.lds;
    unsigned wsrc[3];
#pragma unroll
    for (int i = 0; i < 3; ++i) { const unsigned row = 4 * (3 * w + i) + lg; wsrc[i] = row * (D * 2) + 16u * ((unsigned)l15 ^ (row & 15u)); }
#define RT_DMA(kc, buf) do { _Pragma("unroll") for (int _i = 0; _i < 3; ++_i) GLDS16((const char*)whi + wsrc[_i] + (kc) * 256, (buf) + 1024 * (3 * w + _i)); } while (0)
    for (int base = F.vcu * NWAVES; base < T / 16; base += F.G * NWAVES) {
        const int item = base + w; const int r0 = item * 16;
        const float* xr = F.x + (size_t)(r0 + l15) * D + 8 * lg; unsigned char* hr = h2 + (size_t)(r0 + l15) * D + 8 * lg;
        const bf16_t* dr = dl + (size_t)(r0 + l15) * D + 8 * lg; bf16_t* xo = x1b + (size_t)(r0 + l15) * D + 8 * lg;
        f32x4 acc[3]; float ss = 0.f;
#pragma unroll
        for (int ct = 0; ct < 3; ++ct) acc[ct] = (f32x4){0.f, 0.f, 0.f, 0.f};
        f32x4 xa[8]; u32x4 da[4];
        RT_DMA(0, WB0);
#pragma unroll 1
        for (int kc = 0; kc < 16; ++kc) {
            LAS unsigned char* WB = WB0 + (kc & 1) * 24576;
            asm volatile("s_waitcnt vmcnt(0)" ::: "memory"); RAW_BAR();
            if (kc + 1 < 16) { RT_DMA(kc + 1, WB0 + ((kc + 1) & 1) * 24576); }
#pragma unroll
            for (int j = 0; j < 4; ++j) { xa[2 * j] = *(const f32x4*)(xr + 128 * kc + 32 * j); xa[2 * j + 1] = *(const f32x4*)(xr + 128 * kc + 32 * j + 4); da[j] = *(const u32x4*)(dr + 128 * kc + 32 * j); }
#pragma unroll
            for (int j = 0; j < 4; ++j) {
                const f32x4 a0 = xa[2 * j] + (f32x4){bflo(da[j].x), bfhi(da[j].x), bflo(da[j].y), bfhi(da[j].y)}, a1 = xa[2 * j + 1] + (f32x4){bflo(da[j].z), bfhi(da[j].z), bflo(da[j].w), bfhi(da[j].w)};
                ss += (a0.x * a0.x + a0.y * a0.y) + (a0.z * a0.z + a0.w * a0.w) + (a1.x * a1.x + a1.y * a1.y) + (a1.z * a1.z + a1.w * a1.w);
                const float av[8] = {a0.x, a0.y, a0.z, a0.w, a1.x, a1.y, a1.z, a1.w};
                unsigned hw[4], lw[4];
#pragma unroll
                for (int i = 0; i < 4; ++i) { hw[i] = pk2(av[2 * i], av[2 * i + 1]); lw[i] = pk2(av[2 * i] - bflo(hw[i]), av[2 * i + 1] - bfhi(hw[i])); }
                const u32x4 xh4 = (u32x4){hw[0], hw[1], hw[2], hw[3]}, xl4 = (u32x4){lw[0], lw[1], lw[2], lw[3]};
                *(u32x2*)(hr + 128 * kc + 32 * j) = (u32x2){pk4_fp8(av[0], av[1], av[2], av[3]), pk4_fp8(av[4], av[5], av[6], av[7])};
                *(u32x4*)(xo + 128 * kc + 32 * j) = xh4;
                const bf16x8 xh = __builtin_bit_cast(bf16x8, xh4), xl = __builtin_bit_cast(bf16x8, xl4);
#pragma unroll
                for (int ct = 0; ct < 3; ++ct) { const unsigned rh = 16 * ct + l15, rl = 48 + 16 * ct + l15;
                    const bf16x8 bh = *(const LAS bf16x8*)(WB + 256 * rh + 16 * ((4 * j + lg) ^ (rh & 15))), bl = *(const LAS bf16x8*)(WB + 256 * rl + 16 * ((4 * j + lg) ^ (rl & 15)));
                    acc[ct] = MFMA16(xh, bh, acc[ct]); acc[ct] = MFMA16(xh, bl, acc[ct]); acc[ct] = MFMA16(xl, bh, acc[ct]); }
            }
        }
        ss += __shfl_xor(ss, 16); ss += __shfl_xor(ss, 32);
#pragma unroll
        for (int ct = 0; ct < 3; ++ct)
#pragma unroll
            for (int r = 0; r < 4; ++r) LG[(4 * lg + r) * 48 + 16 * ct + l15] = acc[ct][r];
        LDS_WAIT();
        if (lane < 16) {
            const int t = r0 + lane; const float rs = 1.0f / sqrtf(ss * (1.0f / D) + EPS);
            const LAS float* L = LG + lane * 48;
            float gl[4];
#pragma unroll
            for (int j = 0; j < 4; ++j) gl[j] = L[j] * rs + F.b_group[j];
            int g = 0; float gm = gl[0];
#pragma unroll
            for (int j = 1; j < 4; ++j) if (gl[j] > gm) { gm = gl[j]; g = j; }
            float den = 0.f;
#pragma unroll
            for (int j = 0; j < 4; ++j) den += expf(gl[j] - gm);
            const float gp = 1.0f / den;
            float v[8];
#pragma unroll
            for (int q = 0; q < 8; ++q) v[q] = L[4 + 8 * g + q] * rs + F.b_router[8 * g + q];
            int ia = 0; float va = v[0];
#pragma unroll
            for (int q = 1; q < 8; ++q) if (v[q] > va) { va = v[q]; ia = q; }
            int ib = -1; float vb = -3.0e38f;
#pragma unroll
            for (int q = 0; q < 8; ++q) if (q != ia && v[q] > vb) { vb = v[q]; ib = q; }
            const float wa = 1.0f / (1.0f + expf(vb - va)), wb = 1.0f - wa;
            const int ea = 8 * g + ia, eb = 8 * g + ib;
            const unsigned ra = atomicAdd(F.ctl + CW_CNT + 64 * ea, 1u), rb = atomicAdd(F.ctl + CW_CNT + 64 * eb, 1u);
            tokl[(size_t)ea * CAP + ra] = t; tokl[(size_t)eb * CAP + rb] = t; rss[(size_t)ea * CAP + ra] = rs; rss[(size_t)eb * CAP + rb] = rs;
            apk[t] = (u32x2){((unsigned)ea << 16) | ra, ((unsigned)eb << 16) | rb}; aw[t] = (f32x2){wa * gp, wb * gp};
        }
        LDS_WAIT();
    }
#undef RT_DMA
}
__device__ __forceinline__ void compute_tile_start(Frame& F) {
    LAS int* ts = (LAS int*)(F.lds + TS_OFF); LAS int* cn = (LAS int*)(F.lds + CN_OFF);
    const int tid = F.wave * 64 + lane_id();
    if (tid < NE) { int c = (int)__hip_atomic_load(F.ctl + CW_CNT + 64 * tid, __ATOMIC_RELAXED, __HIP_MEMORY_SCOPE_AGENT); cn[tid] = c < 0 ? 0 : (c > CAP ? CAP : c); }
    __syncthreads();
    if (tid == 0) { int a = 0; for (int e = 0; e < NE; ++e) { ts[e] = a; a += (cn[e] + 255) >> 8; } ts[NE] = a > MAXRT ? MAXRT : a; }
    __syncthreads();
    if (tid < MAXRT) { int e = 0; for (int j = 1; j < NE; ++j) e = (ts[j] <= tid) ? j : e; ((LAS unsigned char*)(F.lds + RE_OFF))[tid] = (unsigned char)e; }
    __syncthreads();
}
__device__ __forceinline__ void combine_phase(Frame& F) {
    const bf16_t* x1 = (const bf16_t*)(F.ws + WS_X1 + 128 * MiB); const unsigned char* Y = F.ws + WS_Y;
    const u32x2* apk = (const u32x2*)(F.ws + WS_APK); const f32x2* aw = (const f32x2*)(F.ws + WS_AW);
    const LAS int* ts = (const LAS int*)(F.lds + TS_OFF);
    const int gw = F.vcu * NWAVES + F.wave, NGW = F.G * NWAVES, lane = lane_id();
    int m = gw; if (m >= T) return;
    u32x2 pk[2]; f32x2 ww[2];
#pragma unroll
    for (int r = 0; r < 2; ++r) { const int mr = m + r * NGW < T ? m + r * NGW : m; pk[r] = apk[mr]; ww[r] = aw[mr]; }
    f32x4 gfin[4][2];
    { const float* gf = F.norm_final_g + 8 * lane;
#pragma unroll
      for (int j = 0; j < 4; ++j) { gfin[j][0] = *(const f32x4*)(gf + 512 * j); gfin[j][1] = *(const f32x4*)(gf + 512 * j + 4); } }
    for (; m < T; m += 2 * NGW) {
        u32x4 xa[2][4]; u32x2 p[2][4], q[2][4]; float w0[2], w1[2]; int mr[2];
#pragma unroll
        for (int r = 0; r < 2; ++r) {
            mr[r] = m + r * NGW < T ? m + r * NGW : m;
            const int e0 = (pk[r].x >> 16) & 31, e1 = (pk[r].y >> 16) & 31;
            const size_t row0 = (size_t)256 * ts[e0] + (pk[r].x & 0xffffu), row1 = (size_t)256 * ts[e1] + (pk[r].y & 0xffffu);
            w0[r] = ww[r].x * (1.0f / SC_Y); w1[r] = ww[r].y * (1.0f / SC_Y);
            const bf16_t* xr = x1 + (size_t)mr[r] * D + 8 * lane; const unsigned char* y0 = Y + row0 * D + 8 * lane; const unsigned char* y1 = Y + row1 * D + 8 * lane;
#pragma unroll
            for (int j = 0; j < 4; ++j) { xa[r][j] = *(const u32x4*)(xr + 512 * j); p[r][j] = *(const u32x2*)(y0 + 512 * j); q[r][j] = *(const u32x2*)(y1 + 512 * j); }
        }
#pragma unroll
        for (int r = 0; r < 2; ++r) { const int mn = m + (2 + r) * NGW < T ? m + (2 + r) * NGW : mr[r]; pk[r] = apk[mn]; ww[r] = aw[mn]; }
#pragma unroll
        for (int r = 0; r < 2; ++r) {
            float v[4][8]; float ss = 0.f;
#pragma unroll
            for (int j = 0; j < 4; ++j) {
                const f32x2 p0 = __builtin_amdgcn_cvt_pk_f32_fp8((int)p[r][j].x, false), p1 = __builtin_amdgcn_cvt_pk_f32_fp8((int)p[r][j].x, true), p2 = __builtin_amdgcn_cvt_pk_f32_fp8((int)p[r][j].y, false), p3 = __builtin_amdgcn_cvt_pk_f32_fp8((int)p[r][j].y, true);
                const f32x2 q0 = __builtin_amdgcn_cvt_pk_f32_fp8((int)q[r][j].x, false), q1 = __builtin_amdgcn_cvt_pk_f32_fp8((int)q[r][j].x, true), q2 = __builtin_amdgcn_cvt_pk_f32_fp8((int)q[r][j].y, false), q3 = __builtin_amdgcn_cvt_pk_f32_fp8((int)q[r][j].y, true);
                const u32x4 xw = xa[r][j];
                v[j][0] = bflo(xw.x) + w0[r] * p0.x + w1[r] * q0.x; v[j][1] = bfhi(xw.x) + w0[r] * p0.y + w1[r] * q0.y;
                v[j][2] = bflo(xw.y) + w0[r] * p1.x + w1[r] * q1.x; v[j][3] = bfhi(xw.y) + w0[r] * p1.y + w1[r] * q1.y;
                v[j][4] = bflo(xw.z) + w0[r] * p2.x + w1[r] * q2.x; v[j][5] = bfhi(xw.z) + w0[r] * p2.y + w1[r] * q2.y;
                v[j][6] = bflo(xw.w) + w0[r] * p3.x + w1[r] * q3.x; v[j][7] = bfhi(xw.w) + w0[r] * p3.y + w1[r] * q3.y;
#pragma unroll
                for (int i = 0; i < 8; ++i) ss += v[j][i] * v[j][i];
            }
            const float rs = 1.0f / sqrtf(wave_sum(ss) * (1.0f / D) + EPS);
            if (r == 0 || m + NGW < T) {
                float* orow = F.out + (size_t)mr[r] * D + 8 * lane;
#pragma unroll
                for (int j = 0; j < 4; ++j) { const f32x4 g0 = gfin[j][0], g1 = gfin[j][1];
                    *(f32x4*)(orow + 512 * j) = (f32x4){v[j][0] * rs * g0.x, v[j][1] * rs * g0.y, v[j][2] * rs * g0.z, v[j][3] * rs * g0.w};
                    *(f32x4*)(orow + 512 * j + 4) = (f32x4){v[j][4] * rs * g1.x, v[j][5] * rs * g1.y, v[j][6] * rs * g1.z, v[j][7] * rs * g1.w}; }
            }
        }
    }
}
__device__ __forceinline__ void final_norm_only(Frame& F, const float* src) {
    const int gw = F.vcu * NWAVES + F.wave, NGW = F.G * NWAVES, lane = lane_id();
    for (int m = gw; m < T; m += NGW) {
        const f32x4* xr = (const f32x4*)(src + (size_t)m * D) + lane; const f32x4* gr = (const f32x4*)F.norm_final_g + lane;
        f32x4 v[8]; float s = 0.f;
#pragma unroll
        for (int j = 0; j < 8; ++j) { v[j] = xr[64 * j]; s += (v[j].x * v[j].x + v[j].y * v[j].y) + (v[j].z * v[j].z + v[j].w * v[j].w); }
        const float rs = 1.0f / sqrtf(wave_sum(s) * (1.0f / D) + EPS);
        f32x4* o = (f32x4*)(F.out + (size_t)m * D) + lane;
#pragma unroll
        for (int j = 0; j < 8; ++j) { const f32x4 g = gr[64 * j]; o[64 * j] = (f32x4){v[j].x * rs * g.x, v[j].y * rs * g.y, v[j].z * rs * g.z, v[j].w * rs * g.w}; }
    }
}

struct Args { const float* in[22]; float* out; unsigned char* ws; int ph_lo, ph_hi, li, pad; };
__global__ void __launch_bounds__(NTHREADS, 2) hymba_fwd(Args args) {
    extern __shared__ __attribute__((aligned(16))) unsigned char lds[];
    Frame F;
    F.lds = (LAS unsigned char*)lds;
    F.MISC = (volatile LAS unsigned*)(F.lds + MISC_OFF);
    F.wave = __builtin_amdgcn_readfirstlane(threadIdx.x >> 6);
    F.G = gridDim.x; { const int bx = blockIdx.x; F.vcu = (F.G % 8 == 0) ? (bx % 8) * (F.G / 8) + bx / 8 : bx; }
    unsigned char* ws = args.ws; F.ws = ws; F.ctl = (unsigned*)(ws + WS_CTL); F.out = args.out;
    F.x = args.in[0]; F.norm_mix_g = args.in[1]; F.w_in = args.in[2]; F.ret_norm_g = args.in[3]; F.conv_w = args.in[4]; F.conv_b = args.in[5]; F.w_rg = args.in[6]; F.b_rg = args.in[7];
    F.w_ig = args.in[8]; F.b_ig = args.in[9]; F.lam = args.in[10]; F.lru_norm_g = args.in[11]; F.w_out = args.in[12]; F.norm_ffn_g = args.in[13]; F.w_group = args.in[14]; F.b_group = args.in[15];
    F.w_router = args.in[16]; F.b_router = args.in[17]; F.w_gate = args.in[18]; F.w_up = args.in[19]; F.w_down = args.in[20]; F.norm_final_g = args.in[21];
    for (int u = threadIdx.x; u < (LDS_BYTES - LDSCTL_OFF) / 4; u += NTHREADS) ((LAS unsigned*)(F.lds + LDSCTL_OFF))[u] = 0u;
    __syncthreads();
    const int lo = args.ph_lo, hi = args.ph_hi;
    XcdBarrier bar; bar.bar = F.ctl + CW_BAR; bar.x = 0; bar.st = nullptr;
    if (hi - lo > 1) bar = xcd_barrier_post(F.ctl + CW_BAR, F.MISC + 8);
#define IN(k) (lo <= (k) && (k) < hi)
#define BOTH(k) (IN(k) && IN((k) + 1))
#define GRID_BAR() xcd_barrier(bar)

    if (IN(0)) { p0_prologue(F); if (BOTH(0)) GRID_BAR(); }
    if (IN(1)) {
        const int G1 = (F.G > 2 * NCONV) ? F.G - NCONV : F.G;
        if ((int)blockIdx.x < G1) {
        pg8::DenseSched<D, T / 256, PROJ / 256, true, true> S; S.so.init(T, PROJ, G1, (int)blockIdx.x); S.A = (const char*)(ws + WS_R1); S.B = (const char*)(ws + WS_WIN);
        pg8::EpiProj E{(bf16_t*)(ws + WS_R2), PROJ, (const float*)(ws + WS_ROPE), (const float*)(ws + WS_ROPE) + SEQ * 64};
        pg8::gemm_phase<pg8::EpiProj, pg8::DenseSched<D, T / 256, PROJ / 256, true, true>, D, true, PG8_ALIGN, PG8_SP2>(F.lds, S, E, F.wave);
        }
        convert_queue(F);
        if (BOTH(1)) GRID_BAR();
    }
    if (IN(2)) {
        for (int u = (int)blockIdx.x; u < 128; u += F.G) retention_unit(F, u >> 3, u & 7);
        for (int u = (int)((blockIdx.x + (unsigned)F.G - (128u % (unsigned)F.G)) % (unsigned)F.G); u < 128; u += F.G) lru_unit(F, u >> 3, u & 7);
        if (BOTH(2)) GRID_BAR();
    }
    if (IN(3)) {
        pg8::DenseSched<D, T / 256, D / 256, false, true> S; S.so.init(T, D, F.G, (int)blockIdx.x); S.A = (const char*)(ws + WS_R1); S.B = (const char*)(ws + WS_WOUT);
        pg8::EpiBf16 E{(bf16_t*)(ws + WS_X1), D, 1.0f};
        pg8::gemm_phase<pg8::EpiBf16, pg8::DenseSched<D, T / 256, D / 256, false, true>, D, true, PG8_ALIGN, PG8_SP2>(F.lds, S, E, F.wave);
        if (BOTH(3)) GRID_BAR();
    }
#if MK_LAST_PHASE <= 4
    if (IN(4)) { final_norm_only(F, (const float*)(ws + WS_X1)); }
#else
    if (IN(4)) { router_phase(F); if (BOTH(4)) GRID_BAR(); }
    if (IN(5)) {
        compute_tile_start(F);
        const LAS int* ts = (const LAS int*)(F.lds + TS_OFF); const LAS int* cn = (const LAS int*)(F.lds + CN_OFF);
        pg8::MoeSched<D / 2, true> S; S.G = F.G; S.c = (int)blockIdx.x; S.nrt = __builtin_amdgcn_readfirstlane(ts[NE]); S.ts = ts; S.cn = cn;
        S.A = (const char*)(ws + WS_H2); S.B = (const char*)(ws + WS_WGU); S.bstride = (size_t)D * D; S.tok = (const int*)(ws + WS_TOK);
        pg8::EpiSwiGLU E{ws + WS_R1, (const float*)(ws + WS_RSS), cn};
        pg8::gemm_phase<pg8::EpiSwiGLU, pg8::MoeSched<D / 2, true>, D / 2, true, PG8_ALIGN, PG8_SP2, true>(F.lds, S, E, F.wave);
        if (BOTH(5)) GRID_BAR();
    }
    if (IN(6)) {
        compute_tile_start(F);
        const LAS int* ts = (const LAS int*)(F.lds + TS_OFF); const LAS int* cn = (const LAS int*)(F.lds + CN_OFF);
        pg8::MoeSched<DE / 2, true, true> S; S.G = F.G; S.c = (int)blockIdx.x; S.nrt = __builtin_amdgcn_readfirstlane(ts[NE]); S.ts = ts; S.cn = cn;
        S.A = (const char*)(ws + WS_R1); S.B = (const char*)(ws + WS_WD); S.bstride = (size_t)D * DE; S.tok = nullptr;
        pg8::EpiFp8 E{ws + WS_Y, D, SC_Y / (SC_HB * SC_WD)};
        pg8::gemm_phase<pg8::EpiFp8, pg8::MoeSched<DE / 2, true, true>, DE / 2, true, PG8_ALIGN, PG8_SP2, true>(F.lds, S, E, F.wave);
        if (BOTH(6)) GRID_BAR();
    }
    if (IN(7)) { compute_tile_start(F); combine_phase(F); }
#endif
#undef IN
#undef BOTH
#undef GRID_BAR
}

extern "C" void kernel_launch(void* const* d_in, const int* in_sizes, int n_in, void* d_out, int out_size, void* d_ws, size_t ws_size, hipStream_t stream) {
    static int grid = 0;
    if (grid == 0) {
        if (n_in != 22 || in_sizes[0] != T * D || out_size != T * D || ws_size < WS_END) { fprintf(stderr, "kernel_launch: unexpected shapes (n_in %d, in0 %d, out %d, ws %zu < %zu); nothing launched\n", n_in, n_in > 0 ? in_sizes[0] : -1, out_size, ws_size, (size_t)WS_END); grid = -1; return; }
        int dev = 0, cus = 0, per_cu = 0;
        if (hipGetDevice(&dev) != hipSuccess || hipDeviceGetAttribute(&cus, hipDeviceAttributeMultiprocessorCount, dev) != hipSuccess) { grid = -1; return; }
        if (hipFuncSetAttribute((const void*)hymba_fwd, hipFuncAttributeMaxDynamicSharedMemorySize, LDS_BYTES) != hipSuccess) { fprintf(stderr, "kernel_launch: hipFuncSetAttribute failed\n"); grid = -1; return; }
        if (hipOccupancyMaxActiveBlocksPerMultiprocessor(&per_cu, (const void*)hymba_fwd, NTHREADS, LDS_BYTES) != hipSuccess || per_cu < 1) { fprintf(stderr, "kernel_launch: occupancy query reports %d blocks per CU\n", per_cu); }
        (void)hipGetLastError();
        grid = cus;
    }
    if (grid < 0) return;
    if (hipMemsetAsync((char*)d_ws + WS_CTL, 0, CTL_ZERO_BYTES, stream) != hipSuccess) return;
    Args a{};
    for (int i = 0; i < 22; ++i) a.in[i] = (const float*)d_in[i];
    a.out = (float*)d_out; a.ws = (unsigned char*)d_ws;
    constexpr int NL = MK_N_LAUNCHES;
    constexpr int LASTP = (MK_LAST_PHASE <= 4) ? 5 : NPHASES;
    if (NL == 1) { a.ph_lo = 0; a.ph_hi = LASTP; a.li = 0; hipLaunchKernelGGL(hymba_fwd, dim3(grid), dim3(NTHREADS), LDS_BYTES, stream, a); }
    else for (int li = 0; li < LASTP; ++li) { a.ph_lo = li; a.ph_hi = li + 1; a.li = li; hipLaunchKernelGGL(hymba_fwd, dim3(grid), dim3(NTHREADS), LDS_BYTES, stream, a);
        if (li == MK_REPEAT_PHASE) hipLaunchKernelGGL(hymba_fwd, dim3(grid), dim3(NTHREADS), LDS_BYTES, stream, a); }
}
```
